# Optimizing an MI355X kernel written in HIP

```python
import math
import jax, jax.numpy as jnp
from jax import lax
import numpy as np

D_MODEL = 1024
BATCH = 16
SEQ = 2048
DEPTH = 2

MLSTM_HEADS = 4
MLSTM_DH = 128
MLSTM_W = MLSTM_HEADS * MLSTM_DH
MLSTM_CHUNK = 128
CONV_W = 5
N_MGATES = 4 * MLSTM_HEADS

DIFF_HEADS = 4
DIFF_DH = 64
DIFF_DV = 2 * DIFF_DH
DIFF_QK_W = DIFF_HEADS * 2 * DIFF_DH
DIFF_W = DIFF_HEADS * DIFF_DV
Q_BLOCK = 128

OFF_MQ = 0
OFF_MK = OFF_MQ + MLSTM_W
OFF_MV = OFF_MK + MLSTM_W
OFF_MO = OFF_MV + MLSTM_W
OFF_MG = OFF_MO + MLSTM_W
OFF_DQ = OFF_MG + N_MGATES
OFF_DK = OFF_DQ + DIFF_QK_W
OFF_DV = OFF_DK + DIFF_QK_W
OFF_GATE = OFF_DV + DIFF_W
N_BRANCH = 2
IN_COLS = OFF_GATE + N_BRANCH * D_MODEL

N_EXPERTS = 16
EC_CAPACITY = 2
D_FF_EXPERT = 2 * D_MODEL

EPS = 1e-6

kernel_name = "hybrid_mlstm_diffattn_ecmoe_encoder"


def rms_norm(x, g):
    xf = x.astype(jnp.float32)
    xf = xf * lax.rsqrt(jnp.mean(xf * xf, axis=-1, keepdims=True) + EPS)
    return (xf * g.astype(jnp.float32)).astype(x.dtype)


def centred_dwconv(x, w, b):
    c = x.shape[-1]
    pad = CONV_W // 2
    y = lax.conv_general_dilated(x, w[:, None, :].astype(x.dtype), window_strides=(1,),
                                 padding=[(pad, pad)], dimension_numbers=('NWC', 'WIO', 'NWC'),
                                 feature_group_count=c)
    return y + b.astype(x.dtype)


def mlstm_chunkwise(q, k, v, i_pre, f_pre):
    B, H, S, dk = q.shape
    dv = v.shape[-1]
    L = MLSTM_CHUNK
    NC = S // L
    q = q.astype(jnp.float32).reshape(B, H, NC, L, dk)
    k = (k.astype(jnp.float32) * dk ** -0.5).reshape(B, H, NC, L, dk)
    v = v.astype(jnp.float32).reshape(B, H, NC, L, dv)
    log_f = jax.nn.log_sigmoid(f_pre).reshape(B, H, NC, L)
    log_i = i_pre.reshape(B, H, NC, L)
    b = jnp.cumsum(log_f, axis=-1)
    g = b[..., -1]
    a = g[..., None] - b + log_i
    a_max = a.max(-1)
    w = jnp.exp(a - a_max[..., None])
    C_loc = jnp.einsum('bhclv,bhclk->bhcvk', v * w[..., None], k)
    n_loc = jnp.einsum('bhcl,bhclk->bhck', w, k)

    def step(carry, inp):
        C, n, m = carry
        C_l, n_l, am, gc = inp
        m_new = jnp.maximum(gc + m, am)
        sp = jnp.exp(gc + m - m_new)
        sl = jnp.exp(am - m_new)
        C_new = sp[..., None, None] * C + sl[..., None, None] * C_l
        n_new = sp[..., None] * n + sl[..., None] * n_l
        return (C_new, n_new, m_new), (C, n, m)

    xs = (jnp.moveaxis(C_loc, 2, 0), jnp.moveaxis(n_loc, 2, 0),
          jnp.moveaxis(a_max, 2, 0), jnp.moveaxis(g, 2, 0))
    init = (jnp.zeros((B, H, dv, dk), jnp.float32), jnp.zeros((B, H, dk), jnp.float32),
            jnp.zeros((B, H), jnp.float32))
    _, (C_in, n_in, m_in) = lax.scan(step, init, xs)
    C_in = jnp.moveaxis(C_in, 0, 2)
    n_in = jnp.moveaxis(n_in, 0, 2)
    m_in = jnp.moveaxis(m_in, 0, 2)

    lower = jnp.tril(jnp.ones((L, L), dtype=bool))
    D = b[..., :, None] - b[..., None, :] + log_i[..., None, :]
    D = jnp.where(lower, D, -jnp.inf)
    inter = b + m_in[..., None]
    m_t = jnp.maximum(inter, D.max(-1))
    P = jnp.exp(D - m_t[..., None])
    W = jnp.einsum('bhctd,bhcsd->bhcts', q, k) * P
    s_in = jnp.exp(inter - m_t)
    num = (jnp.einsum('bhcts,bhcsv->bhctv', W, v)
           + s_in[..., None] * jnp.einsum('bhcvk,bhctk->bhctv', C_in, q))
    den = W.sum(-1) + s_in * jnp.einsum('bhck,bhctk->bhct', n_in, q)
    h = num / jnp.maximum(jnp.abs(den), jnp.exp(-m_t))[..., None]
    return h.reshape(B, H, S, dv)


def mlstm_branch(z, conv_w, conv_b, b_mgate, norm_g):
    B, S, _ = z.shape
    qk = jax.nn.silu(centred_dwconv(z[..., OFF_MQ:OFF_MV], conv_w, conv_b))
    to_heads = lambda t: t.reshape(B, S, MLSTM_HEADS, MLSTM_DH).transpose(0, 2, 1, 3)
    q = to_heads(qk[..., :MLSTM_W])
    k = to_heads(qk[..., MLSTM_W:])
    v = to_heads(z[..., OFF_MV:OFF_MO])
    o = z[..., OFF_MO:OFF_MG]
    gates = z[..., OFF_MG:OFF_MG + N_MGATES].astype(jnp.float32) + b_mgate.astype(jnp.float32)
    gates = gates.reshape(B, S, 2, 2, MLSTM_HEADS).transpose(2, 3, 0, 4, 1)
    h_fwd = mlstm_chunkwise(q, k, v, gates[0, 0], gates[0, 1])
    flip = lambda t: jnp.flip(t, axis=2)
    h_bwd = flip(mlstm_chunkwise(flip(q), flip(k), flip(v),
                                 jnp.flip(gates[1, 0], -1), jnp.flip(gates[1, 1], -1)))
    h = h_fwd + h_bwd
    mu = h.mean(-1, keepdims=True)
    var = jnp.mean((h - mu) ** 2, axis=-1, keepdims=True)
    h = ((h - mu) * lax.rsqrt(var + EPS)).transpose(0, 2, 1, 3).reshape(B, S, MLSTM_W)
    h = h * norm_g.astype(jnp.float32) * jax.nn.sigmoid(o.astype(jnp.float32))
    return h.astype(z.dtype)


def diff_attention_branch(z, lam, norm_g, lam_init):
    B, S, _ = z.shape
    H = DIFF_HEADS
    q = z[..., OFF_DQ:OFF_DK].reshape(B, S, H, 2, DIFF_DH).transpose(0, 2, 3, 1, 4)
    k = z[..., OFF_DK:OFF_DV].reshape(B, S, H, 2, DIFF_DH).transpose(0, 2, 3, 1, 4)
    v = z[..., OFF_DV:OFF_GATE].reshape(B, S, H, DIFF_DV).transpose(0, 2, 1, 3)
    lamf = lam.astype(jnp.float32)
    lam_full = (jnp.exp(jnp.sum(lamf[0] * lamf[1])) - jnp.exp(jnp.sum(lamf[2] * lamf[3]))
                + lam_init)
    slopes = jnp.exp2(-8.0 * jnp.arange(1, H + 1, dtype=jnp.float32) / H)
    scale = DIFF_DH ** -0.5
    NB = S // Q_BLOCK
    qb = q.reshape(B, H, 2, NB, Q_BLOCK, DIFF_DH).transpose(3, 0, 1, 2, 4, 5)
    pos = jnp.arange(S, dtype=jnp.int32)

    def block(args):
        q_blk, start = args
        s = jnp.einsum('bhiqd,bhikd->bhiqk', q_blk, k).astype(jnp.float32) * scale
        tq = start + jnp.arange(Q_BLOCK, dtype=jnp.int32)
        dist = jnp.abs(tq[:, None] - pos[None, :]).astype(jnp.float32)
        s = s - (slopes[:, None, None] * dist)[None, :, None]
        p = jax.nn.softmax(s, axis=-1)
        a = p[:, :, 0] - lam_full * p[:, :, 1]
        return jnp.einsum('bhqk,bhkv->bhqv', a.astype(v.dtype), v)

    starts = jnp.arange(NB, dtype=jnp.int32) * Q_BLOCK
    o = lax.map(block, (qb, starts))
    o = o.transpose(1, 2, 0, 3, 4).reshape(B, H, S, DIFF_DV).astype(jnp.float32)
    o = o * lax.rsqrt(jnp.mean(o * o, axis=-1, keepdims=True) + EPS)
    o = o * norm_g.astype(jnp.float32) * (1.0 - lam_init)
    return o.transpose(0, 2, 1, 3).reshape(B, S, DIFF_W).astype(z.dtype)


def expert_choice_ffn(h, w_router, w_gate, w_up, w_down):
    B, S, _ = h.shape
    cap = EC_CAPACITY * S // N_EXPERTS
    aff = jax.nn.softmax(jnp.einsum('bsd,de->bse', h, w_router).astype(jnp.float32), axis=-1)
    g, idx = lax.top_k(aff.transpose(0, 2, 1), cap)
    bidx = jnp.arange(B)[:, None, None]
    xe = h[bidx, idx]
    hid = (jax.nn.silu(jnp.einsum('becd,edf->becf', xe, w_gate))
           * jnp.einsum('becd,edf->becf', xe, w_up))
    ye = jnp.einsum('becf,efd->becd', hid, w_down) * g[..., None].astype(h.dtype)
    return jnp.zeros_like(h).at[bidx, idx].add(ye)


def setup_inputs(seed: int = 0) -> dict:
    key = jax.random.key(seed)
    ks = jax.random.split(key, 20)
    nrm = lambda k, shape, s: jax.random.normal(k, shape, jnp.float32) * s
    i_bias = nrm(ks[3], (DEPTH, 2, MLSTM_HEADS), 0.1)
    f_bias = jnp.linspace(3.0, 6.0, MLSTM_HEADS, dtype=jnp.float32) + nrm(ks[4], (DEPTH, 2, MLSTM_HEADS), 0.1)
    b_mgate = jnp.stack([i_bias, f_bias], axis=2).reshape(DEPTH, N_MGATES)
    return {
        "x": nrm(ks[0], (BATCH, SEQ, D_MODEL), 1.0),
        "norm_mix_g": 1.0 + nrm(ks[1], (DEPTH, D_MODEL), 0.01),
        "w_in": nrm(ks[2], (DEPTH, D_MODEL, IN_COLS), D_MODEL ** -0.5),
        "b_mgate": b_mgate,
        "conv_w": nrm(ks[5], (DEPTH, CONV_W, 2 * MLSTM_W), CONV_W ** -0.5),
        "conv_b": nrm(ks[6], (DEPTH, 2 * MLSTM_W), 0.01),
        "mlstm_norm_g": 1.0 + nrm(ks[7], (DEPTH, MLSTM_W), 0.01),
        "diff_lam": nrm(ks[8], (DEPTH, 4, DIFF_DH), 0.1),
        "diff_norm_g": 1.0 + nrm(ks[9], (DEPTH, DIFF_DV), 0.01),
        "w_up_a": nrm(ks[10], (DEPTH, MLSTM_W, D_MODEL), MLSTM_W ** -0.5),
        "w_up_b": nrm(ks[11], (DEPTH, DIFF_W, D_MODEL), DIFF_W ** -0.5),
        "w_out": nrm(ks[12], (DEPTH, D_MODEL, D_MODEL), D_MODEL ** -0.5),
        "norm_ffn_g": 1.0 + nrm(ks[13], (DEPTH, D_MODEL), 0.01),
        "w_router": nrm(ks[14], (DEPTH, D_MODEL, N_EXPERTS), D_MODEL ** -0.5),
        "w_gate_e": nrm(ks[15], (DEPTH, N_EXPERTS, D_MODEL, D_FF_EXPERT), D_MODEL ** -0.5),
        "w_up_e": nrm(ks[16], (DEPTH, N_EXPERTS, D_MODEL, D_FF_EXPERT), D_MODEL ** -0.5),
        "w_down_e": nrm(ks[17], (DEPTH, N_EXPERTS, D_FF_EXPERT, D_MODEL), D_FF_EXPERT ** -0.5),
        "norm_f_g": 1.0 + nrm(ks[18], (D_MODEL,), 0.01),
    }


def reference(x, norm_mix_g, w_in, b_mgate, conv_w, conv_b, mlstm_norm_g, diff_lam, diff_norm_g,
              w_up_a, w_up_b, w_out, norm_ffn_g, w_router, w_gate_e, w_up_e, w_down_e, norm_f_g):
    for l in range(DEPTH):
        lam_init = 0.8 - 0.6 * math.exp(-0.3 * l)
        h = rms_norm(x, norm_mix_g[l])
        z = jnp.einsum('bsd,dc->bsc', h, w_in[l])
        y_a = jnp.einsum('bsw,wd->bsd', mlstm_branch(z, conv_w[l], conv_b[l], b_mgate[l], mlstm_norm_g[l]), w_up_a[l])
        y_b = jnp.einsum('bsw,wd->bsd', diff_attention_branch(z, diff_lam[l], diff_norm_g[l], lam_init), w_up_b[l])
        g_a = jax.nn.sigmoid(z[..., OFF_GATE:OFF_GATE + D_MODEL])
        g_b = jax.nn.sigmoid(z[..., OFF_GATE + D_MODEL:])
        x = x + jnp.einsum('bsd,de->bse', g_a * y_a + g_b * y_b, w_out[l])
        h2 = rms_norm(x, norm_ffn_g[l])
        x = x + expert_choice_ffn(h2, w_router[l], w_gate_e[l], w_up_e[l], w_down_e[l])
    return rms_norm(x, norm_f_g)
```

```cpp
#include <hip/hip_runtime.h>
#include <cstdio>
#include <cstdint>

#ifndef PROBE_REP
#define PROBE_REP 0
#endif
#ifndef NAIVE_MLSTM
#define NAIVE_MLSTM 0
#endif
#ifndef NAIVE_ATTN
#define NAIVE_ATTN 0
#endif
#ifndef MK_ONE_LAUNCH
#define MK_ONE_LAUNCH 1
#endif

constexpr int D = 1024, BATCH = 16, SEQ = 2048, T = BATCH * SEQ, DEPTH = 2;
constexpr int MH = 4, MDH = 128, MW = 512, CONVW = 5, NMG = 16;
constexpr int AH = 4, ADH = 64, ADV = 128;
constexpr int IN_COLS = 5648, OFF_MG = 2048, OFF_DQ = 2064;
constexpr int NE = 16, CAP = 256, DFF = 2048;
constexpr int NIN = 5632;
constexpr float EPS = 1e-6f;
constexpr float LOG2E = 1.4426950408889634f;
constexpr int NWAVES = 8, NTHREADS = 512;

#define GAS __attribute__((address_space(1)))
#define LAS __attribute__((address_space(3)))
typedef unsigned short bf16;
typedef unsigned v4u __attribute__((ext_vector_type(4)));
typedef unsigned v2u __attribute__((ext_vector_type(2)));
typedef float f32x4 __attribute__((ext_vector_type(4)));
typedef float f32x2 __attribute__((ext_vector_type(2)));
typedef short bf16x8 __attribute__((ext_vector_type(8)));

__device__ __forceinline__ float bf2f(unsigned short b) { return __uint_as_float(((unsigned)b) << 16); }
__device__ __forceinline__ float bflo(unsigned w) { return __uint_as_float(w << 16); }
__device__ __forceinline__ float bfhi(unsigned w) { return __uint_as_float(w & 0xffff0000u); }
__device__ __forceinline__ unsigned f2bf(float f) { unsigned u = __float_as_uint(f); return (u + 0x7fffu + ((u >> 16) & 1u)) >> 16; }
typedef __bf16 bf16x2_n_ __attribute__((ext_vector_type(2)));
__device__ __forceinline__ unsigned pk2(float lo, float hi) { const f32x2 x = (f32x2){lo, hi}; const bf16x2_n_ v = __builtin_convertvector(x, bf16x2_n_); return __builtin_bit_cast(unsigned, v); }
__device__ __forceinline__ float wave_sum(float v) {
#pragma unroll
    for (int o = 1; o < 64; o <<= 1) v += __shfl_xor(v, o);
    return v;
}
__device__ __forceinline__ float sigmoidf_(float x) { return __builtin_amdgcn_rcpf(1.0f + __builtin_amdgcn_exp2f(-x * LOG2E)); }

namespace pg8 {
#define PG8_LAS __attribute__((address_space(3)))
typedef unsigned short bf16_t;
typedef unsigned u32x4 __attribute__((ext_vector_type(4)));
typedef int v4i __attribute__((ext_vector_type(4)));
constexpr int BM = 256, BK = 64, HALF = 128, HTB = HALF * BK * 2, STAGE_BYTES = 8 * HTB, NXCD = 8, WGM = 8;

__host__ __device__ __forceinline__ int lds_byte(int r, int c) { const int st = (r >> 4) * 2 + (c >> 5), rr = r & 15, cc = c & 31, ob = rr * 64 + cc * 2; return st * 1024 + (ob ^ (((ob >> 9) & 1) << 5)); }
__host__ __device__ __forceinline__ void stage_rc(int b, int& R, int& C) { const int st = b / 1024, sb = b % 1024, swz = sb ^ (((sb >> 9) & 1) << 5); R = (st >> 1) * 16 + swz / 64; C = (st & 1) * 32 + (swz % 64) / 2; }
__host__ __device__ __forceinline__ int perm32(int rho) { const int n = rho >> 4, i = rho & 15; return 8 * (i >> 2) + 4 * n + (i & 3); }

struct Unit { int pm, pn, bt, kofs; };

struct StdOrder {
    int nM, nN, nwg, G, c;
    __device__ void init(int M, int N, int G_, int c_) { nM = M / BM; nN = N / BM; nwg = nM * nN; G = G_; c = c_; }
    __device__ bool next(int i, Unit& u) const {
        const long L = (long)i * G + c; if (L >= nwg) return false;
        int wgid = (int)L; { const int q = nwg / NXCD, r = nwg % NXCD, xcd = wgid % NXCD, off = wgid / NXCD; wgid = (xcd < r ? xcd * (q + 1) : r * (q + 1) + (xcd - r) * q) + off; }
        const int nig = WGM * nN, gid = wgid / nig, fm = gid * WGM, gsz = (nM - fm) < WGM ? (nM - fm) : WGM;
        u.pm = fm + ((wgid % nig) % gsz); u.pn = (wgid % nig) / gsz; u.bt = u.pn; u.kofs = 0; return true;
    }
    static constexpr bool GATHER = false, SAME_ROWS = false;
};
struct StdOrderG : StdOrder {
    static constexpr bool GATHER = true, SAME_ROWS = false;
    __device__ __forceinline__ int a_row(const Unit& u, int r) const { return u.pm * 256 + r; }
};
struct G1Order {
    const int* idx; int G, c;
    __device__ bool next(int i, Unit& u) const {
        if (G != 256) { const int L = i * G + c; if (L >= 4096) return false; u.pm = L >> 4; u.pn = L & 15; u.bt = (u.pm & 15) * 16 + u.pn; u.kofs = 0; return true; }
        if (i >= 16) return false;
        const int xcd = c & 7, loc = c >> 3, e = 2 * xcd + (i >> 3), r = i & 7, b = (r & 3) * 4 + (loc & 3), j = (r >> 2) * 8 + (loc >> 2);
        u.pm = b * 16 + e; u.pn = j; u.bt = e * 16 + j; u.kofs = 0; return true;
    }
    static constexpr bool GATHER = true, SAME_ROWS = false;
    __device__ __forceinline__ int a_row(const Unit& u, int r) const { return idx[u.pm * 256 + r]; }
};
struct G2Order {
    int G, c;
    __device__ bool next(int i, Unit& u) const {
        if (G != 256) { const int L = i * G + c; if (L >= 1024) return false; u.pm = L >> 2; u.pn = L & 3; u.bt = (u.pm & 15) * 4 + u.pn; u.kofs = 0; return true; }
        if (i >= 4) return false;
        const int xcd = c & 7, loc = c >> 3, e = 2 * xcd + (i >> 1), b = (i & 1) * 8 + (loc & 7), pn = loc >> 3;
        u.pm = b * 16 + e; u.pn = pn; u.bt = e * 4 + pn; u.kofs = 0; return true;
    }
    static constexpr bool GATHER = true, SAME_ROWS = false;
    __device__ __forceinline__ int a_row(const Unit& u, int r) const { return u.pm * 256 + r; }
};

struct G1OrderBE {
    const int* idx; int be, n;
    __device__ bool next(int i, Unit& u) const { if (i >= n) return false; int pm = be; asm volatile("" : "+s"(pm)); u.pm = pm; u.pn = i; u.bt = (be & 15) * 16 + i; u.kofs = 0; return true; }
    static constexpr bool GATHER = true, SAME_ROWS = true;
    __device__ __forceinline__ int a_row(const Unit& u, int r) const { return idx[u.pm * 256 + r]; }
};
struct G2OrderBE {
    int be, n;
    __device__ bool next(int i, Unit& u) const { if (i >= n) return false; int pm = be; asm volatile("" : "+s"(pm)); u.pm = pm; u.pn = i; u.bt = (be & 15) * 4 + i; u.kofs = 0; return true; }
    static constexpr bool GATHER = true, SAME_ROWS = true;
    __device__ __forceinline__ int a_row(const Unit& u, int r) const { return u.pm * 256 + r; }
};

typedef float f32x2_t_ __attribute__((ext_vector_type(2))); typedef __bf16 bf16x2_t_ __attribute__((ext_vector_type(2)));
__device__ __forceinline__ unsigned cvt_pk_bf16(float lo, float hi) { const f32x2_t_ x = (f32x2_t_){lo, hi}; const bf16x2_t_ b = __builtin_convertvector(x, bf16x2_t_); return __builtin_bit_cast(unsigned, b); }

typedef f32x4 Acc[2][2][4][2];

struct EpiInproj {
    static constexpr bool PERM = true, MIDWAY = false, F8 = false;
    bf16_t *zqk, *zmv, *zmo, *zdq, *zdk, *zdv, *zg;
    __device__ __forceinline__ void operator()(const Acc& acc, const Unit& u, int wr, int wc, int fr, int fq) const {
        const int pn = u.pn; bf16_t* base; int ldc, colt, act = 0;
        if (pn < 4) { base = zqk; ldc = 1024; colt = pn * 256; }
        else if (pn < 6) { base = zmv; ldc = 512; colt = (pn - 4) * 256; }
        else if (pn < 8) { base = zdq; ldc = 512; colt = (pn - 6) * 256; act = 2; }
        else if (pn < 10) { base = zdk; ldc = 512; colt = (pn - 8) * 256; }
        else { base = zdv; ldc = 512; colt = (pn - 10) * 256; }
        const int row0 = u.pm * BM + wr * 64 + fr, col0 = colt + wc * 32 + 8 * fq;
#pragma unroll
        for (int ai = 0; ai < 2; ++ai)
#pragma unroll
            for (int m = 0; m < 4; ++m) { bf16_t* rowp = base + (size_t)(row0 + ai * HALF + m * 16) * ldc + col0;
#pragma unroll
                for (int bj = 0; bj < 2; ++bj) { f32x4 v0 = acc[ai][bj][m][0], v1 = acc[ai][bj][m][1];
                    if (act == 1) {
#pragma unroll
                        for (int j = 0; j < 4; ++j) { v0[j] = sigmoidf_(v0[j]); v1[j] = sigmoidf_(v1[j]); } }
                    else if (act == 2) { v0 = v0 * (0.125f * LOG2E); v1 = v1 * (0.125f * LOG2E); }
                    u32x4 w; w.x = cvt_pk_bf16(v0[0], v0[1]); w.y = cvt_pk_bf16(v0[2], v0[3]); w.z = cvt_pk_bf16(v1[0], v1[1]); w.w = cvt_pk_bf16(v1[2], v1[3]);
                    *(u32x4*)(rowp + bj * HALF) = w; } }
    }
};
#define RCPG(x) __builtin_amdgcn_rcpf(fmaxf((x), 1e-30f))
struct UpOrder : StdOrder {
    __device__ bool next(int i, Unit& u) const { if (!StdOrder::next(i >> 1, u)) return false; u.kofs = (i & 1) * 1024; return true; }
};
struct EpiUp {
    static constexpr bool PERM = true, MIDWAY = true, F8 = false;
    bf16_t* mix; const bf16_t* zg;
    __device__ __forceinline__ bool midway(Acc& acc, const Unit& u, int wr, int wc, int fr, int fq) const {
        if (u.kofs != 0) return false;
        const int row0 = u.pm * BM + wr * 64 + fr, col0 = u.pn * BM + wc * 32 + 8 * fq;
#pragma unroll
        for (int ai = 0; ai < 2; ++ai)
#pragma unroll
            for (int m = 0; m < 4; ++m) { const size_t row = (size_t)(row0 + ai * HALF + m * 16);
#pragma unroll
                for (int bj = 0; bj < 2; ++bj) { const int col = col0 + bj * HALF;
                    const u32x4 ga = *(const u32x4*)(zg + row * 2048 + col), gb = *(const u32x4*)(zg + row * 2048 + 1024 + col);
                    f32x4& v0 = acc[ai][bj][m][0]; f32x4& v1 = acc[ai][bj][m][1];
                    v0[0] *= bflo(ga.x) * RCPG(bflo(gb.x)); v0[1] *= bfhi(ga.x) * RCPG(bfhi(gb.x)); v0[2] *= bflo(ga.y) * RCPG(bflo(gb.y)); v0[3] *= bfhi(ga.y) * RCPG(bfhi(gb.y));
                    v1[0] *= bflo(ga.z) * RCPG(bflo(gb.z)); v1[1] *= bfhi(ga.z) * RCPG(bfhi(gb.z)); v1[2] *= bflo(ga.w) * RCPG(bflo(gb.w)); v1[3] *= bfhi(ga.w) * RCPG(bfhi(gb.w)); } }
        return true;
    }
    __device__ __forceinline__ void operator()(const Acc& acc, const Unit& u, int wr, int wc, int fr, int fq) const {
        const int row0 = u.pm * BM + wr * 64 + fr, col0 = u.pn * BM + wc * 32 + 8 * fq;
#pragma unroll
        for (int ai = 0; ai < 2; ++ai)
#pragma unroll
            for (int m = 0; m < 4; ++m) { const size_t row = (size_t)(row0 + ai * HALF + m * 16);
#pragma unroll
                for (int bj = 0; bj < 2; ++bj) { const int col = col0 + bj * HALF;
                    const u32x4 g = *(const u32x4*)(zg + row * 2048 + 1024 + col);
                    f32x4 v0 = acc[ai][bj][m][0], v1 = acc[ai][bj][m][1];
                    v0[0] *= bflo(g.x); v0[1] *= bfhi(g.x); v0[2] *= bflo(g.y); v0[3] *= bfhi(g.y);
                    v1[0] *= bflo(g.z); v1[1] *= bfhi(g.z); v1[2] *= bflo(g.w); v1[3] *= bfhi(g.w);
                    u32x4 w; w.x = cvt_pk_bf16(v0[0], v0[1]); w.y = cvt_pk_bf16(v0[2], v0[3]); w.z = cvt_pk_bf16(v1[0], v1[1]); w.w = cvt_pk_bf16(v1[2], v1[3]);
                    *(u32x4*)(mix + row * 1024 + col) = w; } }
    }
};
struct EpiResid {
    static constexpr bool PERM = true, MIDWAY = false, F8 = false;
    bf16_t* x;
    __device__ __forceinline__ void operator()(const Acc& acc, const Unit& u, int wr, int wc, int fr, int fq) const {
        const int row0 = u.pm * BM + wr * 64 + fr, col0 = u.pn * BM + wc * 32 + 8 * fq;
#pragma unroll
        for (int ai = 0; ai < 2; ++ai)
#pragma unroll
            for (int m = 0; m < 4; ++m) { bf16_t* rowp = x + (size_t)(row0 + ai * HALF + m * 16) * 1024 + col0;
#pragma unroll
                for (int bj = 0; bj < 2; ++bj) { const u32x4 o = *(const u32x4*)(rowp + bj * HALF); const f32x4 a0 = acc[ai][bj][m][0], a1 = acc[ai][bj][m][1];
                    u32x4 w; w.x = cvt_pk_bf16(a0[0] + bflo(o.x), a0[1] + bfhi(o.x)); w.y = cvt_pk_bf16(a0[2] + bflo(o.y), a0[3] + bfhi(o.y));
                    w.z = cvt_pk_bf16(a1[0] + bflo(o.z), a1[1] + bfhi(o.z)); w.w = cvt_pk_bf16(a1[2] + bflo(o.w), a1[3] + bfhi(o.w));
                    *(u32x4*)(rowp + bj * HALF) = w; } }
    }
};
constexpr int W8_LOG2 = 5, H8_LOG2 = 2;
constexpr float W8_SCALE = 32.0f, H8_SCALE = 4.0f;
__device__ __forceinline__ float clamp_f8(float x) { float r; asm("v_max_f32 %0, 0xc3e00000, %1\n\tv_min_f32 %0, 0x43e00000, %0" : "=v"(r) : "v"(x)); return r; }
__device__ __forceinline__ unsigned pk4_fp8(float a, float b, float c, float d) {
    int p = __builtin_amdgcn_cvt_pk_fp8_f32(clamp_f8(a), clamp_f8(b), 0, false); p = __builtin_amdgcn_cvt_pk_fp8_f32(clamp_f8(c), clamp_f8(d), p, true); return (unsigned)p; }
struct EpiG1 {
    static constexpr bool PERM = true, MIDWAY = false, F8 = true;
    unsigned char* hid;
    __device__ __forceinline__ void operator()(const Acc& acc, const Unit& u, int wr, int wc, int fr, int fq) const {
        const int row0 = u.pm * BM + wr * 64 + fr, col0 = u.pn * 128 + wc * 32 + 8 * fq;
        constexpr float SG = 1.0f / W8_SCALE;
#pragma unroll
        for (int ai = 0; ai < 2; ++ai)
#pragma unroll
            for (int m = 0; m < 4; ++m) { unsigned char* rowp = hid + (size_t)(row0 + ai * HALF + m * 16) * DFF + col0;
                f32x4 v0, v1;
#pragma unroll
                for (int j = 0; j < 4; ++j) { const float g0 = acc[ai][0][m][0][j], g1 = acc[ai][0][m][1][j];
                    v0[j] = g0 * sigmoidf_(g0 * SG) * __builtin_amdgcn_ldexpf(acc[ai][1][m][0][j], H8_LOG2 - 2 * W8_LOG2); v1[j] = g1 * sigmoidf_(g1 * SG) * __builtin_amdgcn_ldexpf(acc[ai][1][m][1][j], H8_LOG2 - 2 * W8_LOG2); }
                v2u w; w.x = pk4_fp8(v0[0], v0[1], v0[2], v0[3]); w.y = pk4_fp8(v1[0], v1[1], v1[2], v1[3]);
                *(v2u*)rowp = w; }
    }
};
struct EpiGate8 {
    static constexpr bool PERM = true, MIDWAY = false, F8 = true;
    bf16_t *zmo, *zg;
    __device__ __forceinline__ void operator()(const Acc& acc, const Unit& u, int wr, int wc, int fr, int fq) const {
        bf16_t* base; int ldc, colt;
        if (u.pn < 2) { base = zmo; ldc = 512; colt = u.pn * 256; } else { base = zg; ldc = 2048; colt = (u.pn - 2) * 256; }
        const int row0 = u.pm * BM + wr * 64 + fr, col0 = colt + wc * 32 + 8 * fq;
        constexpr float SG = 1.0f / W8_SCALE;
#pragma unroll
        for (int ai = 0; ai < 2; ++ai)
#pragma unroll
            for (int m = 0; m < 4; ++m) { bf16_t* rowp = base + (size_t)(row0 + ai * HALF + m * 16) * ldc + col0;
#pragma unroll
                for (int bj = 0; bj < 2; ++bj) { f32x4 v0 = acc[ai][bj][m][0], v1 = acc[ai][bj][m][1];
#pragma unroll
                    for (int j = 0; j < 4; ++j) { v0[j] = sigmoidf_(v0[j] * SG); v1[j] = sigmoidf_(v1[j] * SG); }
                    u32x4 w; w.x = cvt_pk_bf16(v0[0], v0[1]); w.y = cvt_pk_bf16(v0[2], v0[3]); w.z = cvt_pk_bf16(v1[0], v1[1]); w.w = cvt_pk_bf16(v1[2], v1[3]);
                    *(u32x4*)(rowp + bj * HALF) = w; } }
    }
};
struct EpiG2 {
    static constexpr bool PERM = true, MIDWAY = false, F8 = true;
    bf16_t* ye; const float* gatev;
    __device__ __forceinline__ void operator()(const Acc& acc, const Unit& u, int wr, int wc, int fr, int fq) const {
        const int row0 = u.pm * BM + wr * 64 + fr, col0 = u.pn * BM + wc * 32 + 8 * fq;
#pragma unroll
        for (int ai = 0; ai < 2; ++ai)
#pragma unroll
            for (int m = 0; m < 4; ++m) { const int row = row0 + ai * HALF + m * 16; const float g = gatev[row] * (1.0f / (W8_SCALE * H8_SCALE)); bf16_t* rowp = ye + (size_t)row * 1024 + col0;
#pragma unroll
                for (int bj = 0; bj < 2; ++bj) { const f32x4 v0 = acc[ai][bj][m][0] * g, v1 = acc[ai][bj][m][1] * g;
                    u32x4 w; w.x = cvt_pk_bf16(v0[0], v0[1]); w.y = cvt_pk_bf16(v0[2], v0[3]); w.z = cvt_pk_bf16(v1[0], v1[1]); w.w = cvt_pk_bf16(v1[2], v1[3]);
                    *(u32x4*)(rowp + bj * HALF) = w; } }
    }
};

template <class Epi, class Sched>
__device__ __forceinline__ void gemm_phase(PG8_LAS unsigned char* lds, const bf16_t* Aptr, const bf16_t* Btptr, const int K, const Sched& S, const Epi& E, const int wv, const int LD = 0) {
    const int ld = LD ? LD : K;
    constexpr bool GATHER = Sched::GATHER;
    int tid_; asm volatile("v_mbcnt_lo_u32_b32 %0, -1, 0\n\tv_mbcnt_hi_u32_b32 %0, -1, %0" : "=v"(tid_)); tid_ += wv * 64;
    const int tid = tid_, wid = __builtin_amdgcn_readfirstlane(tid >> 6), lane = tid & 63, wr = wid >> 2, wc = wid & 3, fr = lane & 15, fq = lane >> 4;
    const int nt = K / BK;
    unsigned voffA[2], voffB[2];
#pragma unroll
    for (int i = 0; i < 2; ++i) { int R, C; stage_rc(tid * 16 + i * 8192, R, C); const int Rb = Epi::PERM ? ((R & ~31) + perm32(R & 31)) : R;
        voffA[i] = (unsigned)(R * ld + C) * 2u; voffB[i] = (unsigned)(Rb * ld + C) * 2u; }
    const size_t kstep = (size_t)(BK * 2);
    const size_t hstep = (size_t)HALF * ld * 2;
    const size_t tstep = 2 * hstep;
    const unsigned ldsw = (unsigned)wid * 1024u;
    const int aoff = lds_byte(wr * 64 + fr, fq * 8), boff = lds_byte(wc * 32 + fr, fq * 8);
#define PG8_SA(b, h) (((b) * 2 + (h)) * HTB)
#define PG8_SB(b, h) ((4 + (b) * 2 + (h)) * HTB)
#define PG8_STAGE(bufoff, gbase, voff) do { _Pragma("unroll") for (int _i = 0; _i < 2; ++_i) \
        __builtin_amdgcn_global_load_lds((const unsigned*)((const char*)(gbase) + (voff)[_i]), (PG8_LAS unsigned*)(lds + (bufoff) + ldsw + _i * 8192), 16, 0, 0); } while (0)
#define PG8_STAGE_A(bufoff, gbase, h) do { if constexpr (GATHER) { PG8_STAGE(bufoff, gbase, vg[h]); } else { PG8_STAGE(bufoff, (gbase) + (h) * hstep, voffA); } } while (0)
#define PG8_LDA(dst, b, h) do { _Pragma("unroll") for (int m = 0; m < 4; ++m) _Pragma("unroll") for (int k = 0; k < 2; ++k) dst[m][k] = *(const PG8_LAS bf16x8*)(lds + PG8_SA(b, h) + aoff + m * 2048 + k * 1024); } while (0)
#define PG8_LDB(dst, b, h) do { _Pragma("unroll") for (int n = 0; n < 2; ++n) _Pragma("unroll") for (int k = 0; k < 2; ++k) dst[n][k] = *(const PG8_LAS bf16x8*)(lds + PG8_SB(b, h) + boff + n * 2048 + k * 1024); } while (0)
#define PG8_CAT(x, y) __builtin_shufflevector((v4i)(x), (v4i)(y), 0, 1, 2, 3, 4, 5, 6, 7)
#define PG8_MMA(ai, bj, At, Bt) do { __builtin_amdgcn_s_setprio(1); if constexpr (Epi::F8) { _Pragma("unroll") for (int m = 0; m < 4; ++m) _Pragma("unroll") for (int n = 0; n < 2; ++n) \
        acc[ai][bj][m][n] = __builtin_amdgcn_mfma_scale_f32_16x16x128_f8f6f4(PG8_CAT(Bt[n][0], Bt[n][1]), PG8_CAT(At[m][0], At[m][1]), acc[ai][bj][m][n], 0, 0, 0, sc1, 0, sc1); } \
    else { _Pragma("unroll") for (int m = 0; m < 4; ++m) _Pragma("unroll") for (int n = 0; n < 2; ++n) _Pragma("unroll") for (int k = 0; k < 2; ++k) \
        acc[ai][bj][m][n] = __builtin_amdgcn_mfma_f32_16x16x32_bf16(Bt[n][k], At[m][k], acc[ai][bj][m][n], 0, 0, 0); } __builtin_amdgcn_s_setprio(0); } while (0)
#define PG8_WAIT_V(n) asm volatile("s_waitcnt vmcnt(" #n ")" ::: "memory")
#define PG8_WAIT_L(n) asm volatile("s_waitcnt lgkmcnt(" #n ")" ::: "memory")
#define PG8_BAR __builtin_amdgcn_s_barrier()
#define PG8_SCHED __builtin_amdgcn_sched_barrier(0)
#define PG8_GOFFS(u) do { _Pragma("unroll") for (int _h = 0; _h < 2; ++_h) _Pragma("unroll") for (int _i = 0; _i < 2; ++_i) { \
        int _R, _C; stage_rc(tid * 16 + _i * 8192, _R, _C); vg[_h][_i] = ((unsigned)S.a_row(u, _h * HALF + _R) * (unsigned)ld + (unsigned)_C) * 2u; } } while (0)
    Unit cur, nxt; int ui = 0;
    if (!S.next(0, cur)) return;
    int sc1 = 0x7f7f7f7f; asm volatile("" : "+v"(sc1));
    float zf = 0.f; asm volatile("" : "+v"(zf));
    f32x4 acc[2][2][4][2];
#pragma unroll
    for (int a = 0; a < 2; ++a)
#pragma unroll
        for (int b = 0; b < 2; ++b)
#pragma unroll
            for (int m = 0; m < 4; ++m)
#pragma unroll
                for (int n = 0; n < 2; ++n) acc[a][b][m][n] = (f32x4){zf, zf, zf, zf};
    bf16x8 At[4][2], B0[2][2], B1[2][2];
    unsigned vg[2][2] = {{0u, 0u}, {0u, 0u}};
    const char* cA = (const char*)Aptr + cur.kofs; const char* cB = (const char*)Btptr + (size_t)cur.bt * tstep + cur.kofs;
    if constexpr (GATHER) { PG8_GOFFS(cur); } else { cA += (size_t)cur.pm * tstep; }
    PG8_STAGE(PG8_SB(0, 0), cB, voffB); PG8_STAGE(PG8_SB(0, 1), cB + hstep, voffB); PG8_STAGE_A(PG8_SA(0, 0), cA, 0); PG8_STAGE_A(PG8_SA(0, 1), cA, 1);
    if (wr == 1) PG8_BAR;
    PG8_WAIT_V(2); PG8_BAR;
    PG8_STAGE(PG8_SB(1, 0), cB + kstep, voffB); PG8_STAGE_A(PG8_SA(1, 0), cA + kstep, 0); PG8_STAGE(PG8_SB(1, 1), cB + hstep + kstep, voffB);
    PG8_WAIT_V(6); PG8_BAR;
    for (;;) {
        const bool has_next = S.next(ui + 1, nxt);
        const char* nA = cA; if constexpr (!GATHER) { if (has_next) nA = (const char*)Aptr + (size_t)nxt.pm * tstep + nxt.kofs; }
        const char* nB = has_next ? (const char*)Btptr + (size_t)nxt.bt * tstep + nxt.kofs : cB;
#pragma unroll 1
        for (int t = 0; t < nt; t += 2) {
            const bool last = (t == nt - 2);
            const char* a1 = cA + (size_t)(t + 1) * kstep;
            const char* a2 = last ? nA : cA + (size_t)(t + 2) * kstep; const char* b2 = last ? nB : cB + (size_t)(t + 2) * kstep;
            const char* a3 = a2 + kstep; const char* b3 = b2 + kstep;
            PG8_LDB(B0, 0, 0); PG8_LDB(B1, 0, 1); PG8_SCHED; PG8_LDA(At, 0, 0); PG8_STAGE_A(PG8_SA(1, 1), a1, 1);
            if constexpr (GATHER && !Sched::SAME_ROWS) { if (last && has_next) { PG8_GOFFS(nxt); } }
            if constexpr (GATHER && Sched::SAME_ROWS) { if (last) asm volatile("" : "+v"(vg[0][0]), "+v"(vg[0][1]), "+v"(vg[1][0]), "+v"(vg[1][1])); }
            PG8_WAIT_V(8); PG8_WAIT_L(0); PG8_BAR; PG8_MMA(0, 0, At, B0); PG8_MMA(0, 1, At, B1); PG8_BAR; PG8_SCHED;
            PG8_LDA(At, 0, 1); PG8_STAGE(PG8_SB(0, 0), b2, voffB); PG8_STAGE(PG8_SB(0, 1), b2 + hstep, voffB); PG8_STAGE_A(PG8_SA(0, 0), a2, 0);
            PG8_WAIT_V(8); PG8_WAIT_L(0); PG8_BAR; PG8_MMA(1, 0, At, B0); PG8_MMA(1, 1, At, B1); PG8_BAR; PG8_SCHED;
            PG8_LDB(B0, 1, 0); PG8_LDB(B1, 1, 1); PG8_SCHED; PG8_LDA(At, 1, 0); PG8_STAGE_A(PG8_SA(0, 1), a2, 1);
            PG8_WAIT_V(8); PG8_WAIT_L(0); PG8_BAR; PG8_MMA(0, 0, At, B0); PG8_MMA(0, 1, At, B1); PG8_BAR; PG8_SCHED;
            PG8_LDA(At, 1, 1); PG8_STAGE(PG8_SB(1, 0), b3, voffB); PG8_STAGE(PG8_SB(1, 1), b3 + hstep, voffB); PG8_STAGE_A(PG8_SA(1, 0), a3, 0);
            PG8_WAIT_V(8); PG8_WAIT_L(0); PG8_BAR; PG8_MMA(1, 0, At, B0); PG8_MMA(1, 1, At, B1); PG8_BAR; PG8_SCHED;
        }
        if (wr == 0) PG8_BAR;
        bool keep = false;
        if constexpr (Epi::MIDWAY) keep = E.midway(acc, cur, wr, wc, fr, fq);
        if (!keep) E(acc, cur, wr, wc, fr, fq);
        if (!has_next) break;
        if (!keep) {
#pragma unroll
        for (int a = 0; a < 2; ++a)
#pragma unroll
            for (int b = 0; b < 2; ++b)
#pragma unroll
                for (int m = 0; m < 4; ++m)
#pragma unroll
                    for (int n = 0; n < 2; ++n) acc[a][b][m][n] = (f32x4){zf, zf, zf, zf};
        }
        cur = nxt; cA = nA; cB = nB; ++ui;
        if (wr == 1) PG8_BAR;
    }
    PG8_WAIT_V(0);
    PG8_BAR;
#undef PG8_SA
#undef PG8_SB
#undef PG8_STAGE
#undef PG8_STAGE_A
#undef PG8_LDA
#undef PG8_LDB
#undef PG8_MMA
#undef PG8_CAT
#undef PG8_WAIT_V
#undef PG8_WAIT_L
#undef PG8_BAR
#undef PG8_SCHED
#undef PG8_GOFFS
}
}

constexpr size_t MiB = 1u << 20;
constexpr size_t WS_CTL = 0, CTL_ZERO_BYTES = 1 * MiB;
constexpr size_t WS_MG = 1 * MiB, WS_AFF = 3 * MiB, WS_INV = 5 * MiB, WS_IDX = 7 * MiB, WS_GATEV = 7 * MiB + 256 * 1024;
constexpr size_t WS_WIN = 8 * MiB, WS_WA = 19 * MiB, WS_WB = 20 * MiB, WS_WO = 21 * MiB, WS_WGU = 24 * MiB, WS_WD = 152 * MiB;
constexpr size_t WS_WGU_L1 = 88 * MiB, WS_WD_L1 = 184 * MiB, WS_WA_L1 = 888 * MiB, WS_WO_L1 = 890 * MiB;
constexpr size_t WS_XB = 216 * MiB;
constexpr size_t WS_WIN8 = WS_WIN + (size_t)3584 * 2048;
constexpr size_t WS_ZQK = 280 * MiB, WS_ZMV = 344 * MiB, WS_ZMO = 376 * MiB, WS_ZDQ = 408 * MiB, WS_ZDK = 440 * MiB, WS_ZDV = 472 * MiB, WS_ZG = 504 * MiB;
constexpr size_t WS_HM = 632 * MiB, WS_HD = 664 * MiB, WS_MIX = 696 * MiB, WS_HF = 760 * MiB, WS_HB = 824 * MiB, WS_END = 888 * MiB;
constexpr size_t WS_XR = 892 * MiB, WS_END2 = 956 * MiB;
constexpr size_t WS_HID = 280 * MiB, WS_YE = 536 * MiB;
constexpr int CW_BAR = 4096;

constexpr int RING_BYTES = 131072;
constexpr int LDSCTL_OFF = RING_BYTES, MISC_OFF = LDSCTL_OFF + 320;
constexpr int LDS_BYTES = 147456;

#define XB_TMO      128
#define XB_XCNT(j)  (256  + 64 * (j))
#define XB_XSUB(j)  (1280 + 64 * (j))
#define XB_XGEN(j)  (2304 + 64 * (j))
#define XB_TOP      3328
#define XB_TOPGEN   3392
#define XCD_BAR_WORDS 3456
#define XB_SPIN_CAP (1u << 22)
__device__ __forceinline__ unsigned xb_ld(unsigned* p)              { return __hip_atomic_load(p, __ATOMIC_RELAXED, __HIP_MEMORY_SCOPE_AGENT); }
__device__ __forceinline__ unsigned xb_add(unsigned* p, unsigned v) { return __hip_atomic_fetch_add(p, v, __ATOMIC_RELAXED, __HIP_MEMORY_SCOPE_AGENT); }
__device__ __forceinline__ unsigned xb_xcc_id() { return (unsigned)__builtin_amdgcn_s_getreg((3 << 11) | 20) & 0xFu; }
#define XB_SPIN(cond, bar) do { unsigned _sp = 0; while (cond) { __builtin_amdgcn_s_sleep(1); \
    if ((++_sp & 255u) == 0u) { if (xb_ld(&(bar)[XB_TMO])) break; if (_sp > XB_SPIN_CAP) { atomicAdd(&(bar)[XB_TMO], 1u); break; } } } } while (0)
struct XcdBarrier { unsigned* bar; unsigned x; volatile LAS unsigned* st; };
__device__ __forceinline__ XcdBarrier xcd_barrier_post(unsigned* bar, volatile LAS unsigned* st) {
    XcdBarrier b; b.bar = bar; b.x = xb_xcc_id(); b.st = st;
    if (threadIdx.x == 0) (void)xb_add(&bar[XB_XCNT(b.x)], 1u);
    return b;
}
__device__ __forceinline__ void xcd_barrier_complete(unsigned* bar, unsigned x, unsigned& nloc, unsigned& nx) {
    const unsigned G = gridDim.x * gridDim.y * gridDim.z;
    unsigned sum, cnt, mine, sp = 0u;
    for (;;) {
        sum = 0u; cnt = 0u; mine = 0u;
#pragma unroll
        for (unsigned j = 0; j < 16; ++j) { const unsigned c = xb_ld(&bar[XB_XCNT(j)]); sum += c; cnt += (c > 0u) ? 1u : 0u; mine = (j == x) ? c : mine; }
        if (sum == G) break;
        __builtin_amdgcn_s_sleep(1);
        if ((++sp & 255u) == 0u) { if (xb_ld(&bar[XB_TMO])) break; if (sp > XB_SPIN_CAP) { atomicAdd(&bar[XB_TMO], 1u); break; } }
    }
    nloc = mine > 0u ? mine : 1u; nx = cnt > 0u ? cnt : 1u;
}
__device__ __forceinline__ void xcd_barrier(const XcdBarrier& b) {
    asm volatile("s_waitcnt vmcnt(0)" ::: "memory");
    __syncthreads();
    if (threadIdx.x == 0) {
        unsigned* bar = b.bar;
        __builtin_amdgcn_s_waitcnt(0);
        unsigned nloc = b.st[0], nx = b.st[1];
        if (nloc == 0u) { xcd_barrier_complete(bar, b.x, nloc, nx); b.st[0] = nloc; b.st[1] = nx; }
        const unsigned old = xb_add(&bar[XB_XSUB(b.x)], 1u);
        const unsigned gen = old / nloc;
        if (old + 1u == (gen + 1u) * nloc) {
            __builtin_amdgcn_fence(__ATOMIC_RELEASE, "agent");
            asm volatile("s_waitcnt vmcnt(0)" ::: "memory");
            const unsigned og = xb_add(&bar[XB_TOP], 1u);
            const unsigned tg = og / nx;
            if (og + 1u == (tg + 1u) * nx) xb_add(&bar[XB_TOPGEN], 1u);
            else XB_SPIN(xb_ld(&bar[XB_TOPGEN]) == tg, bar);
            __builtin_amdgcn_fence(__ATOMIC_ACQUIRE, "agent");
            xb_add(&bar[XB_XGEN(b.x)], 1u);
            asm volatile("s_waitcnt vmcnt(0)" ::: "memory");
        } else {
            XB_SPIN(xb_ld(&bar[XB_XGEN(b.x)]) == gen, bar);
            __builtin_amdgcn_fence(__ATOMIC_ACQUIRE, "agent");
            asm volatile("s_waitcnt vmcnt(0)" ::: "memory");
        }
    }
    __syncthreads();
}

struct Args { const float* in[18]; float* out; unsigned char* ws; int ph_lo, ph_hi; };
enum { I_X = 0, I_NMG, I_WIN, I_BMG, I_CW, I_CB, I_MNG, I_LAM, I_DNG, I_WUA, I_WUB, I_WOUT, I_NFG, I_WR, I_WGE, I_WUE, I_WDE, I_NF };

struct Frame {
    LAS unsigned char* lds;
    int G, bx, wv;
    const float* in[18];
    float* X;
    unsigned char* ws;
};
#define WSP(type, off) ((type*)(F.ws + (off)))
__device__ __forceinline__ int lane_id_volatile() { int l; asm volatile("v_mbcnt_lo_u32_b32 %0, -1, 0\n\tv_mbcnt_hi_u32_b32 %0, -1, %0" : "=v"(l)); return l; }
#define PH_IDS int tid = F.wv * 64 + lane_id_volatile(); const int lane = tid & 63; const int wave = __builtin_amdgcn_readfirstlane(tid >> 6); (void)lane; (void)wave

struct CvItem { const float* W; bf16* WT; int pitch, Kdst, k0, f8; };
__device__ __forceinline__ void cv_load(const CvItem& c, int lane, f32x4 (&v)[16]) {
    const int rsh = c.f8 ? 3 : 4, lr = lane >> rsh, lc = (lane & ((1 << rsh) - 1)) * 4, rpi = 64 >> rsh;
    const float* src = c.W + (size_t)(c.k0 + lr) * c.pitch + lc; const size_t step = (size_t)rpi * c.pitch;
#pragma unroll
    for (int i = 0; i < 16; ++i) v[i] = __builtin_nontemporal_load((const f32x4*)(src + i * step));
}
__device__ __forceinline__ void cv_store(const CvItem& c, int lane, const f32x4 (&v)[16], LAS float* scr) {
    if (c.f8) {
#pragma unroll
        for (int i = 0; i < 16; ++i) { const int k = 8 * i + (lane >> 3), n = (lane & 7) * 4; *(LAS f32x4*)(scr + k * 32 + (n ^ (((k >> 4) & 7) << 2))) = v[i]; }
        asm volatile("s_waitcnt lgkmcnt(0)" ::: "memory");
#pragma unroll
        for (int it = 0; it < 4; ++it) { const int n = it * 8 + (lane >> 3), kc = lane & 7; const LAS float* sp = scr + (16 * kc) * 32 + (n ^ (kc << 2));
            float f[16];
#pragma unroll
            for (int j = 0; j < 16; ++j) f[j] = __builtin_amdgcn_ldexpf(sp[j * 32], pg8::W8_LOG2);
            v4u o; o.x = pg8::pk4_fp8(f[0], f[1], f[2], f[3]); o.y = pg8::pk4_fp8(f[4], f[5], f[6], f[7]); o.z = pg8::pk4_fp8(f[8], f[9], f[10], f[11]); o.w = pg8::pk4_fp8(f[12], f[13], f[14], f[15]);
            *(v4u*)((unsigned char*)c.WT + (size_t)n * c.Kdst + c.k0 + 16 * kc) = o; }
        asm volatile("s_waitcnt lgkmcnt(0)" ::: "memory");
        return;
    }
#pragma unroll
    for (int i = 0; i < 16; ++i) { const int k = 4 * i + (lane >> 4), n = (lane & 15) * 4; *(LAS f32x4*)(scr + k * 64 + (n ^ (((k >> 3) & 7) << 2))) = v[i]; }
    asm volatile("s_waitcnt lgkmcnt(0)" ::: "memory");
#pragma unroll
    for (int it = 0; it < 8; ++it) { const int n = it * 8 + (lane >> 3), kc = lane & 7; const LAS float* sp = scr + (8 * kc) * 64 + (n ^ (kc << 2));
        v4u o; o.x = pk2(sp[0 * 64], sp[1 * 64]); o.y = pk2(sp[2 * 64], sp[3 * 64]); o.z = pk2(sp[4 * 64], sp[5 * 64]); o.w = pk2(sp[6 * 64], sp[7 * 64]);
        *(v4u*)(c.WT + (size_t)n * c.Kdst + c.k0 + 8 * kc) = o; }
    asm volatile("s_waitcnt lgkmcnt(0)" ::: "memory");
}
__device__ __forceinline__ CvItem cv_decode(Frame& F, int l, int it) {
    constexpr int J0 = 16 * 32, J1 = 16 * 56, J2 = 8 * 16, J3 = 8 * 16, J4 = 16 * 16, J5 = 16 * 16 * 32, J6 = J5;
    const float* w_in = F.in[I_WIN] + (size_t)l * D * IN_COLS;
    int r = it; CvItem c; c.f8 = 0;
    if (r < J0) { if (r < 16 * 24) { const int kb = r / 24, nb = r % 24; c.W = w_in + nb * 64; c.pitch = IN_COLS; c.WT = WSP(bf16, WS_WIN) + (size_t)(nb * 64) * D; c.Kdst = D; c.k0 = kb * 64; return c; }
        r -= 16 * 24; const int kb = r / 16, nb = r % 16;
        c.W = w_in + 1536 + nb * 32; c.pitch = IN_COLS; c.f8 = 1; c.WT = (bf16*)(F.ws + WS_WIN8 + (size_t)(nb * 32) * D); c.Kdst = D; c.k0 = kb * 128; return c; } r -= J0;
    if (r < J1) { if (r < 16 * 24) { const int kb = r / 24, nb = r % 24; c.W = w_in + OFF_DQ + nb * 64; c.pitch = IN_COLS; c.WT = WSP(bf16, WS_WIN) + (size_t)(1536 + nb * 64) * D; c.Kdst = D; c.k0 = kb * 64; return c; }
        r -= 16 * 24; const int kb = r / 64, nb = r % 64;
        c.W = w_in + OFF_DQ + 1536 + nb * 32; c.pitch = IN_COLS; c.f8 = 1; c.WT = (bf16*)(F.ws + WS_WIN8 + (size_t)(512 + nb * 32) * D); c.Kdst = D; c.k0 = kb * 128; return c; } r -= J1;
    if (r < J2) { const int kb = r / 16, nb = r % 16; c.W = F.in[I_WUA] + (size_t)l * MW * D + nb * 64; c.pitch = D; c.WT = WSP(bf16, l == 0 ? WS_WA : WS_WA_L1) + (size_t)(nb * 64) * 1024; c.Kdst = 1024; c.k0 = kb * 64; return c; } r -= J2;
    if (r < J3) { const int kb = r / 16, nb = r % 16; c.W = F.in[I_WUB] + (size_t)l * MW * D + nb * 64; c.pitch = D; c.WT = WSP(bf16, l == 0 ? WS_WA : WS_WA_L1) + (size_t)(nb * 64) * 1024 + 512; c.Kdst = 1024; c.k0 = kb * 64; return c; } r -= J3;
    if (r < J4) { const int kb = r / 16, nb = r % 16; c.W = F.in[I_WOUT] + (size_t)l * D * D + nb * 64; c.pitch = D; c.WT = WSP(bf16, l == 0 ? WS_WO : WS_WO_L1) + (size_t)(nb * 64) * D; c.Kdst = D; c.k0 = kb * 64; return c; } r -= J4;
    if (r < J5 + J6) { const int up = r >= J5; if (up) r -= J5; const int e = r / 512, q = r % 512, kb = q / 64, nb = q % 64, col = nb * 32;
        c.W = (up ? F.in[I_WUE] : F.in[I_WGE]) + ((size_t)l * NE + e) * D * DFF + col; c.pitch = DFF; c.f8 = 1;
        c.WT = (bf16*)(F.ws + (l == 0 ? WS_WGU : WS_WGU_L1) + (size_t)((e * 16 + (col >> 7)) * 256 + up * 128 + (col & 127)) * D); c.Kdst = D; c.k0 = kb * 128; return c; } r -= J5 + J6;
    { const int e = r / 512, q = r % 512, kb = q / 32, nb = q % 32;
      c.W = F.in[I_WDE] + ((size_t)l * NE + e) * DFF * D + nb * 32; c.pitch = D; c.f8 = 1; c.WT = (bf16*)(F.ws + (l == 0 ? WS_WD : WS_WD_L1) + (size_t)(e * 1024 + nb * 32) * DFF); c.Kdst = DFF; c.k0 = kb * 128; return c; }
}
constexpr int CV_GU0 = 16 * 32 + 16 * 56 + 8 * 16 + 8 * 16 + 16 * 16, CV_GU1 = CV_GU0 + 2 * 16 * 16 * 32, CV_NITEMS = CV_GU1 + 16 * 32 * 16;
__device__ __forceinline__ void cv_run(Frame& F, int l, int lane, LAS float* scr, int first, int count, int wi, int nw) {
    f32x4 va[16], vb[16];
    int it = wi;
    if (it >= count) return;
    CvItem ca = cv_decode(F, l, first + it), cbn = ca;
    cv_load(ca, lane, va);
#pragma unroll 1
    for (;;) {
        const bool hb = (it + nw < count);
        if (hb) { cbn = cv_decode(F, l, first + it + nw); cv_load(cbn, lane, vb); }
        cv_store(ca, lane, va, scr);
        if (!hb) break;
        it += nw;
        const bool ha = (it + nw < count);
        if (ha) { ca = cv_decode(F, l, first + it + nw); cv_load(ca, lane, va); }
        cv_store(cbn, lane, vb, scr);
        if (!ha) break;
        it += nw;
    }
}
constexpr int CV_WIN = 16 * 32 + 16 * 56;
__device__ __forceinline__ void ph_convert(Frame& F, int l) {
    PH_IDS;
    LAS float* scr = (LAS float*)(F.lds + wave * 16384);
    const int gw = F.bx * NWAVES + wave, NGW = F.G * NWAVES;
    cv_run(F, l, lane, scr, 0, CV_WIN, gw, NGW);
}

__device__ __forceinline__ void stage_w16(int tid, LAS float* w16, const float* src, int pitch) {
    __syncthreads();
    f32x4 w[8];
#pragma unroll
    for (int n = 0; n < 8; ++n) { const int i = tid + NTHREADS * n, k = i >> 2, q = i & 3; w[n] = *(const f32x4*)(src + (size_t)k * pitch + q * 4); }
#pragma unroll
    for (int n = 0; n < 8; ++n) { const int i = tid + NTHREADS * n, k = i >> 2, q = i & 3; *(LAS f32x4*)(w16 + ((((k >> 8) * 4 + (k & 3)) * 4 + q) * 64 + ((k & 255) >> 2)) * 4) = w[n]; }
    __syncthreads();
}
template <int N> __device__ __forceinline__ float row_ror_add(float x) { return x + __int_as_float(__builtin_amdgcn_update_dpp(0, __float_as_int(x), 0x120 + N, 0xf, 0xf, false)); }
template <int N> __device__ __forceinline__ float row_ror_max(float x) { return fmaxf(x, __int_as_float(__builtin_amdgcn_update_dpp(0, __float_as_int(x), 0x120 + N, 0xf, 0xf, false))); }
__device__ __forceinline__ float xrow_sum(float v) {
    auto a = __builtin_amdgcn_permlane16_swap(__float_as_uint(v), __float_as_uint(v), false, false); v = __uint_as_float(a[0]) + __uint_as_float(a[1]);
    auto b = __builtin_amdgcn_permlane32_swap(__float_as_uint(v), __float_as_uint(v), false, false); return __uint_as_float(b[0]) + __uint_as_float(b[1]); }
__device__ __forceinline__ float xrow_max(float v) {
    auto a = __builtin_amdgcn_permlane16_swap(__float_as_uint(v), __float_as_uint(v), false, false); v = fmaxf(__uint_as_float(a[0]), __uint_as_float(a[1]));
    auto b = __builtin_amdgcn_permlane32_swap(__float_as_uint(v), __float_as_uint(v), false, false); return fmaxf(__uint_as_float(b[0]), __uint_as_float(b[1])); }
__device__ __forceinline__ float wave_sum_fast(float v) { v = row_ror_add<8>(v); v = row_ror_add<4>(v); v = row_ror_add<2>(v); v = row_ror_add<1>(v); return xrow_sum(v); }
template <int R> __device__ __forceinline__ void proj16(const f32x4 (&h)[R][4], const LAS float* w16, int lane, float (&t)[R][4]) {
    float p[R][16];
#pragma unroll
    for (int r = 0; r < R; ++r)
#pragma unroll
        for (int j = 0; j < 16; ++j) p[r][j] = 0.f;
    int lane4 = 4 * lane; asm volatile("" : "+v"(lane4) : "v"(h[0][0][0]), "v"(h[R - 1][0][0]));
#pragma unroll
    for (int jj = 0; jj < 4; ++jj)
#pragma unroll
        for (int c = 0; c < 4; ++c) {
#pragma unroll
            for (int q = 0; q < 4; ++q) { const f32x4 w = *(const LAS f32x4*)(w16 + ((jj * 4 + c) * 4 + q) * 256 + lane4);
#pragma unroll
                for (int r = 0; r < R; ++r) { const float hv = h[r][jj][c]; p[r][4 * q + 0] += hv * w.x; p[r][4 * q + 1] += hv * w.y; p[r][4 * q + 2] += hv * w.z; p[r][4 * q + 3] += hv * w.w; } }
            if (c & 1) {
#pragma unroll
                for (int r = 0; r < R; ++r) asm volatile("" : "+v"(p[r][0]), "+v"(p[r][1]), "+v"(p[r][2]), "+v"(p[r][3]), "+v"(p[r][4]), "+v"(p[r][5]), "+v"(p[r][6]), "+v"(p[r][7]), "+v"(p[r][8]), "+v"(p[r][9]), "+v"(p[r][10]), "+v"(p[r][11]), "+v"(p[r][12]), "+v"(p[r][13]), "+v"(p[r][14]), "+v"(p[r][15]) :: "memory"); } }
#pragma unroll
    for (int r = 0; r < R; ++r) {
        float q8[8];
#pragma unroll
        for (int j = 0; j < 8; ++j) { auto rr = __builtin_amdgcn_permlane32_swap(__float_as_uint(p[r][j]), __float_as_uint(p[r][j + 8]), false, false); q8[j] = __uint_as_float(rr[0]) + __uint_as_float(rr[1]); }
#pragma unroll
        for (int m = 0; m < 4; ++m) { auto rr = __builtin_amdgcn_permlane16_swap(__float_as_uint(q8[m]), __float_as_uint(q8[m + 4]), false, false); float v = __uint_as_float(rr[0]) + __uint_as_float(rr[1]);
            v = row_ror_add<8>(v); v = row_ror_add<4>(v); v = row_ror_add<2>(v); v = row_ror_add<1>(v); t[r][m] = v; } }
}
__device__ __forceinline__ f32x4 ldx4(const bf16* p) { const v2u w = *(const v2u*)p; return (f32x4){bflo(w.x), bfhi(w.x), bflo(w.y), bfhi(w.y)}; }
__device__ __forceinline__ void store_bf16_row(bf16* dst, const f32x4 (&h)[4], int lane) {
#pragma unroll
    for (int j = 0; j < 4; ++j) { v2u o; o.x = pk2(h[j].x, h[j].y); o.y = pk2(h[j].z, h[j].w); *(v2u*)(dst + 256 * j + 4 * lane) = o; }
}
__device__ __forceinline__ void rms_row(const f32x4 (&v)[4], const float* g, int lane, f32x4 (&h)[4]) {
    float s = 0.f;
#pragma unroll
    for (int j = 0; j < 4; ++j) s += (v[j].x * v[j].x + v[j].y * v[j].y) + (v[j].z * v[j].z + v[j].w * v[j].w);
    const float rstd = 1.0f / sqrtf(wave_sum_fast(s) * (1.0f / D) + EPS);
#pragma unroll
    for (int j = 0; j < 4; ++j) { const f32x4 gg = *(const f32x4*)(g + 256 * j + 4 * lane); h[j] = v[j] * rstd * gg; }
}
template <int R> __device__ __forceinline__ void prep1_rows(Frame& F, int lane, int l, int row0, int rstep, const f32x4 (&v)[R][4]) {
    f32x4 h[R][4];
#pragma unroll
    for (int r = 0; r < R; ++r) { rms_row(v[r], F.in[I_NMG] + (size_t)l * D, lane, h[r]); store_bf16_row(WSP(bf16, WS_XB) + (size_t)(row0 + r * rstep) * D, h[r], lane);
#pragma unroll
        for (int j = 0; j < 4; ++j) *(unsigned*)(F.ws + WS_MIX + (size_t)(row0 + r * rstep) * D + 256 * j + 4 * lane) = pg8::pk4_fp8(h[r][j].x, h[r][j].y, h[r][j].z, h[r][j].w); }
}
__device__ __forceinline__ void ph_prep_first(Frame& F) {
    PH_IDS;
    const int gw = F.bx * NWAVES + wave, NGW = F.G * NWAVES;
    f32x4 v[2][4];
#pragma unroll
    for (int r = 0; r < 2; ++r)
#pragma unroll
        for (int j = 0; j < 4; ++j) v[r][j] = *(const f32x4*)(F.in[I_X] + (size_t)(gw + r * NGW) * D + 256 * j + 4 * lane);
#pragma unroll 1
    for (int row = gw; row < T; row += 2 * NGW) {
        f32x4 vn[2][4];
        const int nrow = (row + 2 * NGW < T) ? row + 2 * NGW : row;
#pragma unroll
        for (int r = 0; r < 2; ++r)
#pragma unroll
            for (int j = 0; j < 4; ++j) { vn[r][j] = *(const f32x4*)(F.in[I_X] + (size_t)(nrow + r * NGW) * D + 256 * j + 4 * lane); { v2u o; o.x = pk2(v[r][j].x, v[r][j].y); o.y = pk2(v[r][j].z, v[r][j].w); *(v2u*)(WSP(bf16, WS_XR) + (size_t)(row + r * NGW) * D + 256 * j + 4 * lane) = o; } }
        prep1_rows<2>(F, lane, 0, row, NGW, v);
#pragma unroll
        for (int r = 0; r < 2; ++r)
#pragma unroll
            for (int j = 0; j < 4; ++j) v[r][j] = vn[r][j];
    }
    __syncthreads();
}
__device__ __forceinline__ void stage_wmf(int tid, LAS unsigned char* img, const float* src, int pitch, const float* g) {
    __syncthreads();
    for (int idx = tid; idx < 32 * 64; idx += NTHREADS) { const int s = idx >> 6, ln = idx & 63, j = ln & 15, q = ln >> 4;
        unsigned hi[4], lo[4];
#pragma unroll
        for (int t2 = 0; t2 < 4; ++t2) { const int k = 32 * s + 8 * q + 2 * t2;
            const float w0 = src[(size_t)k * pitch + j] * g[k], w1 = src[(size_t)(k + 1) * pitch + j] * g[k + 1];
            const unsigned h0 = f2bf(w0), h1 = f2bf(w1); hi[t2] = h0 | (h1 << 16);
            lo[t2] = f2bf(w0 - bf2f((unsigned short)h0)) | (f2bf(w1 - bf2f((unsigned short)h1)) << 16); }
        *(LAS v4u*)(img + ((s * 2 + 0) * 64 + ln) * 16) = (v4u){hi[0], hi[1], hi[2], hi[3]};
        *(LAS v4u*)(img + ((s * 2 + 1) * 64 + ln) * 16) = (v4u){lo[0], lo[1], lo[2], lo[3]}; }
    __syncthreads();
}
__device__ __forceinline__ void ph_prep2(Frame& F, int l) {
    PH_IDS;
    LAS unsigned char* img = (LAS unsigned char*)(F.lds + 0);
    stage_wmf(tid, img, F.in[I_WR] + (size_t)l * D * NE, NE, F.in[I_NFG] + (size_t)l * D);
    const int gw = F.bx * NWAVES + wave, NGW = F.G * NWAVES;
#pragma unroll 1
    for (int grp = gw; grp < T / 16; grp += NGW) {
        const int i = lane & 15, q = lane >> 4;
        const bf16* xp = WSP(bf16, WS_XR) + (size_t)(grp * 16 + i) * D + 8 * q;
        float zf = 0.f; asm volatile("" : "+v"(zf));
        f32x4 acc = (f32x4){zf, zf, zf, zf}; float ssq = 0.f;
#pragma unroll 1
        for (int sb = 0; sb < 32; sb += 8) {
            v4u a[8];
#pragma unroll
            for (int u = 0; u < 8; ++u) a[u] = *(const v4u*)(xp + 32 * (sb + u));
#pragma unroll
            for (int u = 0; u < 8; ++u) { const bf16x8 bh = *(const LAS bf16x8*)(img + (((sb + u) * 2 + 0) * 64 + lane) * 16), bl = *(const LAS bf16x8*)(img + (((sb + u) * 2 + 1) * 64 + lane) * 16);
                const bf16x8 av = __builtin_bit_cast(bf16x8, a[u]);
                acc = __builtin_amdgcn_mfma_f32_16x16x32_bf16(av, bh, acc, 0, 0, 0); acc = __builtin_amdgcn_mfma_f32_16x16x32_bf16(av, bl, acc, 0, 0, 0);
                const float x0 = bflo(a[u].x), x1 = bfhi(a[u].x), x2 = bflo(a[u].y), x3 = bfhi(a[u].y), x4 = bflo(a[u].z), x5 = bfhi(a[u].z), x6 = bflo(a[u].w), x7 = bfhi(a[u].w);
                ssq += (x0 * x0 + x1 * x1) + (x2 * x2 + x3 * x3) + ((x4 * x4 + x5 * x5) + (x6 * x6 + x7 * x7)); }
        }
        ssq = xrow_sum(ssq);
        const float rstd = 1.0f / sqrtf(ssq * (1.0f / D) + EPS);
#pragma unroll
        for (int r = 0; r < 4; ++r) { float t = acc[r] * __int_as_float(__builtin_amdgcn_ds_bpermute((4 * q + r) * 4, __float_as_int(rstd)));
            float mx = row_ror_max<8>(t); mx = row_ror_max<4>(mx); mx = row_ror_max<2>(mx); mx = row_ror_max<1>(mx);
            const float e = __expf(t - mx);
            float se = row_ror_add<8>(e); se = row_ror_add<4>(se); se = row_ror_add<2>(se); se = row_ror_add<1>(se);
            WSP(float, WS_AFF)[(size_t)(grp * 16 + 4 * q + r) * 16 + i] = e / se; }
    }
    f32x4 v[2][4];
#pragma unroll
    for (int r = 0; r < 2; ++r)
#pragma unroll
        for (int j = 0; j < 4; ++j) v[r][j] = ldx4(WSP(bf16, WS_XR) + (size_t)(gw + r * NGW) * D + 256 * j + 4 * lane);
#pragma unroll 1
    for (int row = gw; row < T; row += 2 * NGW) {
        f32x4 vn[2][4], h[2][4];
        const int nrow = (row + 2 * NGW < T) ? row + 2 * NGW : row;
#pragma unroll
        for (int r = 0; r < 2; ++r)
#pragma unroll
            for (int j = 0; j < 4; ++j) vn[r][j] = ldx4(WSP(bf16, WS_XR) + (size_t)(nrow + r * NGW) * D + 256 * j + 4 * lane);
#pragma unroll
        for (int r = 0; r < 2; ++r) { rms_row(v[r], F.in[I_NFG] + (size_t)l * D, lane, h[r]);
#pragma unroll
            for (int j = 0; j < 4; ++j) *(unsigned*)(F.ws + WS_XB + (size_t)(row + r * NGW) * D + 256 * j + 4 * lane) = pg8::pk4_fp8(h[r][j].x, h[r][j].y, h[r][j].z, h[r][j].w); }
#pragma unroll
        for (int r = 0; r < 2; ++r)
#pragma unroll
            for (int j = 0; j < 4; ++j) v[r][j] = vn[r][j];
    }
    __syncthreads();
}
__device__ __forceinline__ void ph_mgate(Frame& F, int l) {
    PH_IDS;
    LAS unsigned char* img = (LAS unsigned char*)(F.lds + 0);
    stage_wmf(tid, img, F.in[I_WIN] + (size_t)l * D * IN_COLS + OFF_MG, IN_COLS, F.in[I_NMG] + (size_t)l * D);
    const int gw = F.bx * NWAVES + wave, NGW = F.G * NWAVES;
#pragma unroll 1
    for (int grp = gw; grp < T / 16; grp += NGW) {
        const int i = lane & 15, q = lane >> 4;
        const bf16* xp = WSP(bf16, WS_XR) + (size_t)(grp * 16 + i) * D + 8 * q;
        float zf = 0.f; asm volatile("" : "+v"(zf));
        f32x4 acc = (f32x4){zf, zf, zf, zf}; float ssq = 0.f;
#pragma unroll 1
        for (int sb = 0; sb < 32; sb += 8) {
            v4u a[8];
#pragma unroll
            for (int u = 0; u < 8; ++u) a[u] = *(const v4u*)(xp + 32 * (sb + u));
#pragma unroll
            for (int u = 0; u < 8; ++u) { const bf16x8 bh = *(const LAS bf16x8*)(img + (((sb + u) * 2 + 0) * 64 + lane) * 16), bl = *(const LAS bf16x8*)(img + (((sb + u) * 2 + 1) * 64 + lane) * 16);
                const bf16x8 av = __builtin_bit_cast(bf16x8, a[u]);
                acc = __builtin_amdgcn_mfma_f32_16x16x32_bf16(av, bh, acc, 0, 0, 0); acc = __builtin_amdgcn_mfma_f32_16x16x32_bf16(av, bl, acc, 0, 0, 0);
                const float x0 = bflo(a[u].x), x1 = bfhi(a[u].x), x2 = bflo(a[u].y), x3 = bfhi(a[u].y), x4 = bflo(a[u].z), x5 = bfhi(a[u].z), x6 = bflo(a[u].w), x7 = bfhi(a[u].w);
                ssq += (x0 * x0 + x1 * x1) + (x2 * x2 + x3 * x3) + ((x4 * x4 + x5 * x5) + (x6 * x6 + x7 * x7)); }
        }
        ssq = xrow_sum(ssq);
        const float rstd = 1.0f / sqrtf(ssq * (1.0f / D) + EPS);
        const float bm = F.in[I_BMG][l * 16 + i];
#pragma unroll
        for (int r = 0; r < 4; ++r) WSP(float, WS_MG)[(size_t)(grp * 16 + 4 * q + r) * 16 + i] = acc[r] * __int_as_float(__builtin_amdgcn_ds_bpermute((4 * q + r) * 4, __float_as_int(rstd))) + bm;
    }
    __syncthreads();
}
__device__ __forceinline__ void ph_topk(Frame& F) {
    PH_IDS;
    LAS unsigned long long* keys = (LAS unsigned long long*)(F.lds + 0);
    for (int item = F.bx; item < BATCH * NE; item += F.G) {
        const int b = item >> 4, e = item & 15;
        __syncthreads();
        for (int s = tid; s < SEQ; s += NTHREADS) { const float v = WSP(float, WS_AFF)[((size_t)b * SEQ + s) * 16 + e];
            keys[s] = ((unsigned long long)__float_as_uint(v) << 32) | (unsigned long long)(0xFFFFFFFFu - (unsigned)s);
            WSP(int, WS_INV)[((size_t)b * SEQ + s) * 16 + e] = -1; }
        __syncthreads();
        for (int k = 2; k <= SEQ; k <<= 1)
            for (int j = k >> 1; j > 0; j >>= 1) {
#pragma unroll
                for (int pp = 0; pp < 2; ++pp) { const int p = tid + NTHREADS * pp; const int i = ((p & ~(j - 1)) << 1) | (p & (j - 1)), ix = i | j;
                    const unsigned long long x = keys[i], y = keys[ix]; const bool up = ((i & k) == 0);
                    if ((x < y) == up) { keys[i] = y; keys[ix] = x; } }
                __syncthreads();
            }
        if (tid < CAP) { const unsigned long long kk = keys[tid]; const int s = (int)(0xFFFFFFFFu - (unsigned)(kk & 0xFFFFFFFFull));
            WSP(int, WS_IDX)[item * CAP + tid] = b * SEQ + s; WSP(float, WS_GATEV)[item * CAP + tid] = __uint_as_float((unsigned)(kk >> 32)); }
        asm volatile("s_waitcnt vmcnt(0)" ::: "memory");
        __syncthreads();
        if (tid < CAP) { const unsigned long long kk = keys[tid]; const int s = (int)(0xFFFFFFFFu - (unsigned)(kk & 0xFFFFFFFFull)); WSP(int, WS_INV)[((size_t)b * SEQ + s) * 16 + e] = tid; }
    }
    __syncthreads();
}
__device__ __forceinline__ void ph_combine(Frame& F, int l) {
    PH_IDS;
    const bool lastl = (l + 1 == DEPTH);
    const int gw = F.bx * NWAVES + wave, NGW = F.G * NWAVES;
    f32x4 v[2][4]; int myinv[2];
#pragma unroll
    for (int r = 0; r < 2; ++r) { myinv[r] = WSP(int, WS_INV)[(size_t)(gw + r * NGW) * 16 + (lane & 15)];
#pragma unroll
        for (int j = 0; j < 4; ++j) v[r][j] = ldx4(WSP(bf16, WS_XR) + (size_t)(gw + r * NGW) * D + 256 * j + 4 * lane); }
#pragma unroll 1
    for (int row = gw; row < T; row += 2 * NGW) {
        f32x4 vn[2][4]; int ninv[2];
        const int nrow = (row + 2 * NGW < T) ? row + 2 * NGW : row;
#pragma unroll
        for (int r = 0; r < 2; ++r) { ninv[r] = WSP(int, WS_INV)[(size_t)(nrow + r * NGW) * 16 + (lane & 15)];
#pragma unroll
            for (int j = 0; j < 4; ++j) vn[r][j] = ldx4(WSP(bf16, WS_XR) + (size_t)(nrow + r * NGW) * D + 256 * j + 4 * lane); }
        v2u y[2][4][4]; float fl[2][4]; unsigned rest[2];
#pragma unroll
        for (int r = 0; r < 2; ++r) { const int b = (row + r * NGW) / SEQ;
            unsigned mask = (unsigned)__builtin_amdgcn_ballot_w64(myinv[r] >= 0) & 0xffffu;
#pragma unroll
            for (int k = 0; k < 4; ++k) { const bool hit = mask != 0u; const int e = hit ? __builtin_ctz(mask) : 0; const int sl = __builtin_amdgcn_readlane(myinv[r], e);
                const bf16* yr = WSP(bf16, WS_YE) + ((size_t)(b * 16 + e) * CAP + (hit ? sl : 0)) * D; fl[r][k] = hit ? 1.0f : 0.0f; mask &= mask - 1u;
#pragma unroll
                for (int j = 0; j < 4; ++j) y[r][k][j] = *(const v2u*)(yr + 256 * j + 4 * lane); }
            rest[r] = mask; }
#pragma unroll
        for (int r = 0; r < 2; ++r) {
#pragma unroll
            for (int k = 0; k < 4; ++k)
#pragma unroll
                for (int j = 0; j < 4; ++j) { const v2u yy = y[r][k][j]; const float f = fl[r][k]; v[r][j].x += f * bflo(yy.x); v[r][j].y += f * bfhi(yy.x); v[r][j].z += f * bflo(yy.y); v[r][j].w += f * bfhi(yy.y); }
            unsigned mask = rest[r]; const int b = (row + r * NGW) / SEQ;
            while (mask) { const int e = __builtin_ctz(mask); mask &= mask - 1u; const int sl = __builtin_amdgcn_readlane(myinv[r], e);
                const bf16* yr = WSP(bf16, WS_YE) + ((size_t)(b * 16 + e) * CAP + sl) * D;
#pragma unroll
                for (int j = 0; j < 4; ++j) { const v2u yy = *(const v2u*)(yr + 256 * j + 4 * lane); v[r][j].x += bflo(yy.x); v[r][j].y += bfhi(yy.x); v[r][j].z += bflo(yy.y); v[r][j].w += bfhi(yy.y); } } }
        if (!lastl) {
#pragma unroll
            for (int r = 0; r < 2; ++r)
#pragma unroll
                for (int j = 0; j < 4; ++j) { v2u o; o.x = pk2(v[r][j].x, v[r][j].y); o.y = pk2(v[r][j].z, v[r][j].w); *(v2u*)(WSP(bf16, WS_XR) + (size_t)(row + r * NGW) * D + 256 * j + 4 * lane) = o; }
            prep1_rows<2>(F, lane, l + 1, row, NGW, v);
        } else {
#pragma unroll
            for (int r = 0; r < 2; ++r) { f32x4 h[4]; rms_row(v[r], F.in[I_NF], lane, h);
#pragma unroll
                for (int j = 0; j < 4; ++j) *(f32x4*)(F.X + (size_t)(row + r * NGW) * D + 256 * j + 4 * lane) = h[j]; } }
#pragma unroll
        for (int r = 0; r < 2; ++r) { myinv[r] = ninv[r];
#pragma unroll
            for (int j = 0; j < 4; ++j) v[r][j] = vn[r][j]; }
    }
    __syncthreads();
}

__device__ __forceinline__ void ph_mlstm_naive(Frame& F, int l) {
    PH_IDS;
    constexpr int TB = 64;
    LAS float* qs = (LAS float*)(F.lds + 0);
    LAS float* ks = (LAS float*)(F.lds + 32768);
    LAS float* vs = (LAS float*)(F.lds + 65536);
    LAS float* gl = (LAS float*)(F.lds + 98304);
    const float* cw = F.in[I_CW] + (size_t)l * CONVW * 2 * MW; const float* cb = F.in[I_CB] + (size_t)l * 2 * MW;
    const bf16* zqk = WSP(bf16, WS_ZQK); const bf16* zmv = WSP(bf16, WS_ZMV); const float* mg = WSP(float, WS_MG);
    for (int item = F.bx; item < BATCH * MH * 2; item += F.G) {
        const int dir = item & 1, h = (item >> 1) & 3, b = item >> 3;
        float* outp = WSP(float, dir ? WS_HB : WS_HF);
        const int v = tid >> 2, kq = tid & 3;
        float C[32], n[32];
#pragma unroll
        for (int i = 0; i < 32; ++i) { C[i] = 0.f; n[i] = 0.f; }
        float m = 0.f;
        for (int blk = 0; blk < SEQ / TB; ++blk) {
            const int ta = dir ? (SEQ - TB - blk * TB) : blk * TB;
            __syncthreads();
            for (int i = tid; i < TB * 256; i += NTHREADS) { const int tt = i >> 8, c = i & 255; const int col = (c < 128) ? (h * 128 + c) : (512 + h * 128 + (c - 128));
                float a = cb[col];
#pragma unroll
                for (int j = 0; j < CONVW; ++j) { const int ts = ta + tt + j - 2; if (ts >= 0 && ts < SEQ) a += cw[j * 2 * MW + col] * bf2f(zqk[((size_t)b * SEQ + ts) * 1024 + col]); }
                a = a * sigmoidf_(a);
                if (c < 128) qs[tt * 128 + c] = a; else ks[tt * 128 + (c - 128)] = a * 0.08838834764831845f; }
            for (int i = tid; i < TB * 128; i += NTHREADS) { const int tt = i >> 7, c = i & 127; vs[i] = bf2f(zmv[((size_t)b * SEQ + ta + tt) * 512 + h * 128 + c]); }
            if (tid < TB) { const float ip = mg[((size_t)b * SEQ + ta + tid) * 16 + dir * 8 + h], fp = mg[((size_t)b * SEQ + ta + tid) * 16 + dir * 8 + 4 + h];
                gl[tid * 2 + 0] = fminf(fp, 0.f) - log1pf(__expf(-fabsf(fp))); gl[tid * 2 + 1] = ip; }
            __syncthreads();
            for (int u = 0; u < TB; ++u) {
                const int tt = dir ? (TB - 1 - u) : u;
                const float lf = gl[tt * 2], li = gl[tt * 2 + 1];
                const float mn = fmaxf(lf + m, li), fs = __expf(lf + m - mn), is = __expf(li - mn); m = mn;
                const float iv = is * vs[tt * 128 + v];
                float hp = 0.f, dp = 0.f;
#pragma unroll
                for (int q4 = 0; q4 < 8; ++q4) { const f32x4 kx = *(const LAS f32x4*)(ks + tt * 128 + kq * 32 + q4 * 4), qx = *(const LAS f32x4*)(qs + tt * 128 + kq * 32 + q4 * 4);
#pragma unroll
                    for (int c = 0; c < 4; ++c) { const int i = q4 * 4 + c; C[i] = fs * C[i] + iv * kx[c]; n[i] = fs * n[i] + is * kx[c]; hp += C[i] * qx[c]; dp += n[i] * qx[c]; } }
                hp += __shfl_xor(hp, 1); hp += __shfl_xor(hp, 2); dp += __shfl_xor(dp, 1); dp += __shfl_xor(dp, 2);
                if (kq == 0) outp[((size_t)b * SEQ + ta + tt) * 512 + h * 128 + v] = hp / fmaxf(fabsf(dp), __expf(-m));
            }
        }
    }
    __syncthreads();
}
__device__ __forceinline__ void ph_mnorm(Frame& F, int l) {
    PH_IDS;
    const int gw = F.bx * NWAVES + wave, NGW = F.G * NWAVES;
    const float* ng = F.in[I_MNG] + (size_t)l * MW + 8 * lane;
    const f32x4 g0 = *(const f32x4*)ng, g1 = *(const f32x4*)(ng + 4);
    for (int tk = gw; tk < T; tk += NGW) {
        const size_t off = (size_t)tk * 512 + 8 * lane;
        const v4u af = *(const v4u*)(WSP(bf16, WS_HF) + off), ab = *(const v4u*)(WSP(bf16, WS_HB) + off);
        const f32x4 a0 = (f32x4){bflo(af.x), bfhi(af.x), bflo(af.y), bfhi(af.y)}, a1 = (f32x4){bflo(af.z), bfhi(af.z), bflo(af.w), bfhi(af.w)}, b0 = (f32x4){bflo(ab.x), bfhi(ab.x), bflo(ab.y), bfhi(ab.y)}, b1 = (f32x4){bflo(ab.z), bfhi(ab.z), bflo(ab.w), bfhi(ab.w)};
        const v4u o = *(const v4u*)(WSP(bf16, WS_ZMO) + off);
        f32x4 x0 = a0 + b0, x1 = a1 + b1;
        float sm = (x0.x + x0.y) + (x0.z + x0.w) + (x1.x + x1.y) + (x1.z + x1.w);
        sm = row_ror_add<8>(sm); sm = row_ror_add<4>(sm); sm = row_ror_add<2>(sm); sm = row_ror_add<1>(sm);
        const float mu = sm * (1.0f / 128.0f);
        x0 = x0 - mu; x1 = x1 - mu;
        float vs = (x0.x * x0.x + x0.y * x0.y) + (x0.z * x0.z + x0.w * x0.w) + (x1.x * x1.x + x1.y * x1.y) + (x1.z * x1.z + x1.w * x1.w);
        vs = row_ror_add<8>(vs); vs = row_ror_add<4>(vs); vs = row_ror_add<2>(vs); vs = row_ror_add<1>(vs);
        const float rs = 1.0f / sqrtf(vs * (1.0f / 128.0f) + EPS);
        v4u w; w.x = pk2(x0.x * rs * g0.x * bflo(o.x), x0.y * rs * g0.y * bfhi(o.x)); w.y = pk2(x0.z * rs * g0.z * bflo(o.y), x0.w * rs * g0.w * bfhi(o.y));
        w.z = pk2(x1.x * rs * g1.x * bflo(o.z), x1.y * rs * g1.y * bfhi(o.z)); w.w = pk2(x1.z * rs * g1.z * bflo(o.w), x1.w * rs * g1.w * bfhi(o.w));
        *(v4u*)(WSP(bf16, WS_HM) + (size_t)tk * 1024 + 8 * lane) = w;
    }
}
__device__ __forceinline__ void ph_attn_naive(Frame& F, int l) {
    PH_IDS;
    LAS float* Ks = (LAS float*)(F.lds + 0);
    LAS float* Vs = (LAS float*)(F.lds + 32768);
    LAS float* Os = (LAS float*)(F.lds + 65536);
    const float lam_init = __uint_as_float(__builtin_amdgcn_readfirstlane(__float_as_uint(0.8f - 0.6f * __expf(-0.3f * (float)l))));
    const float* lam = F.in[I_LAM] + (size_t)l * 4 * ADH;
    const float s01 = wave_sum(lam[lane] * lam[64 + lane]), s23 = wave_sum(lam[128 + lane] * lam[192 + lane]);
    const float lam_full = __expf(s01) - __expf(s23) + lam_init;
    const float* ng = F.in[I_DNG] + (size_t)l * ADV;
    const bf16* zdq = WSP(bf16, WS_ZDQ); const bf16* zdk = WSP(bf16, WS_ZDK); const bf16* zdv = WSP(bf16, WS_ZDV);
    const int r = tid & 63, part = tid >> 6, hi = part >> 2, dq = part & 3;
    for (int unit = F.bx; unit < BATCH * AH * (SEQ / 64); unit += F.G) {
        const int qb = unit & 31, h = (unit >> 5) & 3, b = unit >> 7;
        const int tq = qb * 64 + r;
        const float slope2 = __builtin_amdgcn_exp2f(-2.0f * (float)(h + 1)) * LOG2E;
        float q[64];
        { const bf16* qp = zdq + ((size_t)b * SEQ + tq) * 512 + h * 128 + hi * 64;
#pragma unroll
          for (int d8 = 0; d8 < 8; ++d8) { const v4u w = *(const v4u*)(qp + d8 * 8); q[d8 * 8 + 0] = bflo(w.x); q[d8 * 8 + 1] = bfhi(w.x); q[d8 * 8 + 2] = bflo(w.y); q[d8 * 8 + 3] = bfhi(w.y);
              q[d8 * 8 + 4] = bflo(w.z); q[d8 * 8 + 5] = bfhi(w.z); q[d8 * 8 + 6] = bflo(w.w); q[d8 * 8 + 7] = bfhi(w.w); } }
        float o[32];
#pragma unroll
        for (int c = 0; c < 32; ++c) o[c] = 0.f;
        float m = -1e30f, lsum = 0.f;
        for (int kt = 0; kt < SEQ / 64; ++kt) {
            __syncthreads();
            for (int i = tid; i < 64 * 16; i += NTHREADS) { const int kr = i >> 4, c8 = i & 15; const size_t g = ((size_t)b * SEQ + kt * 64 + kr) * 512 + h * 128 + c8 * 8;
                const v4u kw = *(const v4u*)(zdk + g), vw = *(const v4u*)(zdv + g);
                LAS float* kd = Ks + kr * 128 + c8 * 8; LAS float* vd = Vs + kr * 128 + c8 * 8;
                kd[0] = bflo(kw.x); kd[1] = bfhi(kw.x); kd[2] = bflo(kw.y); kd[3] = bfhi(kw.y); kd[4] = bflo(kw.z); kd[5] = bfhi(kw.z); kd[6] = bflo(kw.w); kd[7] = bfhi(kw.w);
                vd[0] = bflo(vw.x); vd[1] = bfhi(vw.x); vd[2] = bflo(vw.y); vd[3] = bfhi(vw.y); vd[4] = bflo(vw.z); vd[5] = bfhi(vw.z); vd[6] = bflo(vw.w); vd[7] = bfhi(vw.w); }
            __syncthreads();
            for (int j = 0; j < 64; ++j) {
                float s = 0.f;
#pragma unroll
                for (int d4 = 0; d4 < 16; ++d4) { const f32x4 kx = *(const LAS f32x4*)(Ks + j * 128 + hi * 64 + d4 * 4); s += q[d4 * 4] * kx.x + q[d4 * 4 + 1] * kx.y + q[d4 * 4 + 2] * kx.z + q[d4 * 4 + 3] * kx.w; }
                s -= slope2 * fabsf((float)(tq - (kt * 64 + j)));
                if (s > m) { const float corr = __builtin_amdgcn_exp2f(m - s); lsum *= corr;
#pragma unroll
                    for (int c = 0; c < 32; ++c) o[c] *= corr;
                    m = s; }
                const float p = __builtin_amdgcn_exp2f(s - m); lsum += p;
#pragma unroll
                for (int c4 = 0; c4 < 8; ++c4) { const f32x4 vx = *(const LAS f32x4*)(Vs + j * 128 + dq * 32 + c4 * 4); o[c4 * 4] += p * vx.x; o[c4 * 4 + 1] += p * vx.y; o[c4 * 4 + 2] += p * vx.z; o[c4 * 4 + 3] += p * vx.w; }
            }
        }
        __syncthreads();
        { const float il = 1.0f / lsum;
#pragma unroll
          for (int c = 0; c < 32; ++c) Os[(r * 2 + hi) * 128 + dq * 32 + c] = o[c] * il; }
        __syncthreads();
        float dv[16]; float ss = 0.f;
#pragma unroll
        for (int c = 0; c < 16; ++c) { dv[c] = Os[(r * 2 + 0) * 128 + part * 16 + c] - lam_full * Os[(r * 2 + 1) * 128 + part * 16 + c]; ss += dv[c] * dv[c]; }
        __syncthreads();
        Ks[r * 8 + part] = ss;
        __syncthreads();
        float tot = 0.f;
#pragma unroll
        for (int p8 = 0; p8 < 8; ++p8) tot += Ks[r * 8 + p8];
        const float rs = 1.0f / sqrtf(tot * (1.0f / 128.0f) + EPS) * (1.0f - lam_init);
        bf16* op = WSP(bf16, WS_HD) + ((size_t)b * SEQ + tq) * 512 + h * 128 + part * 16;
        v4u w0, w1;
        w0.x = pk2(dv[0] * rs * ng[part * 16 + 0], dv[1] * rs * ng[part * 16 + 1]); w0.y = pk2(dv[2] * rs * ng[part * 16 + 2], dv[3] * rs * ng[part * 16 + 3]);
        w0.z = pk2(dv[4] * rs * ng[part * 16 + 4], dv[5] * rs * ng[part * 16 + 5]); w0.w = pk2(dv[6] * rs * ng[part * 16 + 6], dv[7] * rs * ng[part * 16 + 7]);
        w1.x = pk2(dv[8] * rs * ng[part * 16 + 8], dv[9] * rs * ng[part * 16 + 9]); w1.y = pk2(dv[10] * rs * ng[part * 16 + 10], dv[11] * rs * ng[part * 16 + 11]);
        w1.z = pk2(dv[12] * rs * ng[part * 16 + 12], dv[13] * rs * ng[part * 16 + 13]); w1.w = pk2(dv[14] * rs * ng[part * 16 + 14], dv[15] * rs * ng[part * 16 + 15]);
        *(v4u*)op = w0; *(v4u*)(op + 8) = w1;
    }
    __syncthreads();
}

namespace attn {
typedef float f32x16 __attribute__((ext_vector_type(16)));
typedef short s16x4 __attribute__((ext_vector_type(4)));
typedef short v4i16_t __attribute__((ext_vector_type(4)));
constexpr int KVT = 64, NT = SEQ / KVT, SLOT = 32768;
__device__ __forceinline__ int crow(int r, int h) { return (r & 3) + 8 * (r >> 2) + 4 * h; }
__device__ __forceinline__ s16x4 vtr(const LAS unsigned char* p) { return __builtin_bit_cast(s16x4, __builtin_amdgcn_ds_read_tr16_b64_v4i16((LAS v4i16_t*)p)); }
__device__ __forceinline__ float max3f(float a, float b, float c) { float r; asm("v_max3_f32 %0, %1, %2, %3" : "=v"(r) : "v"(a), "v"(b), "v"(c)); return r; }
__device__ __forceinline__ float swapmax(float v) { auto rr = __builtin_amdgcn_permlane32_swap(__float_as_uint(v), __float_as_uint(v), false, false); return fmaxf(__uint_as_float(rr[0]), __uint_as_float(rr[1])); }
__device__ __forceinline__ float swapsum(float v) { auto rr = __builtin_amdgcn_permlane32_swap(__float_as_uint(v), __float_as_uint(v), false, false); return __uint_as_float(rr[0]) + __uint_as_float(rr[1]); }
__device__ __forceinline__ unsigned cvtpk(float lo, float hi) { typedef float f2 __attribute__((ext_vector_type(2))); typedef __bf16 b2 __attribute__((ext_vector_type(2))); f2 v = {lo, hi}; b2 b = __builtin_convertvector(v, b2); return __builtin_bit_cast(unsigned, b); }

__device__ __forceinline__ void unit(LAS unsigned char* lds, int tid, int b, int h, int qb, const bf16* zdq, const bf16* zdk, const bf16* zdv, bf16* hd,
                                     const float* ng, float lam_full, unsigned oml) {
    const int lane = tid & 63, wave = __builtin_amdgcn_readfirstlane(tid >> 6), hf = wave >> 2, w4 = wave & 3, r32 = lane & 31, hh = lane >> 5;
    const int tq = qb * 128 + w4 * 32 + r32;
    const float slope2 = __builtin_amdgcn_exp2f(-2.0f * (float)(h + 1)) * LOG2E;
    bf16x8 qf[4];
    { const bf16* qp = zdq + ((size_t)b * SEQ + tq) * 512 + h * 128 + hf * 64 + hh * 8;
#pragma unroll
      for (int ks = 0; ks < 4; ++ks) qf[ks] = *(const bf16x8*)(qp + ks * 16); }
    const char* kg = (const char*)(zdk + (size_t)b * SEQ * 512 + h * 128); const char* vg = (const char*)(zdv + (size_t)b * SEQ * 512 + h * 128);
    unsigned koff[2], voff[2];
#pragma unroll
    for (int e = 0; e < 2; ++e) { const int kv = 8 * wave + 4 * e + (lane >> 4), cc = lane & 15;
        koff[e] = (unsigned)(kv * 1024 + ((cc ^ (kv & 15)) * 16)); voff[e] = (unsigned)(kv * 1024 + ((cc ^ ((kv & 3) << 2)) * 16)); }
    const unsigned ldsa = (unsigned)(uintptr_t)lds;
#define AT_GLDS(gsrc, ldst) do { unsigned _keep; asm volatile("s_mov_b32 %0, m0\n\ts_mov_b32 m0, %2\n\ts_nop 0\n\tglobal_load_lds_dwordx4 %1, off\n\ts_mov_b32 m0, %0" : "=&s"(_keep) : "v"(gsrc), "s"(ldst) : "memory"); } while (0)
#define AT_STAGE(t, slot) do { _Pragma("unroll") for (int _e = 0; _e < 2; ++_e) { \
        const unsigned _kd = (unsigned)__builtin_amdgcn_readfirstlane((int)(ldsa + (slot) * SLOT + (2 * wave + _e) * 1024)); \
        AT_GLDS(kg + (size_t)(t) * (KVT * 1024) + koff[_e], _kd); AT_GLDS(vg + (size_t)(t) * (KVT * 1024) + voff[_e], _kd + 16384u); } } while (0)
    int kx[4], vb[4];
#pragma unroll
    for (int ks = 0; ks < 4; ++ks) kx[ks] = r32 * 256 + (((hf * 8 + 2 * ks + hh) ^ (r32 & 15)) * 16);
    { const int li = lane & 15, q_ = li >> 2, p_ = li & 3, g1 = (lane >> 4) & 1;
#pragma unroll
      for (int db = 0; db < 4; ++db) vb[db] = 16384 + (4 * hh + q_) * 256 + ((((db ^ q_) << 2) + 2 * g1 + (p_ >> 1)) * 16) + (p_ & 1) * 8; }
    f32x16 cc;
#pragma unroll
    for (int r = 0; r < 16; ++r) cc[r] = slope2 * (float)crow(r, hh);
    f32x16 o[4];
#pragma unroll
    for (int db = 0; db < 4; ++db)
#pragma unroll
        for (int r = 0; r < 16; ++r) o[db][r] = 0.f;
    float m = 0.f, l = 0.f;
    int ktd = (qb * 128 + w4 * 32) >> 6;
    const int t0 = 2 * qb;
#define AT_SEQ(i) (((i) < NT - t0) ? t0 + (i) : NT - 1 - (i))
    AT_STAGE(AT_SEQ(0), 0); AT_STAGE(AT_SEQ(1), 1); AT_STAGE(AT_SEQ(2), 2);
    asm volatile("" : "+v"(qf[0]), "+v"(qf[1]), "+v"(qf[2]), "+v"(qf[3]));
    asm volatile("s_waitcnt vmcnt(4)" ::: "memory");
    __builtin_amdgcn_s_barrier();
    if (hf == 1) __builtin_amdgcn_s_barrier();
    asm volatile("" ::: "memory");
    f32x16 s0, s1;
    bf16x8 k0[4], k1[4];
#define AT_KLOAD(slq) do { _Pragma("unroll") for (int ks = 0; ks < 4; ++ks) { k0[ks] = *(const LAS bf16x8*)((slq) + kx[ks]); k1[ks] = *(const LAS bf16x8*)((slq) + kx[ks] + 8192); } } while (0)
#define AT_QK(ktq) do { asm volatile("" : "+s"(ktd)); const bool dg_ = ((ktq) == ktd), lf_ = ((ktq) < ktd); const float sg_ = lf_ ? slope2 : -slope2; \
        { const float z = dg_ ? 0.f : (lf_ ? 1.f : -1.f), cm0 = (dg_ ? 0.f : sg_ * (float)((ktq) * 64 - tq)) - m, cm1 = cm0 + (dg_ ? 0.f : 32.0f * sg_); \
          _Pragma("unroll") for (int r = 0; r < 16; ++r) { s0[r] = cc[r] * z + cm0; s1[r] = cc[r] * z + cm1; } }        \
        __builtin_amdgcn_sched_barrier(0); \
        _Pragma("unroll") for (int ks = 0; ks < 4; ++ks) { s0 = __builtin_amdgcn_mfma_f32_32x32x16_bf16(k0[ks], qf[ks], s0, 0, 0, 0); s1 = __builtin_amdgcn_mfma_f32_32x32x16_bf16(k1[ks], qf[ks], s1, 0, 0, 0); } } while (0)
    AT_KLOAD(lds);
    AT_QK(AT_SEQ(0));
    int slot = 0;
    for (int ti = 0; ti < NT; ++ti) {
        const int kt = AT_SEQ(ti);
        const int s2 = (slot == 0) ? 3 : slot - 1;
        const LAS unsigned char* sl = lds + slot * SLOT;
        if (hf == 1 && ti + 3 < NT) { AT_STAGE(AT_SEQ(ti + 3), s2); }
        asm volatile("" : "+s"(ktd));
        const bool diag = (kt == ktd), left = (kt < ktd);
        (void)left;
        if (diag) {
            const float dq = (float)(tq - kt * 64 - 4 * hh);
#pragma unroll
            for (int r = 0; r < 16; ++r) { const float kk = (float)((r & 3) + 8 * (r >> 2)); s0[r] -= slope2 * fabsf(dq - kk); s1[r] -= slope2 * fabsf(dq - kk - 32.0f); }
        }
        float mxa = max3f(s0[0], s0[1], s0[2]), mxb = max3f(s1[0], s1[1], s1[2]), mxc = max3f(s0[3], s0[4], s0[5]), mxd = max3f(s1[3], s1[4], s1[5]);
        mxa = max3f(mxa, s0[6], s0[7]); mxb = max3f(mxb, s1[6], s1[7]); mxc = max3f(mxc, s0[8], s0[9]); mxd = max3f(mxd, s1[8], s1[9]);
        mxa = max3f(mxa, s0[10], s0[11]); mxb = max3f(mxb, s1[10], s1[11]); mxc = max3f(mxc, s0[12], s0[13]); mxd = max3f(mxd, s1[12], s1[13]);
        mxa = max3f(mxa, s0[14], s0[15]); mxb = max3f(mxb, s1[14], s1[15]);
        const float mx = swapmax(max3f(max3f(mxa, mxb, mxc), mxd, mxd));
        const bool dead = (ti > 0) && __all(mx < -40.0f);
        bf16x8 pf[4];
        if (!dead) {
        if (ti == 0 || __any(mx > 8.0f)) {
            const float delta = (ti == 0) ? mx : fmaxf(mx, 0.f);
#pragma unroll
            for (int r = 0; r < 16; ++r) { s0[r] -= delta; s1[r] -= delta; }
            if (ti > 0) { const float alpha = __builtin_amdgcn_exp2f(-delta); l *= alpha;
#pragma unroll
                for (int db = 0; db < 4; ++db)
#pragma unroll
                    for (int r = 0; r < 16; ++r) o[db][r] *= alpha; }
            m += delta;
        }
        float lsa = 0.f, lsb = 0.f, lsc = 0.f, lsd = 0.f;
#pragma unroll
        for (int r = 0; r < 16; r += 2) { s0[r] = __builtin_amdgcn_exp2f(s0[r]); s1[r] = __builtin_amdgcn_exp2f(s1[r]); s0[r + 1] = __builtin_amdgcn_exp2f(s0[r + 1]); s1[r + 1] = __builtin_amdgcn_exp2f(s1[r + 1]);
            lsa += s0[r]; lsb += s1[r]; lsc += s0[r + 1]; lsd += s1[r + 1]; }
        l += (lsa + lsb) + (lsc + lsd);
        {
            v4u w;
            w.x = cvtpk(s0[0], s0[1]); w.y = cvtpk(s0[2], s0[3]); w.z = cvtpk(s0[4], s0[5]); w.w = cvtpk(s0[6], s0[7]); pf[0] = __builtin_bit_cast(bf16x8, w);
            w.x = cvtpk(s0[8], s0[9]); w.y = cvtpk(s0[10], s0[11]); w.z = cvtpk(s0[12], s0[13]); w.w = cvtpk(s0[14], s0[15]); pf[1] = __builtin_bit_cast(bf16x8, w);
            w.x = cvtpk(s1[0], s1[1]); w.y = cvtpk(s1[2], s1[3]); w.z = cvtpk(s1[4], s1[5]); w.w = cvtpk(s1[6], s1[7]); pf[2] = __builtin_bit_cast(bf16x8, w);
            w.x = cvtpk(s1[8], s1[9]); w.y = cvtpk(s1[10], s1[11]); w.z = cvtpk(s1[12], s1[13]); w.w = cvtpk(s1[14], s1[15]); pf[3] = __builtin_bit_cast(bf16x8, w);
        }
        } else {
#pragma unroll
            for (int f = 0; f < 4; ++f) pf[f] = (bf16x8){0, 0, 0, 0, 0, 0, 0, 0};
        }
        if (hf == 1) { if (ti + 3 < NT) asm volatile("s_waitcnt vmcnt(4)" ::: "memory"); else asm volatile("s_waitcnt vmcnt(0)" ::: "memory"); }
        asm volatile("s_waitcnt lgkmcnt(0)" ::: "memory");
        __builtin_amdgcn_s_barrier();
        if (PROBE_REP & 16384) __builtin_amdgcn_s_barrier();
        asm volatile("" ::: "memory");
        if (hf == 0 && ti + 3 < NT) { AT_STAGE(AT_SEQ(ti + 3), s2); }
        if (ti + 1 < NT) { AT_KLOAD(lds + ((slot == 3) ? 0 : slot + 1) * SLOT); }
        __builtin_amdgcn_sched_barrier(0);
#define AT_VLOAD(dst, db) do { _Pragma("unroll") for (int _f = 0; _f < 4; ++_f) { dst##lo[_f] = vtr(sl + vb[db] + _f * 4096); dst##hi[_f] = vtr(sl + vb[db] + _f * 4096 + 2048); } } while (0)
#define AT_VMMA(src, db) do { _Pragma("unroll") for (int _f = 0; _f < 4; ++_f) { const bf16x8 vf = (bf16x8){src##lo[_f][0], src##lo[_f][1], src##lo[_f][2], src##lo[_f][3], src##hi[_f][0], src##hi[_f][1], src##hi[_f][2], src##hi[_f][3]}; \
            o[db] = __builtin_amdgcn_mfma_f32_32x32x16_bf16(vf, pf[_f], o[db], 0, 0, 0); if (PROBE_REP & 32768) { bf16x8 pz = (bf16x8){0,0,0,0,0,0,0,0}; asm volatile("" : "+v"(pz)); o[db] = __builtin_amdgcn_mfma_f32_32x32x16_bf16(vf, pz, o[db], 0, 0, 0); } } } while (0)
        if (!dead) {
            s16x4 valo[4], vahi[4], vb_lo[4], vb_hi[4];
            AT_VLOAD(va, 0); __builtin_amdgcn_sched_barrier(0);
            AT_VLOAD(vb_, 1); __builtin_amdgcn_sched_barrier(0);
            AT_VMMA(va, 0); __builtin_amdgcn_sched_barrier(0);
            AT_VLOAD(va, 2); __builtin_amdgcn_sched_barrier(0);
            AT_VMMA(vb_, 1); __builtin_amdgcn_sched_barrier(0);
            AT_VLOAD(vb_, 3); __builtin_amdgcn_sched_barrier(0);
            AT_VMMA(va, 2); __builtin_amdgcn_sched_barrier(0);
            AT_VMMA(vb_, 3); __builtin_amdgcn_sched_barrier(0);
        }
#undef AT_VLOAD
#undef AT_VMMA
        __builtin_amdgcn_sched_barrier(0);
        if (ti + 1 < NT) { const int ktn = AT_SEQ(ti + 1); AT_QK(ktn); }
        if (hf == 0) { if (ti + 3 < NT) asm volatile("s_waitcnt vmcnt(4)" ::: "memory"); else asm volatile("s_waitcnt vmcnt(0)" ::: "memory"); }
        asm volatile("s_waitcnt lgkmcnt(0)" ::: "memory");
        __builtin_amdgcn_s_barrier();
        if (PROBE_REP & 16384) __builtin_amdgcn_s_barrier();
        asm volatile("" ::: "memory");
        slot = (slot == 3) ? 0 : slot + 1;
    }
    if (hf == 0) __builtin_amdgcn_s_barrier();
    asm volatile("" ::: "memory");
#undef AT_QK
#undef AT_KLOAD
#undef AT_STAGE
#undef AT_GLDS
#undef AT_SEQ
    l = swapsum(l);
    const float il = 1.0f / l;
    __builtin_amdgcn_s_barrier();
    LAS float* xch = (LAS float*)lds + w4 * (64 * 64);
    if (hf == 1) {
#pragma unroll
        for (int db = 0; db < 4; ++db)
#pragma unroll
            for (int r = 0; r < 16; ++r) xch[(db * 16 + r) * 64 + lane] = o[db][r] * il;
    }
    asm volatile("s_waitcnt lgkmcnt(0)" ::: "memory");
    __builtin_amdgcn_s_barrier();
    asm volatile("" ::: "memory");
    if (hf == 0) {
        float ss = 0.f; float lfv, omv; asm volatile("v_mov_b32 %0, %2\n\tv_mov_b32 %1, %3" : "=&v"(lfv), "=&v"(omv) : "s"(lam_full), "s"(oml));
#pragma unroll
        for (int db = 0; db < 4; ++db)
#pragma unroll
            for (int r = 0; r < 16; ++r) { const float v = o[db][r] * il - lfv * xch[(db * 16 + r) * 64 + lane]; o[db][r] = v; ss += v * v; }
        ss = swapsum(ss);
        const float rs = omv / sqrtf(ss * (1.0f / 128.0f) + EPS);
        const int le = lane_id_volatile(), tqe = qb * 128 + w4 * 32 + (le & 31), hhe = le >> 5;
        bf16* op = hd + ((size_t)b * SEQ + tqe) * 1024 + 512 + h * 128 + 4 * hhe;
#pragma unroll
        for (int db = 0; db < 4; ++db)
#pragma unroll
            for (int r4 = 0; r4 < 4; ++r4) { const int d = db * 32 + 8 * r4; const f32x4 g = *(const f32x4*)(ng + d + 4 * hhe);
                v2u w; w.x = pk2(o[db][4 * r4] * rs * g.x, o[db][4 * r4 + 1] * rs * g.y); w.y = pk2(o[db][4 * r4 + 2] * rs * g.z, o[db][4 * r4 + 3] * rs * g.w);
                *(v2u*)(op + d) = w; }
    }
    asm volatile("s_waitcnt lgkmcnt(0)" ::: "memory");
    __builtin_amdgcn_s_barrier();
}
}
namespace mls {
using attn::f32x16; using attn::s16x4; using attn::vtr; using attn::cvtpk; using attn::swapsum; using attn::crow;
constexpr int QS = 0, KS = 32768, VS = 65536, CB = 98304, AUX = 132096;
constexpr int A_FS = 0, A_ET = 512, A_SIN = 1024, A_EMT = 1536, A_WS = 2048, A_NV = 2560, A_NP = 3072, A_SC = 5120, A_CW = 5632;
__device__ __forceinline__ int swz(int row) { return ((row & 3) << 2) | ((row >> 2) & 3); }
__device__ __forceinline__ int offs(int row, int ch) { return row * 256 + ((ch ^ swz(row)) << 4); }
__device__ __forceinline__ bf16x8 rdrow(const LAS unsigned char* lds, int buf, int RB, int i, int ks) { return *(const LAS bf16x8*)(lds + buf + (RB ^ (ks << 5)) + i * 8192); }
__device__ __forceinline__ bf16x8 trB(const LAS unsigned char* lds, int buf, int TB, int rowc, int c0) {
    const s16x4 lo = vtr(lds + buf + (TB ^ (c0 << 4)) + rowc * 256), hi = vtr(lds + buf + (TB ^ ((c0 | 2) << 4)) + (rowc + 8) * 256);
    return (bf16x8){lo[0], lo[1], lo[2], lo[3], hi[0], hi[1], hi[2], hi[3]};
}
__device__ __forceinline__ bf16x8 trC(const LAS unsigned char* lds, int buf, int TC, int ss, int c0) {
    const s16x4 lo = vtr(lds + buf + (TC ^ (c0 << 4)) + (16 * ss) * 256), hi = vtr(lds + buf + (TC ^ ((c0 | 1) << 4)) + (16 * ss + 4) * 256);
    return (bf16x8){lo[0], lo[1], lo[2], lo[3], hi[0], hi[1], hi[2], hi[3]};
}
__device__ __forceinline__ void mm8(f32x16& acc, const LAS unsigned char* lds, int bufA, int ia, int bufB, int ib, int RB) {
    bf16x8 a[2], b[2];
    a[0] = rdrow(lds, bufA, RB, ia, 0); b[0] = rdrow(lds, bufB, RB, ib, 0);
#pragma unroll
    for (int ks = 0; ks < 8; ++ks) {
        if (ks + 1 < 8) { a[(ks + 1) & 1] = rdrow(lds, bufA, RB, ia, ks + 1); b[(ks + 1) & 1] = rdrow(lds, bufB, RB, ib, ks + 1); }
        acc = __builtin_amdgcn_mfma_f32_32x32x16_bf16(a[ks & 1], b[ks & 1], acc, 0, 0, 0);
        __builtin_amdgcn_sched_barrier(0);
    }
}
template <int CTRL, int RM> __device__ __forceinline__ float dpp_f(float idv, float v) { return __int_as_float(__builtin_amdgcn_update_dpp(__float_as_int(idv), __float_as_int(v), CTRL, RM, 0xf, false)); }
__device__ __forceinline__ float scan_add(float x, int) {
    x += dpp_f<0x111, 0xf>(0.f, x); x += dpp_f<0x112, 0xf>(0.f, x); x += dpp_f<0x114, 0xf>(0.f, x); x += dpp_f<0x118, 0xf>(0.f, x);
    x += dpp_f<0x142, 0xa>(0.f, x); x += dpp_f<0x143, 0xc>(0.f, x); return x;
}
__device__ __forceinline__ float scan_max(float x, int) {
    const float ni = -3.0e38f;
    x = fmaxf(x, dpp_f<0x111, 0xf>(ni, x)); x = fmaxf(x, dpp_f<0x112, 0xf>(ni, x)); x = fmaxf(x, dpp_f<0x114, 0xf>(ni, x)); x = fmaxf(x, dpp_f<0x118, 0xf>(ni, x));
    x = fmaxf(x, dpp_f<0x142, 0xa>(ni, x)); x = fmaxf(x, dpp_f<0x143, 0xc>(ni, x)); return x;
}
__device__ __forceinline__ void item(LAS unsigned char* lds, int tid, int b, int h, int dir, const bf16* zqk, const bf16* zmv, const float* mg, const float* cw, const float* cb, bf16* outp) {
    const int lane = tid & 63, wave = __builtin_amdgcn_readfirstlane(tid >> 6);
    LAS float* aux = (LAS float*)(lds + AUX);
    { unsigned zz = 0u; asm volatile("" : "+v"(zz)); for (int i = tid; i < 32768 / 16; i += NTHREADS) *(LAS v4u*)(lds + CB + i * 16) = (v4u){zz, zz, zz, zz}; }
    if (tid < 128) aux[A_NV / 4 + tid] = 0.f;
    if (tid < 4 * 128) aux[A_NP / 4 + tid] = 0.f;
    if (tid < 8) aux[A_SC / 4 + tid] = 1.f;
    for (int i = tid; i < 6 * 256; i += NTHREADS) { const int j = i >> 8, c = i & 255; const int col = (c < 128) ? (h * 128 + c) : (512 + h * 128 + (c - 128)); aux[A_CW / 4 + i] = (j < 5) ? cw[j * 1024 + col] : cb[col]; }
    f32x16 X[2];
#pragma unroll
    for (int kb = 0; kb < 2; ++kb)
#pragma unroll
        for (int r = 0; r < 16; ++r) X[kb][r] = 0.f;
    float mstate = 0.f;
    __syncthreads();
#pragma unroll 1
    for (int c = 0; c < SEQ / 128; ++c) {
        const int c0 = dir ? (SEQ - 128 - c * 128) : c * 128;
        int tl = tid; asm volatile("" : "+v"(tl));
        if (tl >= 128 && tl < 256) { const int k = tl - 128; aux[A_NV / 4 + k] = aux[A_SC / 4 + ((c + 1) & 1)] * aux[A_NV / 4 + k] + (aux[A_NP / 4 + k] + aux[A_NP / 4 + 128 + k]) + (aux[A_NP / 4 + 256 + k] + aux[A_NP / 4 + 384 + k]); }
        {
          const int cq = tl & 31, rg = tl >> 5; const int col = (cq < 16) ? (h * 128 + cq * 8) : (512 + h * 128 + (cq - 16) * 8);
          const float ksc = (cq < 16) ? 1.0f : 0.08838834764831845f;
          const int base = dir ? (c0 + 118 - 8 * rg) : (c0 + 8 * rg - 2);
          v4u xr[12], vr[4];
#pragma unroll
          for (int i = 0; i < 12; ++i) { const int ts = dir ? base + 11 - i : base + i; xr[i] = (v4u){0u, 0u, 0u, 0u}; if (ts >= 0 && ts < SEQ) xr[i] = *(const v4u*)(zqk + ((size_t)b * SEQ + ts) * 1024 + col); }
#pragma unroll
          for (int n = 0; n < 4; ++n) { const int i = tl + NTHREADS * n, u = i >> 4, ch = i & 15; const int pos = dir ? (c0 + 127 - u) : (c0 + u);
              vr[n] = *(const v4u*)(zmv + ((size_t)b * SEQ + pos) * 512 + h * 128 + ch * 8); }
          const LAS float* cwl = aux + A_CW / 4 + cq * 8;
          float xu[12][8];
#define ML_UNP(r_) do { xu[r_][0] = bflo(xr[r_].x); xu[r_][1] = bfhi(xr[r_].x); xu[r_][2] = bflo(xr[r_].y); xu[r_][3] = bfhi(xr[r_].y); xu[r_][4] = bflo(xr[r_].z); xu[r_][5] = bfhi(xr[r_].z); xu[r_][6] = bflo(xr[r_].w); xu[r_][7] = bfhi(xr[r_].w); } while (0)
#pragma unroll
          for (int n = 0; n < 8; ++n) {
              if (n == 0) { ML_UNP(0); ML_UNP(1); ML_UNP(2); ML_UNP(3); }
              ML_UNP(n + 4);
              float a[8];
              { const f32x4 b0 = *(const LAS f32x4*)(cwl + 5 * 256), b1 = *(const LAS f32x4*)(cwl + 5 * 256 + 4); a[0] = b0.x; a[1] = b0.y; a[2] = b0.z; a[3] = b0.w; a[4] = b1.x; a[5] = b1.y; a[6] = b1.z; a[7] = b1.w; }
#pragma unroll
              for (int j = 0; j < CONVW; ++j) { const LAS float* wp = cwl + (dir ? (CONVW - 1 - j) : j) * 256; const f32x4 w0 = *(const LAS f32x4*)wp, w1 = *(const LAS f32x4*)(wp + 4);
                  a[0] += w0.x * xu[n + j][0]; a[1] += w0.y * xu[n + j][1]; a[2] += w0.z * xu[n + j][2]; a[3] += w0.w * xu[n + j][3]; a[4] += w1.x * xu[n + j][4]; a[5] += w1.y * xu[n + j][5]; a[6] += w1.z * xu[n + j][6]; a[7] += w1.w * xu[n + j][7]; }
#pragma unroll
              for (int e = 0; e < 8; ++e) a[e] = a[e] * sigmoidf_(a[e]) * ksc;
              v4u o; o.x = pk2(a[0], a[1]); o.y = pk2(a[2], a[3]); o.z = pk2(a[4], a[5]); o.w = pk2(a[6], a[7]);
              *(LAS v4u*)(lds + ((cq < 16) ? QS : KS) + offs(8 * rg + n, cq & 15)) = o;
              __builtin_amdgcn_sched_barrier(0); }
#undef ML_UNP
#pragma unroll
          for (int n = 0; n < 4; ++n) { const int i = tl + NTHREADS * n, u = i >> 4, ch = i & 15; *(LAS v4u*)(lds + VS + offs(u, ch)) = vr[n]; } }
        if (wave == 0) {
            int ln_ = lane; asm volatile("" : "+v"(ln_));
            const int u0 = 2 * ln_, u1 = u0 + 1; const int p0 = dir ? (c0 + 127 - u0) : (c0 + u0), p1 = dir ? (c0 + 127 - u1) : (c0 + u1);
            const float* g0 = mg + ((size_t)b * SEQ + p0) * 16 + dir * 8 + h; const float* g1p = mg + ((size_t)b * SEQ + p1) * 16 + dir * 8 + h;
            const float ip0 = g0[0], fp0 = g0[4], ip1 = g1p[0], fp1 = g1p[4];
            const float lf0 = fminf(fp0, 0.f) - log1pf(__expf(-fabsf(fp0))), lf1 = fminf(fp1, 0.f) - log1pf(__expf(-fabsf(fp1)));
            const float incl = scan_add(lf0 + lf1, lane);
            const float bc1 = incl, bc0 = incl - lf1;
            const float fs0 = ip0 - bc0, fs1 = ip1 - bc1;
            const float pmx = scan_max(fmaxf(fs0, fs1), lane);
            const float prev = dpp_f<0x138, 0xf>(-3.0e38f, pmx);
            const float dm0 = fmaxf(prev, fs0), dm1 = pmx;
            const float gtot = __uint_as_float(__builtin_amdgcn_readlane(__float_as_uint(bc1), 63)), dlast = __uint_as_float(__builtin_amdgcn_readlane(__float_as_uint(pmx), 63));
            const float M0 = fmaxf(mstate, dm0), M1 = fmaxf(mstate, dm1), Ml = fmaxf(mstate, dlast);
            aux[A_FS / 4 + u0] = fs0; aux[A_FS / 4 + u1] = fs1;
            aux[A_ET / 4 + u0] = -M0; aux[A_ET / 4 + u1] = -M1;
            aux[A_SIN / 4 + u0] = __expf(mstate - M0); aux[A_SIN / 4 + u1] = __expf(mstate - M1);
            aux[A_EMT / 4 + u0] = __expf(-(bc0 + M0)); aux[A_EMT / 4 + u1] = __expf(-(bc1 + M1));
            aux[A_WS / 4 + u0] = __expf(fs0 - Ml); aux[A_WS / 4 + u1] = __expf(fs1 - Ml);
            if (lane == 0) aux[A_SC / 4 + (c & 1)] = __expf(mstate - Ml);
            mstate = gtot + Ml;
        }
        __syncthreads();
        {
            int lb = lane; asm volatile("" : "+v"(lb));
            const int r32 = lb & 31, hh = lb >> 5;
            int RB, RB2, TB;
            { const int sw = swz(r32), li = lb & 15, q_ = li >> 2, p_ = li & 3, x = 2 * ((lb >> 4) & 1) + (p_ >> 1);
              RB = r32 * 256 + ((hh ^ sw) << 4); RB2 = r32 * 256 + (((8 * hh) ^ sw) << 4);
              TB = (4 * hh + q_) * 256 + (((q_ << 2) | (x ^ hh)) << 4) + 8 * (p_ & 1); }
            const int j = wave & 3, vh = wave >> 2, t = 32 * j + r32;
            f32x16 acc[2];
#pragma unroll
            for (int vb2 = 0; vb2 < 2; ++vb2) {
#pragma unroll
                for (int r = 0; r < 16; ++r) acc[vb2][r] = 0.f;
                mm8(acc[vb2], lds, CB, 2 * vh + vb2, QS, j, RB);
                asm volatile("" : "+v"(RB));
            }
            const float sin = aux[A_SIN / 4 + t], et = aux[A_ET / 4 + t];
#pragma unroll
            for (int vb2 = 0; vb2 < 2; ++vb2)
#pragma unroll
                for (int r = 0; r < 16; ++r) acc[vb2][r] *= sin;
            float dn = 0.f;
#pragma unroll
            for (int cq = 0; cq < 8; ++cq) { const int ch = 8 * hh + cq; const v4u qv = *(const LAS v4u*)(lds + QS + (RB2 ^ (cq << 4)) + j * 8192); const f32x4 n0 = *(const LAS f32x4*)(aux + A_NV / 4 + 8 * ch), n1 = *(const LAS f32x4*)(aux + A_NV / 4 + 8 * ch + 4);
                dn += n0.x * bflo(qv.x) + n0.y * bfhi(qv.x) + n0.z * bflo(qv.y) + n0.w * bfhi(qv.y) + n1.x * bflo(qv.z) + n1.y * bfhi(qv.z) + n1.z * bflo(qv.w) + n1.w * bfhi(qv.w);
                if (cq & 1) { asm volatile("" : "+v"(dn)); __builtin_amdgcn_sched_barrier(0); } }
            float dsum = 0.f;
            for (int i = 0; i <= j; ++i) {
                f32x16 sc;
#pragma unroll
                for (int r = 0; r < 16; ++r) sc[r] = 0.f;
                mm8(sc, lds, KS, i, QS, j, RB);
                asm volatile("" : "+v"(RB));
                bf16x8 vfr[4];
#pragma unroll
                for (int vb2 = 0; vb2 < 2; ++vb2) { vfr[2 * vb2] = trB(lds, VS, TB, 32 * i, 4 * (2 * vh + vb2)); vfr[2 * vb2 + 1] = trB(lds, VS, TB, 32 * i + 16, 4 * (2 * vh + vb2)); }
                __builtin_amdgcn_sched_barrier(0);
#pragma unroll
                for (int r4 = 0; r4 < 4; ++r4) { const f32x4 fs = *(const LAS f32x4*)(aux + A_FS / 4 + 32 * i + 8 * r4 + 4 * hh);
#pragma unroll
                    for (int e = 0; e < 4; ++e) { const int r = 4 * r4 + e; const float p = __expf(et + fs[e]); const bool ok = (i < j) || (8 * r4 + 4 * hh + e <= r32);
                        const float w = ok ? sc[r] * p : 0.f; sc[r] = w; dsum += w; } }
                v4u w0, w1;
                w0.x = cvtpk(sc[0], sc[1]); w0.y = cvtpk(sc[2], sc[3]); w0.z = cvtpk(sc[4], sc[5]); w0.w = cvtpk(sc[6], sc[7]);
                w1.x = cvtpk(sc[8], sc[9]); w1.y = cvtpk(sc[10], sc[11]); w1.z = cvtpk(sc[12], sc[13]); w1.w = cvtpk(sc[14], sc[15]);
                const bf16x8 wf0 = __builtin_bit_cast(bf16x8, w0), wf1 = __builtin_bit_cast(bf16x8, w1);
                __builtin_amdgcn_sched_barrier(0);
#pragma unroll
                for (int vb2 = 0; vb2 < 2; ++vb2) {
                    acc[vb2] = __builtin_amdgcn_mfma_f32_32x32x16_bf16(vfr[2 * vb2], wf0, acc[vb2], 0, 0, 0);
                    acc[vb2] = __builtin_amdgcn_mfma_f32_32x32x16_bf16(vfr[2 * vb2 + 1], wf1, acc[vb2], 0, 0, 0);
                    __builtin_amdgcn_sched_barrier(0);
                }
            }
            const float den = swapsum(dn) * sin + swapsum(dsum);
            const float scale = 1.0f / fmaxf(fabsf(den), aux[A_EMT / 4 + t]);
            const int pos = dir ? (c0 + 127 - t) : (c0 + t);
            bf16* op = outp + ((size_t)b * SEQ + pos) * 512 + h * 128 + 4 * hh;
#pragma unroll
            for (int vb2 = 0; vb2 < 2; ++vb2)
#pragma unroll
                for (int r4 = 0; r4 < 4; ++r4) { v2u o4; o4.x = cvtpk(acc[vb2][4 * r4] * scale, acc[vb2][4 * r4 + 1] * scale); o4.y = cvtpk(acc[vb2][4 * r4 + 2] * scale, acc[vb2][4 * r4 + 3] * scale);
                    *(v2u*)(op + 32 * (2 * vh + vb2) + 8 * r4) = o4; }
        }
        __syncthreads();
        {
            int lb = lane; asm volatile("" : "+v"(lb));
            const int hh = lb >> 5;
            int TC;
            { const int li = lb & 15, q_ = li >> 2, p_ = li & 3, x = 2 * ((lb >> 4) & 1) + (p_ >> 1);
              TC = (8 * hh + q_) * 256 + (((q_ << 2) | (x ^ (2 * hh))) << 4) + 8 * (p_ & 1); }
            const int vs = wave & 3, kh = wave >> 2;
            const float sp = aux[A_SC / 4 + (c & 1)];
#pragma unroll
            for (int kb = 0; kb < 2; ++kb)
#pragma unroll
                for (int r = 0; r < 16; ++r) X[kb][r] *= sp;
            {
                bf16x8 vr_[2], k0_[2], k1_[2]; f32x4 wa_[2], wb_[2];
                vr_[0] = trC(lds, VS, TC, 0, 4 * vs); k0_[0] = trC(lds, KS, TC, 0, 8 * kh); k1_[0] = trC(lds, KS, TC, 0, 8 * kh + 4);
                wa_[0] = *(const LAS f32x4*)(aux + A_WS / 4 + 8 * hh); wb_[0] = *(const LAS f32x4*)(aux + A_WS / 4 + 8 * hh + 4);
#pragma unroll
                for (int ss = 0; ss < 8; ++ss) { const int cu = ss & 1, nx = cu ^ 1;
                    if (ss + 1 < 8) { vr_[nx] = trC(lds, VS, TC, ss + 1, 4 * vs); k0_[nx] = trC(lds, KS, TC, ss + 1, 8 * kh); k1_[nx] = trC(lds, KS, TC, ss + 1, 8 * kh + 4);
                        wa_[nx] = *(const LAS f32x4*)(aux + A_WS / 4 + 16 * (ss + 1) + 8 * hh); wb_[nx] = *(const LAS f32x4*)(aux + A_WS / 4 + 16 * (ss + 1) + 8 * hh + 4); }
                    const v4u vv = __builtin_bit_cast(v4u, vr_[cu]); const f32x4 wa = wa_[cu], wb = wb_[cu]; v4u vw;
                    vw.x = cvtpk(bflo(vv.x) * wa.x, bfhi(vv.x) * wa.y); vw.y = cvtpk(bflo(vv.y) * wa.z, bfhi(vv.y) * wa.w); vw.z = cvtpk(bflo(vv.z) * wb.x, bfhi(vv.z) * wb.y); vw.w = cvtpk(bflo(vv.w) * wb.z, bfhi(vv.w) * wb.w);
                    const bf16x8 vf = __builtin_bit_cast(bf16x8, vw);
                    X[0] = __builtin_amdgcn_mfma_f32_32x32x16_bf16(k0_[cu], vf, X[0], 0, 0, 0);
                    X[1] = __builtin_amdgcn_mfma_f32_32x32x16_bf16(k1_[cu], vf, X[1], 0, 0, 0);
                    __builtin_amdgcn_sched_barrier(0);
                }
            }
            { int t2 = tid; asm volatile("" : "+v"(t2)); const int k = t2 & 127, sq = t2 >> 7; float a = 0.f;
#pragma unroll 8
              for (int s2 = 0; s2 < 32; ++s2) { const int sI = 32 * sq + s2; a += aux[A_WS / 4 + sI] * bf2f(*(const LAS unsigned short*)(lds + KS + offs(sI, k >> 3) + (k & 7) * 2)); }
              aux[A_NP / 4 + sq * 128 + k] = a; }
        }
        __syncthreads();
        { int lb = lane; asm volatile("" : "+v"(lb)); const int r32 = lb & 31, hh = lb >> 5;
          const int vs = wave & 3, kh = wave >> 2, v = 32 * vs + r32;
#pragma unroll
          for (int kb = 0; kb < 2; ++kb)
#pragma unroll
              for (int r4 = 0; r4 < 4; ++r4) { v2u w; w.x = cvtpk(X[kb][4 * r4], X[kb][4 * r4 + 1]); w.y = cvtpk(X[kb][4 * r4 + 2], X[kb][4 * r4 + 3]);
                  *(LAS v2u*)(lds + CB + offs(v, 8 * kh + 4 * kb + r4) + 8 * hh) = w; } }
    }
    __syncthreads();
}
}
constexpr int CW_QUEUE = 2048;
__device__ __forceinline__ void ph_mixers(Frame& F, int l, int qslot) {
    PH_IDS;
    static_assert(DEPTH == 2, "lam_init literals");
    const float lam_init = (l == 0) ? 0.2f : 0.35550906759096927f;
    const float* lam = F.in[I_LAM] + (size_t)l * 4 * ADH;
    const float s01 = wave_sum_fast(lam[lane] * lam[64 + lane]), s23 = wave_sum_fast(lam[128 + lane] * lam[192 + lane]);
    const float lam_full = __uint_as_float(__builtin_amdgcn_readfirstlane(__float_as_uint(__expf(s01) - __expf(s23) + lam_init)));
    const unsigned oml = (l == 0) ? 0x3f4ccccdu : 0x3f24fd5cu;
    const float* cw = F.in[I_CW] + (size_t)l * CONVW * 2 * MW; const float* cb = F.in[I_CB] + (size_t)l * 2 * MW;
    unsigned* head = (unsigned*)(F.ws + WS_CTL) + CW_QUEUE + 64 * qslot;
    volatile LAS unsigned* qw = (volatile LAS unsigned*)(F.lds + MISC_OFF + 64);
    constexpr int NML = BATCH * MH * 2, NAT = BATCH * AH * (SEQ / 128);
    constexpr int NCV0 = (CV_NITEMS - CV_WIN) / 128, NCV1 = CV_WIN / 128;
    static_assert((CV_NITEMS - CV_WIN) % 128 == 0 && CV_WIN % 128 == 0 && 3 * (NCV0 + NCV1) <= NAT + NCV0 + NCV1, "conversion items are 128 tiles; the (2 attention, 1 conversion) groups fit");
    const int NCV = NCV0 + ((l + 1 < DEPTH) ? NCV1 : 0);
    for (;;) {
        __syncthreads();
        if (tid == 0) qw[0] = __hip_atomic_fetch_add(head, 1u, __ATOMIC_RELAXED, __HIP_MEMORY_SCOPE_AGENT);
        __syncthreads();
        int it = (int)qw[0];
        if (PROBE_REP & 8) { if (it >= NML + 2 * (NAT + NCV)) break; if (it >= NML + NAT + NCV) it -= NAT + NCV; }
        else if (PROBE_REP & 4) { if (it >= 2 * NML + NAT + NCV) break; if (it >= NML + NAT + NCV) it -= NML + NAT + NCV; }
        else if (it >= NML + NAT + NCV) break;
        const int tq_ = F.wv * 64 + lane_id_volatile();
        if (it < NML) { const int dir = it & 1, h = (it >> 1) & 3, b = it >> 3; int t1 = tq_; asm volatile("" : "+v"(t1));
            mls::item(F.lds, t1, b, h, dir, WSP(bf16, WS_ZQK), WSP(bf16, WS_ZMV), WSP(float, WS_MG), cw, cb, WSP(bf16, dir ? WS_HB : WS_HF)); }
        else {
            const int j = it - NML; int u, ci = -1;
            if (j < 3 * NCV) { if (j % 3 == 2) ci = j / 3; u = j - j / 3; } else u = j - NCV;
            if (ci >= 0) {
                int t2 = tq_; asm volatile("" : "+v"(t2));
                const int l2 = (ci >= NCV0) ? l + 1 : l, first = (ci >= NCV0) ? (ci - NCV0) * 128 : CV_WIN + ci * 128;
                cv_run(F, l2, t2 & 63, (LAS float*)(F.lds + (t2 >> 6) * 16384), first, 128, __builtin_amdgcn_readfirstlane(t2 >> 6), NWAVES); }
            else { const int qb = u & 15, b = (u >> 4) & 15, h = 3 - (u >> 8);
            int t3 = tq_; asm volatile("" : "+v"(t3));
            attn::unit(F.lds, t3, b, h, qb, WSP(bf16, WS_ZDQ), WSP(bf16, WS_ZDK), WSP(bf16, WS_ZDV), WSP(bf16, WS_HM), F.in[I_DNG] + (size_t)l * ADV, lam_full, oml); } }
    }
}

constexpr int NPH = 1 + DEPTH * 10;
__global__ void __launch_bounds__(NTHREADS, 2) fwd(Args args) {
    extern __shared__ __attribute__((aligned(16))) unsigned char lds_raw[];
    Frame F;
    F.lds = (LAS unsigned char*)lds_raw;
    F.G = gridDim.x; F.bx = blockIdx.x; F.wv = __builtin_amdgcn_readfirstlane(threadIdx.x >> 6);
#pragma unroll
    for (int i = 0; i < 18; ++i) F.in[i] = args.in[i];
    F.X = args.out; F.ws = args.ws;
    volatile LAS unsigned* MISC = (volatile LAS unsigned*)(F.lds + MISC_OFF);
    for (int u = threadIdx.x; u < (LDS_BYTES - LDSCTL_OFF) / 4; u += NTHREADS) ((LAS unsigned*)(F.lds + LDSCTL_OFF))[u] = 0u;
    __syncthreads();
    const int lo = args.ph_lo, hi = args.ph_hi;
    XcdBarrier bar; bar.bar = (unsigned*)(F.ws + WS_CTL) + CW_BAR; bar.x = 0; bar.st = nullptr;
    if (hi - lo > 1) bar = xcd_barrier_post((unsigned*)(F.ws + WS_CTL) + CW_BAR, MISC + 8);
#define IN(k) (lo <= (k) && (k) < hi)
#define SEAM(k) do { if (IN(k) && IN((k) + 1)) { xcd_barrier(bar); if (PROBE_REP & 4096) xcd_barrier(bar); } } while (0)
    LAS unsigned char* ring = F.lds;

    if (IN(0)) { ph_convert(F, 0); ph_prep_first(F);
        if (PROBE_REP & 1) { __syncthreads(); ph_convert(F, 0); ph_prep_first(F); } }
    SEAM(0);
    for (int l = 0; l < DEPTH; ++l) {
        const int p0 = 1 + l * 10;
        if (IN(p0 + 0)) {
            ph_mgate(F, l);
            pg8::StdOrder S; S.init(T, NIN - 2560, F.G, F.bx);
            pg8::EpiInproj E{WSP(bf16, WS_ZQK), WSP(bf16, WS_ZMV), WSP(bf16, WS_ZMO), WSP(bf16, WS_ZDQ), WSP(bf16, WS_ZDK), WSP(bf16, WS_ZDV), WSP(bf16, WS_ZG)};
            pg8::gemm_phase(ring, WSP(bf16, WS_XB), WSP(bf16, WS_WIN), D, S, E, F.wv);
            pg8::StdOrderG S2; S2.init(T, 2560, F.G, F.bx);
            pg8::EpiGate8 E2{WSP(bf16, WS_ZMO), WSP(bf16, WS_ZG)};
            pg8::gemm_phase(ring, WSP(bf16, WS_MIX), (const pg8::bf16_t*)(F.ws + WS_WIN8), D / 2, S2, E2, F.wv);
        }
        SEAM(p0 + 0);
        if (IN(p0 + 1)) { ph_mixers(F, l, l); }
        SEAM(p0 + 1);
        if (IN(p0 + 2)) { for (int rep = 0; rep < ((PROBE_REP & 16) ? 2 : 1); ++rep) ph_mnorm(F, l); }
        SEAM(p0 + 2);
        if (IN(p0 + 3)) {
            pg8::UpOrder S; S.init(T, D, F.G, F.bx);
            pg8::EpiUp E{WSP(bf16, WS_MIX), WSP(bf16, WS_ZG)}; pg8::gemm_phase(ring, WSP(bf16, WS_HM), WSP(bf16, l == 0 ? WS_WA : WS_WA_L1), MW, S, E, F.wv, 1024);
        }
        SEAM(p0 + 3);
        if (IN(p0 + 4)) {
            pg8::StdOrder S; S.init(T, D, F.G, F.bx);
            pg8::EpiResid E{WSP(bf16, WS_XR)}; pg8::gemm_phase(ring, WSP(bf16, WS_MIX), WSP(bf16, l == 0 ? WS_WO : WS_WO_L1), D, S, E, F.wv);
        }
        SEAM(p0 + 4);
        if (IN(p0 + 5)) { for (int rep = 0; rep < ((PROBE_REP & 64) ? 2 : 1); ++rep) ph_prep2(F, l); }
        SEAM(p0 + 5);
        if (IN(p0 + 6)) { for (int rep = 0; rep < ((PROBE_REP & 128) ? 2 : 1); ++rep) ph_topk(F); }
        SEAM(p0 + 6);
        if (IN(p0 + 7)) {
            const int xcd = F.bx & 7, loc = F.bx >> 3; int be = (loc & 15) * 16 + 2 * xcd + (loc >> 4); asm volatile("" : "+s"(be));
            int n1 = 16, n2 = 4; asm volatile("" : "+s"(n1), "+s"(n2));
            pg8::G1OrderBE S1{WSP(int, WS_IDX), be, n1}; pg8::EpiG1 E1{F.ws + WS_HID};
            pg8::gemm_phase(ring, WSP(bf16, WS_XB), WSP(bf16, l == 0 ? WS_WGU : WS_WGU_L1), D / 2, S1, E1, F.wv);
            __builtin_amdgcn_fence(__ATOMIC_RELEASE, "workgroup"); __syncthreads(); __builtin_amdgcn_fence(__ATOMIC_ACQUIRE, "agent");
            pg8::G2OrderBE S2{be, n2}; pg8::EpiG2 E2{WSP(bf16, WS_YE), WSP(float, WS_GATEV)};
            pg8::gemm_phase(ring, WSP(bf16, WS_HID), WSP(bf16, l == 0 ? WS_WD : WS_WD_L1), DFF / 2, S2, E2, F.wv);
        }
        SEAM(p0 + 8);
        if (IN(p0 + 9)) { ph_combine(F, l); }
        SEAM(p0 + 9);
    }
#undef IN
#undef SEAM
}

extern "C" void kernel_launch(void* const* d_in, const int* in_sizes, int n_in, void* d_out, int out_size, void* d_ws, size_t ws_size, hipStream_t stream) {
    static int grid = 0;
    if (grid == 0) {
        if (n_in != 18 || out_size != T * D || ws_size < WS_END2) { fprintf(stderr, "kernel_launch: unexpected shapes (n_in %d, out %d, ws %zu)\n", n_in, out_size, ws_size); grid = -1; return; }
        int dev = 0, cus = 0, per_cu = 0;
        if (hipGetDevice(&dev) != hipSuccess || hipDeviceGetAttribute(&cus, hipDeviceAttributeMultiprocessorCount, dev) != hipSuccess) { grid = -1; return; }
        if (hipFuncSetAttribute((const void*)fwd, hipFuncAttributeMaxDynamicSharedMemorySize, LDS_BYTES) != hipSuccess) { fprintf(stderr, "kernel_launch: hipFuncSetAttribute failed\n"); grid = -1; return; }
        if (hipOccupancyMaxActiveBlocksPerMultiprocessor(&per_cu, (const void*)fwd, NTHREADS, LDS_BYTES) != hipSuccess || per_cu < 1) fprintf(stderr, "kernel_launch: occupancy query says %d\n", per_cu);
        (void)hipGetLastError();
        if (cus != 256) { fprintf(stderr, "kernel_launch: this build maps one (sequence, expert) pair per workgroup and needs 256 CUs (found %d)\n", cus); grid = -1; return; }
        grid = cus;
    }
    if (grid < 0) return;
    (void)hipMemsetAsync((char*)d_ws + WS_CTL, 0, CTL_ZERO_BYTES, stream);
    Args a{};
    for (int i = 0; i < 18; ++i) a.in[i] = (const float*)d_in[i];
    a.out = (float*)d_out; a.ws = (unsigned char*)d_ws;
#if MK_ONE_LAUNCH
    a.ph_lo = 0; a.ph_hi = NPH;
    hipLaunchKernelGGL(fwd, dim3(grid), dim3(NTHREADS), LDS_BYTES, stream, a);
#else
    for (int p = 0; p < NPH; ++p) { a.ph_lo = p; a.ph_hi = p + 1; hipLaunchKernelGGL(fwd, dim3(grid), dim3(NTHREADS), LDS_BYTES, stream, a); }
#endif
}
```

```cpp
#include <hip/hip_runtime.h>
#include <cstdio>
#include <cstdint>

#ifndef PROBE_REP
#define PROBE_REP 0
#endif
#ifndef NAIVE_MLSTM
#define NAIVE_MLSTM 0
#endif
#ifndef NAIVE_ATTN
#define NAIVE_ATTN 0
#endif
#ifndef MK_ONE_LAUNCH
#define MK_ONE_LAUNCH 1
#endif

constexpr int D = 1024, BATCH = 16, SEQ = 2048, T = BATCH * SEQ, DEPTH = 2;
constexpr int MH = 4, MDH = 128, MW = 512, CONVW = 5, NMG = 16;
constexpr int AH = 4, ADH = 64, ADV = 128;
constexpr int IN_COLS = 5648, OFF_MG = 2048, OFF_DQ = 2064;
constexpr int NE = 16, CAP = 256, DFF = 2048;
constexpr int NIN = 5632;
constexpr float EPS = 1e-6f;
constexpr float LOG2E = 1.4426950408889634f;
constexpr int NWAVES = 8, NTHREADS = 512;

#define GAS __attribute__((address_space(1)))
#define LAS __attribute__((address_space(3)))
typedef unsigned short bf16;
typedef unsigned v4u __attribute__((ext_vector_type(4)));
typedef unsigned v2u __attribute__((ext_vector_type(2)));
typedef float f32x4 __attribute__((ext_vector_type(4)));
typedef float f32x2 __attribute__((ext_vector_type(2)));
typedef short bf16x8 __attribute__((ext_vector_type(8)));

__device__ __forceinline__ float bf2f(unsigned short b) { return __uint_as_float(((unsigned)b) << 16); }
__device__ __forceinline__ float bflo(unsigned w) { return __uint_as_float(w << 16); }
__device__ __forceinline__ float bfhi(unsigned w) { return __uint_as_float(w & 0xffff0000u); }
__device__ __forceinline__ unsigned f2bf(float f) { unsigned u = __float_as_uint(f); return (u + 0x7fffu + ((u >> 16) & 1u)) >> 16; }
typedef __bf16 bf16x2_n_ __attribute__((ext_vector_type(2)));
__device__ __forceinline__ unsigned pk2(float lo, float hi) { const f32x2 x = (f32x2){lo, hi}; const bf16x2_n_ v = __builtin_convertvector(x, bf16x2_n_); return __builtin_bit_cast(unsigned, v); }
__device__ __forceinline__ float wave_sum(float v) {
#pragma unroll
    for (int o = 1; o < 64; o <<= 1) v += __shfl_xor(v, o);
    return v;
}
__device__ __forceinline__ float sigmoidf_(float x) { return __builtin_amdgcn_rcpf(1.0f + __builtin_amdgcn_exp2f(-x * LOG2E)); }

namespace pg8 {
#define PG8_LAS __attribute__((address_space(3)))
typedef unsigned short bf16_t;
typedef unsigned u32x4 __attribute__((ext_vector_type(4)));
typedef int v4i __attribute__((ext_vector_type(4)));
constexpr int BM = 256, BK = 64, HALF = 128, HTB = HALF * BK * 2, STAGE_BYTES = 8 * HTB, NXCD = 8, WGM = 8;

__host__ __device__ __forceinline__ int lds_byte(int r, int c) { const int st = (r >> 4) * 2 + (c >> 5), rr = r & 15, cc = c & 31, ob = rr * 64 + cc * 2; return st * 1024 + (ob ^ (((ob >> 9) & 1) << 5)); }
__host__ __device__ __forceinline__ void stage_rc(int b, int& R, int& C) { const int st = b / 1024, sb = b % 1024, swz = sb ^ (((sb >> 9) & 1) << 5); R = (st >> 1) * 16 + swz / 64; C = (st & 1) * 32 + (swz % 64) / 2; }
__host__ __device__ __forceinline__ int perm32(int rho) { const int n = rho >> 4, i = rho & 15; return 8 * (i >> 2) + 4 * n + (i & 3); }

struct Unit { int pm, pn, bt, kofs; };

struct StdOrder {
    int nM, nN, nwg, G, c;
    __device__ void init(int M, int N, int G_, int c_) { nM = M / BM; nN = N / BM; nwg = nM * nN; G = G_; c = c_; }
    __device__ bool next(int i, Unit& u) const {
        const long L = (long)i * G + c; if (L >= nwg) return false;
        int wgid = (int)L; { const int q = nwg / NXCD, r = nwg % NXCD, xcd = wgid % NXCD, off = wgid / NXCD; wgid = (xcd < r ? xcd * (q + 1) : r * (q + 1) + (xcd - r) * q) + off; }
        const int nig = WGM * nN, gid = wgid / nig, fm = gid * WGM, gsz = (nM - fm) < WGM ? (nM - fm) : WGM;
        u.pm = fm + ((wgid % nig) % gsz); u.pn = (wgid % nig) / gsz; u.bt = u.pn; u.kofs = 0; return true;
    }
    static constexpr bool GATHER = false;
};
struct StdOrderG : StdOrder {
    static constexpr bool GATHER = true;
    __device__ __forceinline__ int a_row(const Unit& u, int r) const { return u.pm * 256 + r; }
};
struct G1Order {
    const int* idx; int G, c;
    __device__ bool next(int i, Unit& u) const {
        if (G != 256) { const int L = i * G + c; if (L >= 4096) return false; u.pm = L >> 4; u.pn = L & 15; u.bt = (u.pm & 15) * 16 + u.pn; u.kofs = 0; return true; }
        if (i >= 16) return false;
        const int xcd = c & 7, loc = c >> 3, e = 2 * xcd + (i >> 3), r = i & 7, b = (r & 3) * 4 + (loc & 3), j = (r >> 2) * 8 + (loc >> 2);
        u.pm = b * 16 + e; u.pn = j; u.bt = e * 16 + j; u.kofs = 0; return true;
    }
    static constexpr bool GATHER = true;
    __device__ __forceinline__ int a_row(const Unit& u, int r) const { return idx[u.pm * 256 + r]; }
};
struct G2Order {
    int G, c;
    __device__ bool next(int i, Unit& u) const {
        if (G != 256) { const int L = i * G + c; if (L >= 1024) return false; u.pm = L >> 2; u.pn = L & 3; u.bt = (u.pm & 15) * 4 + u.pn; u.kofs = 0; return true; }
        if (i >= 4) return false;
        const int xcd = c & 7, loc = c >> 3, e = 2 * xcd + (i >> 1), b = (i & 1) * 8 + (loc & 7), pn = loc >> 3;
        u.pm = b * 16 + e; u.pn = pn; u.bt = e * 4 + pn; u.kofs = 0; return true;
    }
    static constexpr bool GATHER = true;
    __device__ __forceinline__ int a_row(const Unit& u, int r) const { return u.pm * 256 + r; }
};

typedef float f32x2_t_ __attribute__((ext_vector_type(2))); typedef __bf16 bf16x2_t_ __attribute__((ext_vector_type(2)));
__device__ __forceinline__ unsigned cvt_pk_bf16(float lo, float hi) { const f32x2_t_ x = (f32x2_t_){lo, hi}; const bf16x2_t_ b = __builtin_convertvector(x, bf16x2_t_); return __builtin_bit_cast(unsigned, b); }

typedef f32x4 Acc[2][2][4][2];

struct EpiInproj {
    static constexpr bool PERM = true, MIDWAY = false, F8 = false;
    bf16_t *zqk, *zmv, *zmo, *zdq, *zdk, *zdv, *zg; const float* rs;
    __device__ __forceinline__ void operator()(const Acc& acc, const Unit& u, int wr, int wc, int fr, int fq) const {
        const int pn = u.pn; bf16_t* base; int ldc, colt, act = 0;
        if (pn < 4) { base = zqk; ldc = 1024; colt = pn * 256; }
        else if (pn < 6) { base = zmv; ldc = 512; colt = (pn - 4) * 256; }
        else if (pn < 8) { base = zdq; ldc = 512; colt = (pn - 6) * 256; act = 2; }
        else if (pn < 10) { base = zdk; ldc = 512; colt = (pn - 8) * 256; }
        else { base = zdv; ldc = 512; colt = (pn - 10) * 256; }
        const int row0 = u.pm * BM + wr * 64 + fr, col0 = colt + wc * 32 + 8 * fq;
#pragma unroll
        for (int ai = 0; ai < 2; ++ai)
#pragma unroll
            for (int m = 0; m < 4; ++m) { const int row = row0 + ai * HALF + m * 16; bf16_t* rowp = base + (size_t)row * ldc + col0; const float rsc = rs[row] * ((act == 2) ? 0.125f * LOG2E : 1.0f);
#pragma unroll
                for (int bj = 0; bj < 2; ++bj) { f32x4 v0 = acc[ai][bj][m][0] * rsc, v1 = acc[ai][bj][m][1] * rsc;
                    if (act == 1) {
#pragma unroll
                        for (int j = 0; j < 4; ++j) { v0[j] = sigmoidf_(v0[j]); v1[j] = sigmoidf_(v1[j]); } }
                    u32x4 w; w.x = cvt_pk_bf16(v0[0], v0[1]); w.y = cvt_pk_bf16(v0[2], v0[3]); w.z = cvt_pk_bf16(v1[0], v1[1]); w.w = cvt_pk_bf16(v1[2], v1[3]);
                    *(u32x4*)(rowp + bj * HALF) = w; } }
    }
};
#define RCPG(x) __builtin_amdgcn_rcpf(fmaxf((x), 1e-30f))
struct UpOrder : StdOrder {
    __device__ bool next(int i, Unit& u) const { if (!StdOrder::next(i >> 1, u)) return false; u.kofs = (i & 1) * 1024; return true; }
};
struct EpiUp {
    static constexpr bool PERM = true, MIDWAY = true, F8 = false;
    bf16_t* mix; const bf16_t* zg;
    __device__ __forceinline__ bool midway(Acc& acc, const Unit& u, int wr, int wc, int fr, int fq) const {
        if (u.kofs != 0) return false;
        const int row0 = u.pm * BM + wr * 64 + fr, col0 = u.pn * BM + wc * 32 + 8 * fq;
#pragma unroll
        for (int ai = 0; ai < 2; ++ai)
#pragma unroll
            for (int m = 0; m < 4; ++m) { const size_t row = (size_t)(row0 + ai * HALF + m * 16);
#pragma unroll
                for (int bj = 0; bj < 2; ++bj) { const int col = col0 + bj * HALF;
                    const u32x4 ga = *(const u32x4*)(zg + row * 2048 + col), gb = *(const u32x4*)(zg + row * 2048 + 1024 + col);
                    f32x4& v0 = acc[ai][bj][m][0]; f32x4& v1 = acc[ai][bj][m][1];
                    v0[0] *= bflo(ga.x) * RCPG(bflo(gb.x)); v0[1] *= bfhi(ga.x) * RCPG(bfhi(gb.x)); v0[2] *= bflo(ga.y) * RCPG(bflo(gb.y)); v0[3] *= bfhi(ga.y) * RCPG(bfhi(gb.y));
                    v1[0] *= bflo(ga.z) * RCPG(bflo(gb.z)); v1[1] *= bfhi(ga.z) * RCPG(bfhi(gb.z)); v1[2] *= bflo(ga.w) * RCPG(bflo(gb.w)); v1[3] *= bfhi(ga.w) * RCPG(bfhi(gb.w)); } }
        return true;
    }
    __device__ __forceinline__ void operator()(const Acc& acc, const Unit& u, int wr, int wc, int fr, int fq) const {
        const int row0 = u.pm * BM + wr * 64 + fr, col0 = u.pn * BM + wc * 32 + 8 * fq;
#pragma unroll
        for (int ai = 0; ai < 2; ++ai)
#pragma unroll
            for (int m = 0; m < 4; ++m) { const size_t row = (size_t)(row0 + ai * HALF + m * 16);
#pragma unroll
                for (int bj = 0; bj < 2; ++bj) { const int col = col0 + bj * HALF;
                    const u32x4 g = *(const u32x4*)(zg + row * 2048 + 1024 + col);
                    f32x4 v0 = acc[ai][bj][m][0], v1 = acc[ai][bj][m][1];
                    v0[0] *= bflo(g.x); v0[1] *= bfhi(g.x); v0[2] *= bflo(g.y); v0[3] *= bfhi(g.y);
                    v1[0] *= bflo(g.z); v1[1] *= bfhi(g.z); v1[2] *= bflo(g.w); v1[3] *= bfhi(g.w);
                    u32x4 w; w.x = cvt_pk_bf16(v0[0], v0[1]); w.y = cvt_pk_bf16(v0[2], v0[3]); w.z = cvt_pk_bf16(v1[0], v1[1]); w.w = cvt_pk_bf16(v1[2], v1[3]);
                    *(u32x4*)(mix + row * 1024 + col) = w; } }
    }
};
struct EpiResid {
    static constexpr bool PERM = true, MIDWAY = false, F8 = false;
    bf16_t* x;
    __device__ __forceinline__ void operator()(const Acc& acc, const Unit& u, int wr, int wc, int fr, int fq) const {
        const int row0 = u.pm * BM + wr * 64 + fr, col0 = u.pn * BM + wc * 32 + 8 * fq;
#pragma unroll
        for (int ai = 0; ai < 2; ++ai)
#pragma unroll
            for (int m = 0; m < 4; ++m) { bf16_t* rowp = x + (size_t)(row0 + ai * HALF + m * 16) * 1024 + col0;
#pragma unroll
                for (int bj = 0; bj < 2; ++bj) { const u32x4 o = *(const u32x4*)(rowp + bj * HALF); const f32x4 a0 = acc[ai][bj][m][0], a1 = acc[ai][bj][m][1];
                    u32x4 w; w.x = cvt_pk_bf16(a0[0] + bflo(o.x), a0[1] + bfhi(o.x)); w.y = cvt_pk_bf16(a0[2] + bflo(o.y), a0[3] + bfhi(o.y));
                    w.z = cvt_pk_bf16(a1[0] + bflo(o.z), a1[1] + bfhi(o.z)); w.w = cvt_pk_bf16(a1[2] + bflo(o.w), a1[3] + bfhi(o.w));
                    *(u32x4*)(rowp + bj * HALF) = w; } }
    }
};
constexpr int W8_LOG2 = 5, H8_LOG2 = 2;
constexpr float W8_SCALE = 32.0f, H8_SCALE = 4.0f;
__device__ __forceinline__ float clamp_f8(float x) { float r; asm("v_max_f32 %0, 0xc3e00000, %1\n\tv_min_f32 %0, 0x43e00000, %0" : "=v"(r) : "v"(x)); return r; }
__device__ __forceinline__ unsigned pk4_fp8(float a, float b, float c, float d) {
    int p = __builtin_amdgcn_cvt_pk_fp8_f32(clamp_f8(a), clamp_f8(b), 0, false); p = __builtin_amdgcn_cvt_pk_fp8_f32(clamp_f8(c), clamp_f8(d), p, true); return (unsigned)p; }
struct EpiG1 {
    static constexpr bool PERM = true, MIDWAY = false, F8 = true;
    unsigned char* hid;
    __device__ __forceinline__ void operator()(const Acc& acc, const Unit& u, int wr, int wc, int fr, int fq) const {
        const int row0 = u.pm * BM + wr * 64 + fr, col0 = u.pn * 128 + wc * 32 + 8 * fq;
        constexpr float SG = 1.0f / W8_SCALE;
#pragma unroll
        for (int ai = 0; ai < 2; ++ai)
#pragma unroll
            for (int m = 0; m < 4; ++m) { unsigned char* rowp = hid + (size_t)(row0 + ai * HALF + m * 16) * DFF + col0;
                f32x4 v0, v1;
#pragma unroll
                for (int j = 0; j < 4; ++j) { const float g0 = acc[ai][0][m][0][j], g1 = acc[ai][0][m][1][j];
                    v0[j] = g0 * sigmoidf_(g0 * SG) * __builtin_amdgcn_ldexpf(acc[ai][1][m][0][j], H8_LOG2 - 2 * W8_LOG2); v1[j] = g1 * sigmoidf_(g1 * SG) * __builtin_amdgcn_ldexpf(acc[ai][1][m][1][j], H8_LOG2 - 2 * W8_LOG2); }
                v2u w; w.x = pk4_fp8(v0[0], v0[1], v0[2], v0[3]); w.y = pk4_fp8(v1[0], v1[1], v1[2], v1[3]);
                *(v2u*)rowp = w; }
    }
};
struct EpiGate8 {
    static constexpr bool PERM = true, MIDWAY = false, F8 = true;
    bf16_t *zmo, *zg; const float* rs;
    __device__ __forceinline__ void operator()(const Acc& acc, const Unit& u, int wr, int wc, int fr, int fq) const {
        bf16_t* base; int ldc, colt;
        if (u.pn < 2) { base = zmo; ldc = 512; colt = u.pn * 256; } else { base = zg; ldc = 2048; colt = (u.pn - 2) * 256; }
        const int row0 = u.pm * BM + wr * 64 + fr, col0 = colt + wc * 32 + 8 * fq;
        constexpr float SG = 1.0f / W8_SCALE;
#pragma unroll
        for (int ai = 0; ai < 2; ++ai)
#pragma unroll
            for (int m = 0; m < 4; ++m) { const int row = row0 + ai * HALF + m * 16; bf16_t* rowp = base + (size_t)row * ldc + col0; const float rsc = rs[row] * SG;
#pragma unroll
                for (int bj = 0; bj < 2; ++bj) { f32x4 v0 = acc[ai][bj][m][0], v1 = acc[ai][bj][m][1];
#pragma unroll
                    for (int j = 0; j < 4; ++j) { v0[j] = sigmoidf_(v0[j] * rsc); v1[j] = sigmoidf_(v1[j] * rsc); }
                    u32x4 w; w.x = cvt_pk_bf16(v0[0], v0[1]); w.y = cvt_pk_bf16(v0[2], v0[3]); w.z = cvt_pk_bf16(v1[0], v1[1]); w.w = cvt_pk_bf16(v1[2], v1[3]);
                    *(u32x4*)(rowp + bj * HALF) = w; } }
    }
};
struct EpiG2 {
    static constexpr bool PERM = true, MIDWAY = false, F8 = true;
    bf16_t* ye; const float* gatev;
    __device__ __forceinline__ void operator()(const Acc& acc, const Unit& u, int wr, int wc, int fr, int fq) const {
        const int row0 = u.pm * BM + wr * 64 + fr, col0 = u.pn * BM + wc * 32 + 8 * fq;
#pragma unroll
        for (int ai = 0; ai < 2; ++ai)
#pragma unroll
            for (int m = 0; m < 4; ++m) { const int row = row0 + ai * HALF + m * 16; const float g = gatev[row] * (1.0f / (W8_SCALE * H8_SCALE)); bf16_t* rowp = ye + (size_t)row * 1024 + col0;
#pragma unroll
                for (int bj = 0; bj < 2; ++bj) { const f32x4 v0 = acc[ai][bj][m][0] * g, v1 = acc[ai][bj][m][1] * g;
                    u32x4 w; w.x = cvt_pk_bf16(v0[0], v0[1]); w.y = cvt_pk_bf16(v0[2], v0[3]); w.z = cvt_pk_bf16(v1[0], v1[1]); w.w = cvt_pk_bf16(v1[2], v1[3]);
                    *(u32x4*)(rowp + bj * HALF) = w; } }
    }
};

template <class Epi, class Sched>
__device__ __forceinline__ void gemm_phase(PG8_LAS unsigned char* lds, const bf16_t* Aptr, const bf16_t* Btptr, const int K, const Sched& S, const Epi& E, const int wv, const int LD = 0) {
    const int ld = LD ? LD : K;
    constexpr bool GATHER = Sched::GATHER;
    int tid_; asm volatile("v_mbcnt_lo_u32_b32 %0, -1, 0\n\tv_mbcnt_hi_u32_b32 %0, -1, %0" : "=v"(tid_)); tid_ += wv * 64;
    const int tid = tid_, wid = __builtin_amdgcn_readfirstlane(tid >> 6), lane = tid & 63, wr = wid >> 2, wc = wid & 3, fr = lane & 15, fq = lane >> 4;
    const int nt = K / BK;
    unsigned voffA[2], voffB[2];
#pragma unroll
    for (int i = 0; i < 2; ++i) { int R, C; stage_rc(tid * 16 + i * 8192, R, C); const int Rb = Epi::PERM ? ((R & ~31) + perm32(R & 31)) : R;
        voffA[i] = (unsigned)(R * ld + C) * 2u; voffB[i] = (unsigned)(Rb * ld + C) * 2u; }
    const size_t kstep = (size_t)(BK * 2);
    const size_t hstep = (size_t)HALF * ld * 2;
    const size_t tstep = 2 * hstep;
    const unsigned ldsw = (unsigned)wid * 1024u;
    const int aoff = lds_byte(wr * 64 + fr, fq * 8), boff = lds_byte(wc * 32 + fr, fq * 8);
#define PG8_SA(b, h) (((b) * 2 + (h)) * HTB)
#define PG8_SB(b, h) ((4 + (b) * 2 + (h)) * HTB)
#define PG8_STAGE(bufoff, gbase, voff) do { _Pragma("unroll") for (int _i = 0; _i < 2; ++_i) \
        __builtin_amdgcn_global_load_lds((const unsigned*)((const char*)(gbase) + (voff)[_i]), (PG8_LAS unsigned*)(lds + (bufoff) + ldsw + _i * 8192), 16, 0, 0); } while (0)
#define PG8_STAGE_A(bufoff, gbase, h) do { if constexpr (GATHER) { PG8_STAGE(bufoff, gbase, vg[h]); } else { PG8_STAGE(bufoff, (gbase) + (h) * hstep, voffA); } } while (0)
#define PG8_LDA(dst, b, h) do { _Pragma("unroll") for (int m = 0; m < 4; ++m) _Pragma("unroll") for (int k = 0; k < 2; ++k) dst[m][k] = *(const PG8_LAS bf16x8*)(lds + PG8_SA(b, h) + aoff + m * 2048 + k * 1024); } while (0)
#define PG8_LDB(dst, b, h) do { _Pragma("unroll") for (int n = 0; n < 2; ++n) _Pragma("unroll") for (int k = 0; k < 2; ++k) dst[n][k] = *(const PG8_LAS bf16x8*)(lds + PG8_SB(b, h) + boff + n * 2048 + k * 1024); } while (0)
#define PG8_CAT(x, y) __builtin_shufflevector((v4i)(x), (v4i)(y), 0, 1, 2, 3, 4, 5, 6, 7)
#define PG8_MMA(ai, bj, At, Bt) do { __builtin_amdgcn_s_setprio(1); if constexpr (Epi::F8) { _Pragma("unroll") for (int m = 0; m < 4; ++m) _Pragma("unroll") for (int n = 0; n < 2; ++n) \
        acc[ai][bj][m][n] = __builtin_amdgcn_mfma_scale_f32_16x16x128_f8f6f4(PG8_CAT(Bt[n][0], Bt[n][1]), PG8_CAT(At[m][0], At[m][1]), acc[ai][bj][m][n], 0, 0, 0, sc1, 0, sc1); } \
    else { _Pragma("unroll") for (int m = 0; m < 4; ++m) _Pragma("unroll") for (int n = 0; n < 2; ++n) _Pragma("unroll") for (int k = 0; k < 2; ++k) \
        acc[ai][bj][m][n] = __builtin_amdgcn_mfma_f32_16x16x32_bf16(Bt[n][k], At[m][k], acc[ai][bj][m][n], 0, 0, 0); } __builtin_amdgcn_s_setprio(0); } while (0)
#define PG8_WAIT_V(n) asm volatile("s_waitcnt vmcnt(" #n ")" ::: "memory")
#define PG8_WAIT_L(n) asm volatile("s_waitcnt lgkmcnt(" #n ")" ::: "memory")
#define PG8_BAR __builtin_amdgcn_s_barrier()
#define PG8_SCHED __builtin_amdgcn_sched_barrier(0)
#define PG8_GOFFS(u) do { _Pragma("unroll") for (int _h = 0; _h < 2; ++_h) _Pragma("unroll") for (int _i = 0; _i < 2; ++_i) { \
        int _R, _C; stage_rc(tid * 16 + _i * 8192, _R, _C); vg[_h][_i] = ((unsigned)S.a_row(u, _h * HALF + _R) * (unsigned)ld + (unsigned)_C) * 2u; } } while (0)
    Unit cur, nxt; int ui = 0;
    if (!S.next(0, cur)) return;
    int sc1 = 0x7f7f7f7f; asm volatile("" : "+v"(sc1));
    float zf = 0.f; asm volatile("" : "+v"(zf));
    f32x4 acc[2][2][4][2];
#pragma unroll
    for (int a = 0; a < 2; ++a)
#pragma unroll
        for (int b = 0; b < 2; ++b)
#pragma unroll
            for (int m = 0; m < 4; ++m)
#pragma unroll
                for (int n = 0; n < 2; ++n) acc[a][b][m][n] = (f32x4){zf, zf, zf, zf};
    bf16x8 At[4][2], B0[2][2], B1[2][2];
    unsigned vg[2][2] = {{0u, 0u}, {0u, 0u}};
    const char* cA = (const char*)Aptr + cur.kofs; const char* cB = (const char*)Btptr + (size_t)cur.bt * tstep + cur.kofs;
    if constexpr (GATHER) { PG8_GOFFS(cur); } else { cA += (size_t)cur.pm * tstep; }
    PG8_STAGE(PG8_SB(0, 0), cB, voffB); PG8_STAGE(PG8_SB(0, 1), cB + hstep, voffB); PG8_STAGE_A(PG8_SA(0, 0), cA, 0); PG8_STAGE_A(PG8_SA(0, 1), cA, 1);
    if (wr == 1) PG8_BAR;
    PG8_WAIT_V(2); PG8_BAR;
    PG8_STAGE(PG8_SB(1, 0), cB + kstep, voffB); PG8_STAGE_A(PG8_SA(1, 0), cA + kstep, 0); PG8_STAGE(PG8_SB(1, 1), cB + hstep + kstep, voffB);
    PG8_WAIT_V(6); PG8_BAR;
    for (;;) {
        const bool has_next = S.next(ui + 1, nxt);
        const char* nA = cA; if constexpr (!GATHER) { if (has_next) nA = (const char*)Aptr + (size_t)nxt.pm * tstep + nxt.kofs; }
        const char* nB = has_next ? (const char*)Btptr + (size_t)nxt.bt * tstep + nxt.kofs : cB;
        for (int t = 0; t < nt; t += 2) {
            const bool last = (t == nt - 2);
            const char* a1 = cA + (size_t)(t + 1) * kstep;
            const char* a2 = last ? nA : cA + (size_t)(t + 2) * kstep; const char* b2 = last ? nB : cB + (size_t)(t + 2) * kstep;
            const char* a3 = a2 + kstep; const char* b3 = b2 + kstep;
            PG8_LDB(B0, 0, 0); PG8_LDB(B1, 0, 1); PG8_SCHED; PG8_LDA(At, 0, 0); PG8_STAGE_A(PG8_SA(1, 1), a1, 1);
            if constexpr (GATHER) { if (last && has_next) { PG8_GOFFS(nxt); } }
            PG8_WAIT_V(8); PG8_WAIT_L(0); PG8_BAR; PG8_MMA(0, 0, At, B0); PG8_MMA(0, 1, At, B1); PG8_BAR; PG8_SCHED;
            PG8_LDA(At, 0, 1); PG8_STAGE(PG8_SB(0, 0), b2, voffB); PG8_STAGE(PG8_SB(0, 1), b2 + hstep, voffB); PG8_STAGE_A(PG8_SA(0, 0), a2, 0);
            PG8_WAIT_V(8); PG8_WAIT_L(0); PG8_BAR; PG8_MMA(1, 0, At, B0); PG8_MMA(1, 1, At, B1); PG8_BAR; PG8_SCHED;
            PG8_LDB(B0, 1, 0); PG8_LDB(B1, 1, 1); PG8_SCHED; PG8_LDA(At, 1, 0); PG8_STAGE_A(PG8_SA(0, 1), a2, 1);
            PG8_WAIT_V(8); PG8_WAIT_L(0); PG8_BAR; PG8_MMA(0, 0, At, B0); PG8_MMA(0, 1, At, B1); PG8_BAR; PG8_SCHED;
            PG8_LDA(At, 1, 1); PG8_STAGE(PG8_SB(1, 0), b3, voffB); PG8_STAGE(PG8_SB(1, 1), b3 + hstep, voffB); PG8_STAGE_A(PG8_SA(1, 0), a3, 0);
            PG8_WAIT_V(8); PG8_WAIT_L(0); PG8_BAR; PG8_MMA(1, 0, At, B0); PG8_MMA(1, 1, At, B1); PG8_BAR; PG8_SCHED;
        }
        if (wr == 0) PG8_BAR;
        bool keep = false;
        if constexpr (Epi::MIDWAY) keep = E.midway(acc, cur, wr, wc, fr, fq);
        if (!keep) E(acc, cur, wr, wc, fr, fq);
        if (!has_next) break;
        if (!keep) {
#pragma unroll
        for (int a = 0; a < 2; ++a)
#pragma unroll
            for (int b = 0; b < 2; ++b)
#pragma unroll
                for (int m = 0; m < 4; ++m)
#pragma unroll
                    for (int n = 0; n < 2; ++n) acc[a][b][m][n] = (f32x4){zf, zf, zf, zf};
        }
        cur = nxt; cA = nA; cB = nB; ++ui;
        if (wr == 1) PG8_BAR;
    }
    PG8_WAIT_V(0);
    PG8_BAR;
#undef PG8_SA
#undef PG8_SB
#undef PG8_STAGE
#undef PG8_STAGE_A
#undef PG8_LDA
#undef PG8_LDB
#undef PG8_MMA
#undef PG8_CAT
#undef PG8_WAIT_V
#undef PG8_WAIT_L
#undef PG8_BAR
#undef PG8_SCHED
#undef PG8_GOFFS
}
}

constexpr size_t MiB = 1u << 20;
constexpr size_t WS_CTL = 0, CTL_ZERO_BYTES = 1 * MiB;
constexpr size_t WS_MG = 1 * MiB, WS_AFF = 3 * MiB, WS_INV = 5 * MiB, WS_IDX = 7 * MiB, WS_GATEV = 7 * MiB + 256 * 1024, WS_RSTD1 = 7 * MiB + 512 * 1024;
constexpr size_t WS_WIN = 8 * MiB, WS_WA = 19 * MiB, WS_WB = 20 * MiB, WS_WO = 21 * MiB, WS_WGU = 24 * MiB, WS_WD = 152 * MiB;
constexpr size_t WS_WGU_L1 = 88 * MiB, WS_WD_L1 = 184 * MiB, WS_WA_L1 = 888 * MiB, WS_WO_L1 = 890 * MiB;
constexpr size_t WS_XB = 216 * MiB;
constexpr size_t WS_WIN8 = WS_WIN + (size_t)3584 * 2048;
constexpr size_t WS_ZQK = 280 * MiB, WS_ZMV = 344 * MiB, WS_ZMO = 376 * MiB, WS_ZDQ = 408 * MiB, WS_ZDK = 440 * MiB, WS_ZDV = 472 * MiB, WS_ZG = 504 * MiB;
constexpr size_t WS_HM = 632 * MiB, WS_HD = 664 * MiB, WS_MIX = 696 * MiB, WS_HF = 760 * MiB, WS_HB = 824 * MiB, WS_END = 888 * MiB;
constexpr size_t WS_XR = 892 * MiB, WS_END2 = 956 * MiB;
constexpr size_t WS_HID = 280 * MiB, WS_YE = 536 * MiB;
constexpr int CW_BAR = 4096;

constexpr int RING_BYTES = 131072;
constexpr int LDSCTL_OFF = RING_BYTES, MISC_OFF = LDSCTL_OFF + 320;
constexpr int LDS_BYTES = 147456;

#define XB_TMO      128
#define XB_XCNT(j)  (256  + 64 * (j))
#define XB_XSUB(j)  (1280 + 64 * (j))
#define XB_XGEN(j)  (2304 + 64 * (j))
#define XB_TOP      3328
#define XB_TOPGEN   3392
#define XCD_BAR_WORDS 3456
#define XB_SPIN_CAP (1u << 22)
__device__ __forceinline__ unsigned xb_ld(unsigned* p)              { return __hip_atomic_load(p, __ATOMIC_RELAXED, __HIP_MEMORY_SCOPE_AGENT); }
__device__ __forceinline__ unsigned xb_add(unsigned* p, unsigned v) { return __hip_atomic_fetch_add(p, v, __ATOMIC_RELAXED, __HIP_MEMORY_SCOPE_AGENT); }
__device__ __forceinline__ unsigned xb_xcc_id() { return (unsigned)__builtin_amdgcn_s_getreg((3 << 11) | 20) & 0xFu; }
#define XB_SPIN(cond, bar) do { unsigned _sp = 0; while (cond) { __builtin_amdgcn_s_sleep(1); \
    if ((++_sp & 255u) == 0u) { if (xb_ld(&(bar)[XB_TMO])) break; if (_sp > XB_SPIN_CAP) { atomicAdd(&(bar)[XB_TMO], 1u); break; } } } } while (0)
struct XcdBarrier { unsigned* bar; unsigned x; volatile LAS unsigned* st; };
__device__ __forceinline__ XcdBarrier xcd_barrier_post(unsigned* bar, volatile LAS unsigned* st) {
    XcdBarrier b; b.bar = bar; b.x = xb_xcc_id(); b.st = st;
    if (threadIdx.x == 0) (void)xb_add(&bar[XB_XCNT(b.x)], 1u);
    return b;
}
__device__ __forceinline__ void xcd_barrier_complete(unsigned* bar, unsigned x, unsigned& nloc, unsigned& nx) {
    const unsigned G = gridDim.x * gridDim.y * gridDim.z;
    unsigned sum, cnt, mine, sp = 0u;
    for (;;) {
        sum = 0u; cnt = 0u; mine = 0u;
#pragma unroll
        for (unsigned j = 0; j < 16; ++j) { const unsigned c = xb_ld(&bar[XB_XCNT(j)]); sum += c; cnt += (c > 0u) ? 1u : 0u; mine = (j == x) ? c : mine; }
        if (sum == G) break;
        __builtin_amdgcn_s_sleep(1);
        if ((++sp & 255u) == 0u) { if (xb_ld(&bar[XB_TMO])) break; if (sp > XB_SPIN_CAP) { atomicAdd(&bar[XB_TMO], 1u); break; } }
    }
    nloc = mine > 0u ? mine : 1u; nx = cnt > 0u ? cnt : 1u;
}
__device__ __forceinline__ void xcd_barrier(const XcdBarrier& b) {
    asm volatile("s_waitcnt vmcnt(0)" ::: "memory");
    __syncthreads();
    if (threadIdx.x == 0) {
        unsigned* bar = b.bar;
        __builtin_amdgcn_s_waitcnt(0);
        unsigned nloc = b.st[0], nx = b.st[1];
        if (nloc == 0u) { xcd_barrier_complete(bar, b.x, nloc, nx); b.st[0] = nloc; b.st[1] = nx; }
        const unsigned old = xb_add(&bar[XB_XSUB(b.x)], 1u);
        const unsigned gen = old / nloc;
        if (old + 1u == (gen + 1u) * nloc) {
            __builtin_amdgcn_fence(__ATOMIC_RELEASE, "agent");
            asm volatile("s_waitcnt vmcnt(0)" ::: "memory");
            const unsigned og = xb_add(&bar[XB_TOP], 1u);
            const unsigned tg = og / nx;
            if (og + 1u == (tg + 1u) * nx) xb_add(&bar[XB_TOPGEN], 1u);
            else XB_SPIN(xb_ld(&bar[XB_TOPGEN]) == tg, bar);
            __builtin_amdgcn_fence(__ATOMIC_ACQUIRE, "agent");
            xb_add(&bar[XB_XGEN(b.x)], 1u);
            asm volatile("s_waitcnt vmcnt(0)" ::: "memory");
        } else {
            XB_SPIN(xb_ld(&bar[XB_XGEN(b.x)]) == gen, bar);
            __builtin_amdgcn_fence(__ATOMIC_ACQUIRE, "agent");
            asm volatile("s_waitcnt vmcnt(0)" ::: "memory");
        }
    }
    __syncthreads();
}

struct Args { const float* in[18]; float* out; unsigned char* ws; int ph_lo, ph_hi; };
enum { I_X = 0, I_NMG, I_WIN, I_BMG, I_CW, I_CB, I_MNG, I_LAM, I_DNG, I_WUA, I_WUB, I_WOUT, I_NFG, I_WR, I_WGE, I_WUE, I_WDE, I_NF };

struct Frame {
    LAS unsigned char* lds;
    int G, bx, wv;
    const float* in[18];
    float* X;
    unsigned char* ws;
};
#define WSP(type, off) ((type*)(F.ws + (off)))
__device__ __forceinline__ int lane_id_volatile() { int l; asm volatile("v_mbcnt_lo_u32_b32 %0, -1, 0\n\tv_mbcnt_hi_u32_b32 %0, -1, %0" : "=v"(l)); return l; }
#define PH_IDS int tid = F.wv * 64 + lane_id_volatile(); const int lane = tid & 63; const int wave = __builtin_amdgcn_readfirstlane(tid >> 6); (void)lane; (void)wave

struct CvItem { const float* W; bf16* WT; int pitch, Kdst, k0, f8; const float* gk; };
__device__ __forceinline__ void cv_load(const CvItem& c, int lane, f32x4 (&v)[16]) {
    const int rsh = c.f8 ? 3 : 4, lr = lane >> rsh, lc = (lane & ((1 << rsh) - 1)) * 4, rpi = 64 >> rsh;
    const float* src = c.W + (size_t)(c.k0 + lr) * c.pitch + lc; const size_t step = (size_t)rpi * c.pitch;
#pragma unroll
    for (int i = 0; i < 16; ++i) v[i] = __builtin_nontemporal_load((const f32x4*)(src + i * step));
}
__device__ __forceinline__ void cv_store(const CvItem& c, int lane, const f32x4 (&v)[16], LAS float* scr) {
    if (c.f8) {
#pragma unroll
        for (int i = 0; i < 16; ++i) { const int k = 8 * i + (lane >> 3), n = (lane & 7) * 4; *(LAS f32x4*)(scr + k * 32 + (n ^ (((k >> 4) & 7) << 2))) = v[i]; }
        asm volatile("s_waitcnt lgkmcnt(0)" ::: "memory");
        float gs[16];
        if (c.gk) {
#pragma unroll
            for (int j4 = 0; j4 < 4; ++j4) { const f32x4 g4 = *(const f32x4*)(c.gk + c.k0 + 16 * (lane & 7) + 4 * j4); gs[4 * j4] = g4.x; gs[4 * j4 + 1] = g4.y; gs[4 * j4 + 2] = g4.z; gs[4 * j4 + 3] = g4.w; } }
        else {
#pragma unroll
            for (int j = 0; j < 16; ++j) gs[j] = 1.0f; }
#pragma unroll
        for (int it = 0; it < 4; ++it) { const int n = it * 8 + (lane >> 3), kc = lane & 7; const LAS float* sp = scr + (16 * kc) * 32 + (n ^ (kc << 2));
            float f[16];
#pragma unroll
            for (int j = 0; j < 16; ++j) f[j] = __builtin_amdgcn_ldexpf(sp[j * 32] * gs[j], pg8::W8_LOG2);
            v4u o; o.x = pg8::pk4_fp8(f[0], f[1], f[2], f[3]); o.y = pg8::pk4_fp8(f[4], f[5], f[6], f[7]); o.z = pg8::pk4_fp8(f[8], f[9], f[10], f[11]); o.w = pg8::pk4_fp8(f[12], f[13], f[14], f[15]);
            *(v4u*)((unsigned char*)c.WT + (size_t)n * c.Kdst + c.k0 + 16 * kc) = o; }
        asm volatile("s_waitcnt lgkmcnt(0)" ::: "memory");
        return;
    }
#pragma unroll
    for (int i = 0; i < 16; ++i) { const int k = 4 * i + (lane >> 4), n = (lane & 15) * 4; *(LAS f32x4*)(scr + k * 64 + (n ^ (((k >> 3) & 7) << 2))) = v[i]; }
    asm volatile("s_waitcnt lgkmcnt(0)" ::: "memory");
    float gb[8];
    if (c.gk) { const f32x4 g0 = *(const f32x4*)(c.gk + c.k0 + 8 * (lane & 7)), g1 = *(const f32x4*)(c.gk + c.k0 + 8 * (lane & 7) + 4); gb[0] = g0.x; gb[1] = g0.y; gb[2] = g0.z; gb[3] = g0.w; gb[4] = g1.x; gb[5] = g1.y; gb[6] = g1.z; gb[7] = g1.w; }
    else {
#pragma unroll
        for (int j = 0; j < 8; ++j) gb[j] = 1.0f; }
#pragma unroll
    for (int it = 0; it < 8; ++it) { const int n = it * 8 + (lane >> 3), kc = lane & 7; const LAS float* sp = scr + (8 * kc) * 64 + (n ^ (kc << 2));
        v4u o; o.x = pk2(sp[0 * 64] * gb[0], sp[1 * 64] * gb[1]); o.y = pk2(sp[2 * 64] * gb[2], sp[3 * 64] * gb[3]); o.z = pk2(sp[4 * 64] * gb[4], sp[5 * 64] * gb[5]); o.w = pk2(sp[6 * 64] * gb[6], sp[7 * 64] * gb[7]);
        *(v4u*)(c.WT + (size_t)n * c.Kdst + c.k0 + 8 * kc) = o; }
    asm volatile("s_waitcnt lgkmcnt(0)" ::: "memory");
}
__device__ __forceinline__ CvItem cv_decode(Frame& F, int l, int it) {
    constexpr int J0 = 16 * 32, J1 = 16 * 56, J2 = 8 * 16, J3 = 8 * 16, J4 = 16 * 16, J5 = 16 * 16 * 32, J6 = J5;
    const float* w_in = F.in[I_WIN] + (size_t)l * D * IN_COLS;
    int r = it; CvItem c; c.f8 = 0; c.gk = nullptr;
    if (r < J0 + J1) c.gk = F.in[I_NMG] + (size_t)l * D;
    if (r < J0) { if (r < 16 * 24) { const int kb = r / 24, nb = r % 24; c.W = w_in + nb * 64; c.pitch = IN_COLS; c.WT = WSP(bf16, WS_WIN) + (size_t)(nb * 64) * D; c.Kdst = D; c.k0 = kb * 64; return c; }
        r -= 16 * 24; const int kb = r / 16, nb = r % 16;
        c.W = w_in + 1536 + nb * 32; c.pitch = IN_COLS; c.f8 = 1; c.WT = (bf16*)(F.ws + WS_WIN8 + (size_t)(nb * 32) * D); c.Kdst = D; c.k0 = kb * 128; return c; } r -= J0;
    if (r < J1) { if (r < 16 * 24) { const int kb = r / 24, nb = r % 24; c.W = w_in + OFF_DQ + nb * 64; c.pitch = IN_COLS; c.WT = WSP(bf16, WS_WIN) + (size_t)(1536 + nb * 64) * D; c.Kdst = D; c.k0 = kb * 64; return c; }
        r -= 16 * 24; const int kb = r / 64, nb = r % 64;
        c.W = w_in + OFF_DQ + 1536 + nb * 32; c.pitch = IN_COLS; c.f8 = 1; c.WT = (bf16*)(F.ws + WS_WIN8 + (size_t)(512 + nb * 32) * D); c.Kdst = D; c.k0 = kb * 128; return c; } r -= J1;
    if (r < J2) { const int kb = r / 16, nb = r % 16; c.W = F.in[I_WUA] + (size_t)l * MW * D + nb * 64; c.pitch = D; c.WT = WSP(bf16, l == 0 ? WS_WA : WS_WA_L1) + (size_t)(nb * 64) * 1024; c.Kdst = 1024; c.k0 = kb * 64; return c; } r -= J2;
    if (r < J3) { const int kb = r / 16, nb = r % 16; c.W = F.in[I_WUB] + (size_t)l * MW * D + nb * 64; c.pitch = D; c.WT = WSP(bf16, l == 0 ? WS_WA : WS_WA_L1) + (size_t)(nb * 64) * 1024 + 512; c.Kdst = 1024; c.k0 = kb * 64; return c; } r -= J3;
    if (r < J4) { const int kb = r / 16, nb = r % 16; c.W = F.in[I_WOUT] + (size_t)l * D * D + nb * 64; c.pitch = D; c.WT = WSP(bf16, l == 0 ? WS_WO : WS_WO_L1) + (size_t)(nb * 64) * D; c.Kdst = D; c.k0 = kb * 64; return c; } r -= J4;
    if (r < J5 + J6) { const int up = r >= J5; if (up) r -= J5; const int e = r / 512, q = r % 512, kb = q / 64, nb = q % 64, col = nb * 32;
        c.W = (up ? F.in[I_WUE] : F.in[I_WGE]) + ((size_t)l * NE + e) * D * DFF + col; c.pitch = DFF; c.f8 = 1;
        c.WT = (bf16*)(F.ws + (l == 0 ? WS_WGU : WS_WGU_L1) + (size_t)((e * 16 + (col >> 7)) * 256 + up * 128 + (col & 127)) * D); c.Kdst = D; c.k0 = kb * 128; return c; } r -= J5 + J6;
    { const int e = r / 512, q = r % 512, kb = q / 32, nb = q % 32;
      c.W = F.in[I_WDE] + ((size_t)l * NE + e) * DFF * D + nb * 32; c.pitch = D; c.f8 = 1; c.WT = (bf16*)(F.ws + (l == 0 ? WS_WD : WS_WD_L1) + (size_t)(e * 1024 + nb * 32) * DFF); c.Kdst = DFF; c.k0 = kb * 128; return c; }
}
constexpr int CV_GU0 = 16 * 32 + 16 * 56 + 8 * 16 + 8 * 16 + 16 * 16, CV_GU1 = CV_GU0 + 2 * 16 * 16 * 32, CV_NITEMS = CV_GU1 + 16 * 32 * 16;
__device__ __forceinline__ void cv_run(Frame& F, int l, int lane, LAS float* scr, int first, int count, int wi, int nw) {
    f32x4 va[16], vb[16];
    int it = wi;
    if (it >= count) return;
    CvItem ca = cv_decode(F, l, first + it), cbn = ca;
    cv_load(ca, lane, va);
#pragma unroll 1
    for (;;) {
        const bool hb = (it + nw < count);
        if (hb) { cbn = cv_decode(F, l, first + it + nw); cv_load(cbn, lane, vb); }
        cv_store(ca, lane, va, scr);
        if (!hb) break;
        it += nw;
        const bool ha = (it + nw < count);
        if (ha) { ca = cv_decode(F, l, first + it + nw); cv_load(ca, lane, va); }
        cv_store(cbn, lane, vb, scr);
        if (!ha) break;
        it += nw;
    }
}
constexpr int CV_WIN = 16 * 32 + 16 * 56;
__device__ __forceinline__ void ph_convert(Frame& F, int l) {
    PH_IDS;
    LAS float* scr = (LAS float*)(F.lds + wave * 16384);
    const int gw = F.bx * NWAVES + wave, NGW = F.G * NWAVES;
    cv_run(F, l, lane, scr, 0, CV_WIN, gw, NGW);
}

__device__ __forceinline__ void stage_w16(int tid, LAS float* w16, const float* src, int pitch) {
    __syncthreads();
    f32x4 w[8];
#pragma unroll
    for (int n = 0; n < 8; ++n) { const int i = tid + NTHREADS * n, k = i >> 2, q = i & 3; w[n] = *(const f32x4*)(src + (size_t)k * pitch + q * 4); }
#pragma unroll
    for (int n = 0; n < 8; ++n) { const int i = tid + NTHREADS * n, k = i >> 2, q = i & 3; *(LAS f32x4*)(w16 + ((((k >> 8) * 4 + (k & 3)) * 4 + q) * 64 + ((k & 255) >> 2)) * 4) = w[n]; }
    __syncthreads();
}
template <int N> __device__ __forceinline__ float row_ror_add(float x) { return x + __int_as_float(__builtin_amdgcn_update_dpp(0, __float_as_int(x), 0x120 + N, 0xf, 0xf, false)); }
template <int N> __device__ __forceinline__ float row_ror_max(float x) { return fmaxf(x, __int_as_float(__builtin_amdgcn_update_dpp(0, __float_as_int(x), 0x120 + N, 0xf, 0xf, false))); }
__device__ __forceinline__ float xrow_sum(float v) {
    auto a = __builtin_amdgcn_permlane16_swap(__float_as_uint(v), __float_as_uint(v), false, false); v = __uint_as_float(a[0]) + __uint_as_float(a[1]);
    auto b = __builtin_amdgcn_permlane32_swap(__float_as_uint(v), __float_as_uint(v), false, false); return __uint_as_float(b[0]) + __uint_as_float(b[1]); }
__device__ __forceinline__ float xrow_max(float v) {
    auto a = __builtin_amdgcn_permlane16_swap(__float_as_uint(v), __float_as_uint(v), false, false); v = fmaxf(__uint_as_float(a[0]), __uint_as_float(a[1]));
    auto b = __builtin_amdgcn_permlane32_swap(__float_as_uint(v), __float_as_uint(v), false, false); return fmaxf(__uint_as_float(b[0]), __uint_as_float(b[1])); }
__device__ __forceinline__ float wave_sum_fast(float v) { v = row_ror_add<8>(v); v = row_ror_add<4>(v); v = row_ror_add<2>(v); v = row_ror_add<1>(v); return xrow_sum(v); }
template <int R> __device__ __forceinline__ void proj16(const f32x4 (&h)[R][4], const LAS float* w16, int lane, float (&t)[R][4]) {
    float p[R][16];
#pragma unroll
    for (int r = 0; r < R; ++r)
#pragma unroll
        for (int j = 0; j < 16; ++j) p[r][j] = 0.f;
    int lane4 = 4 * lane; asm volatile("" : "+v"(lane4) : "v"(h[0][0][0]), "v"(h[R - 1][0][0]));
#pragma unroll
    for (int jj = 0; jj < 4; ++jj)
#pragma unroll
        for (int c = 0; c < 4; ++c) {
#pragma unroll
            for (int q = 0; q < 4; ++q) { const f32x4 w = *(const LAS f32x4*)(w16 + ((jj * 4 + c) * 4 + q) * 256 + lane4);
#pragma unroll
                for (int r = 0; r < R; ++r) { const float hv = h[r][jj][c]; p[r][4 * q + 0] += hv * w.x; p[r][4 * q + 1] += hv * w.y; p[r][4 * q + 2] += hv * w.z; p[r][4 * q + 3] += hv * w.w; } }
            if (c & 1) {
#pragma unroll
                for (int r = 0; r < R; ++r) asm volatile("" : "+v"(p[r][0]), "+v"(p[r][1]), "+v"(p[r][2]), "+v"(p[r][3]), "+v"(p[r][4]), "+v"(p[r][5]), "+v"(p[r][6]), "+v"(p[r][7]), "+v"(p[r][8]), "+v"(p[r][9]), "+v"(p[r][10]), "+v"(p[r][11]), "+v"(p[r][12]), "+v"(p[r][13]), "+v"(p[r][14]), "+v"(p[r][15]) :: "memory"); } }
#pragma unroll
    for (int r = 0; r < R; ++r) {
        float q8[8];
#pragma unroll
        for (int j = 0; j < 8; ++j) { auto rr = __builtin_amdgcn_permlane32_swap(__float_as_uint(p[r][j]), __float_as_uint(p[r][j + 8]), false, false); q8[j] = __uint_as_float(rr[0]) + __uint_as_float(rr[1]); }
#pragma unroll
        for (int m = 0; m < 4; ++m) { auto rr = __builtin_amdgcn_permlane16_swap(__float_as_uint(q8[m]), __float_as_uint(q8[m + 4]), false, false); float v = __uint_as_float(rr[0]) + __uint_as_float(rr[1]);
            v = row_ror_add<8>(v); v = row_ror_add<4>(v); v = row_ror_add<2>(v); v = row_ror_add<1>(v); t[r][m] = v; } }
}
__device__ __forceinline__ f32x4 ldx4(const bf16* p) { const v2u w = *(const v2u*)p; return (f32x4){bflo(w.x), bfhi(w.x), bflo(w.y), bfhi(w.y)}; }
__device__ __forceinline__ void store_bf16_row(bf16* dst, const f32x4 (&h)[4], int lane) {
#pragma unroll
    for (int j = 0; j < 4; ++j) { v2u o; o.x = pk2(h[j].x, h[j].y); o.y = pk2(h[j].z, h[j].w); *(v2u*)(dst + 256 * j + 4 * lane) = o; }
}
__device__ __forceinline__ void rms_row(const f32x4 (&v)[4], const float* g, int lane, f32x4 (&h)[4]) {
    float s = 0.f;
#pragma unroll
    for (int j = 0; j < 4; ++j) s += (v[j].x * v[j].x + v[j].y * v[j].y) + (v[j].z * v[j].z + v[j].w * v[j].w);
    const float rstd = 1.0f / sqrtf(wave_sum_fast(s) * (1.0f / D) + EPS);
#pragma unroll
    for (int j = 0; j < 4; ++j) { const f32x4 gg = *(const f32x4*)(g + 256 * j + 4 * lane); h[j] = v[j] * rstd * gg; }
}
template <int R> __device__ __forceinline__ void prep1_rows(Frame& F, int lane, int l, int row0, int rstep, const f32x4 (&v)[R][4]) {
    (void)l;
#pragma unroll
    for (int r = 0; r < R; ++r) {
        float ss = 0.f;
#pragma unroll
        for (int j = 0; j < 4; ++j) ss += (v[r][j].x * v[r][j].x + v[r][j].y * v[r][j].y) + (v[r][j].z * v[r][j].z + v[r][j].w * v[r][j].w);
        const float rstd = 1.0f / sqrtf(wave_sum_fast(ss) * (1.0f / D) + EPS);
        if (lane == 0) WSP(float, WS_RSTD1)[row0 + r * rstep] = rstd;
#pragma unroll
        for (int j = 0; j < 4; ++j) *(unsigned*)(F.ws + WS_MIX + (size_t)(row0 + r * rstep) * D + 256 * j + 4 * lane) = pg8::pk4_fp8(v[r][j].x, v[r][j].y, v[r][j].z, v[r][j].w); }
}
__device__ __forceinline__ void ph_prep_first(Frame& F) {
    PH_IDS;
    const int gw = F.bx * NWAVES + wave, NGW = F.G * NWAVES;
    f32x4 v[2][4];
#pragma unroll
    for (int r = 0; r < 2; ++r)
#pragma unroll
        for (int j = 0; j < 4; ++j) v[r][j] = *(const f32x4*)(F.in[I_X] + (size_t)(gw + r * NGW) * D + 256 * j + 4 * lane);
#pragma unroll 1
    for (int row = gw; row < T; row += 2 * NGW) {
        f32x4 vn[2][4];
        const int nrow = (row + 2 * NGW < T) ? row + 2 * NGW : row;
#pragma unroll
        for (int r = 0; r < 2; ++r)
#pragma unroll
            for (int j = 0; j < 4; ++j) { vn[r][j] = *(const f32x4*)(F.in[I_X] + (size_t)(nrow + r * NGW) * D + 256 * j + 4 * lane); { v2u o; o.x = pk2(v[r][j].x, v[r][j].y); o.y = pk2(v[r][j].z, v[r][j].w); *(v2u*)(WSP(bf16, WS_XR) + (size_t)(row + r * NGW) * D + 256 * j + 4 * lane) = o; } }
        prep1_rows<2>(F, lane, 0, row, NGW, v);
#pragma unroll
        for (int r = 0; r < 2; ++r)
#pragma unroll
            for (int j = 0; j < 4; ++j) v[r][j] = vn[r][j];
    }
    __syncthreads();
}
__device__ __forceinline__ void stage_wmf(int tid, LAS unsigned char* img, const float* src, int pitch, const float* g) {
    __syncthreads();
    for (int idx = tid; idx < 32 * 64; idx += NTHREADS) { const int s = idx >> 6, ln = idx & 63, j = ln & 15, q = ln >> 4;
        unsigned hi[4], lo[4];
#pragma unroll
        for (int t2 = 0; t2 < 4; ++t2) { const int k = 32 * s + 8 * q + 2 * t2;
            const float w0 = src[(size_t)k * pitch + j] * g[k], w1 = src[(size_t)(k + 1) * pitch + j] * g[k + 1];
            const unsigned h0 = f2bf(w0), h1 = f2bf(w1); hi[t2] = h0 | (h1 << 16);
            lo[t2] = f2bf(w0 - bf2f((unsigned short)h0)) | (f2bf(w1 - bf2f((unsigned short)h1)) << 16); }
        *(LAS v4u*)(img + ((s * 2 + 0) * 64 + ln) * 16) = (v4u){hi[0], hi[1], hi[2], hi[3]};
        *(LAS v4u*)(img + ((s * 2 + 1) * 64 + ln) * 16) = (v4u){lo[0], lo[1], lo[2], lo[3]}; }
    __syncthreads();
}
__device__ __forceinline__ void ph_prep2(Frame& F, int l) {
    PH_IDS;
    LAS unsigned char* img = (LAS unsigned char*)(F.lds + 0);
    stage_wmf(tid, img, F.in[I_WR] + (size_t)l * D * NE, NE, F.in[I_NFG] + (size_t)l * D);
    const int gw = F.bx * NWAVES + wave, NGW = F.G * NWAVES;
#pragma unroll 1
    for (int grp = gw; grp < T / 16; grp += NGW) {
        const int i = lane & 15, q = lane >> 4;
        const bf16* xp = WSP(bf16, WS_XR) + (size_t)(grp * 16 + i) * D + 8 * q;
        float zf = 0.f; asm volatile("" : "+v"(zf));
        f32x4 acc = (f32x4){zf, zf, zf, zf}; float ssq = 0.f;
#pragma unroll 1
        for (int sb = 0; sb < 32; sb += 8) {
            v4u a[8];
#pragma unroll
            for (int u = 0; u < 8; ++u) a[u] = *(const v4u*)(xp + 32 * (sb + u));
#pragma unroll
            for (int u = 0; u < 8; ++u) { const bf16x8 bh = *(const LAS bf16x8*)(img + (((sb + u) * 2 + 0) * 64 + lane) * 16), bl = *(const LAS bf16x8*)(img + (((sb + u) * 2 + 1) * 64 + lane) * 16);
                const bf16x8 av = __builtin_bit_cast(bf16x8, a[u]);
                acc = __builtin_amdgcn_mfma_f32_16x16x32_bf16(av, bh, acc, 0, 0, 0); acc = __builtin_amdgcn_mfma_f32_16x16x32_bf16(av, bl, acc, 0, 0, 0);
                const float x0 = bflo(a[u].x), x1 = bfhi(a[u].x), x2 = bflo(a[u].y), x3 = bfhi(a[u].y), x4 = bflo(a[u].z), x5 = bfhi(a[u].z), x6 = bflo(a[u].w), x7 = bfhi(a[u].w);
                ssq += (x0 * x0 + x1 * x1) + (x2 * x2 + x3 * x3) + ((x4 * x4 + x5 * x5) + (x6 * x6 + x7 * x7)); }
        }
        ssq += __shfl_xor(ssq, 16); ssq += __shfl_xor(ssq, 32);
        const float rstd = 1.0f / sqrtf(ssq * (1.0f / D) + EPS);
#pragma unroll
        for (int r = 0; r < 4; ++r) { float t = acc[r] * __shfl(rstd, 4 * q + r);
            float mx = row_ror_max<8>(t); mx = row_ror_max<4>(mx); mx = row_ror_max<2>(mx); mx = row_ror_max<1>(mx);
            const float e = __expf(t - mx);
            float se = row_ror_add<8>(e); se = row_ror_add<4>(se); se = row_ror_add<2>(se); se = row_ror_add<1>(se);
            WSP(float, WS_AFF)[(size_t)(grp * 16 + 4 * q + r) * 16 + i] = e / se; }
    }
    f32x4 v[2][4];
#pragma unroll
    for (int r = 0; r < 2; ++r)
#pragma unroll
        for (int j = 0; j < 4; ++j) v[r][j] = ldx4(WSP(bf16, WS_XR) + (size_t)(gw + r * NGW) * D + 256 * j + 4 * lane);
#pragma unroll 1
    for (int row = gw; row < T; row += 2 * NGW) {
        f32x4 vn[2][4], h[2][4];
        const int nrow = (row + 2 * NGW < T) ? row + 2 * NGW : row;
#pragma unroll
        for (int r = 0; r < 2; ++r)
#pragma unroll
            for (int j = 0; j < 4; ++j) vn[r][j] = ldx4(WSP(bf16, WS_XR) + (size_t)(nrow + r * NGW) * D + 256 * j + 4 * lane);
#pragma unroll
        for (int r = 0; r < 2; ++r) { rms_row(v[r], F.in[I_NFG] + (size_t)l * D, lane, h[r]);
#pragma unroll
            for (int j = 0; j < 4; ++j) *(unsigned*)(F.ws + WS_XB + (size_t)(row + r * NGW) * D + 256 * j + 4 * lane) = pg8::pk4_fp8(h[r][j].x, h[r][j].y, h[r][j].z, h[r][j].w); }
#pragma unroll
        for (int r = 0; r < 2; ++r)
#pragma unroll
            for (int j = 0; j < 4; ++j) v[r][j] = vn[r][j];
    }
    __syncthreads();
}
__device__ __forceinline__ void ph_mgate(Frame& F, int l) {
    PH_IDS;
    LAS unsigned char* img = (LAS unsigned char*)(F.lds + 0);
    stage_wmf(tid, img, F.in[I_WIN] + (size_t)l * D * IN_COLS + OFF_MG, IN_COLS, F.in[I_NMG] + (size_t)l * D);
    const int gw = F.bx * NWAVES + wave, NGW = F.G * NWAVES;
#pragma unroll 1
    for (int grp = gw; grp < T / 16; grp += NGW) {
        const int i = lane & 15, q = lane >> 4;
        const bf16* xp = WSP(bf16, WS_XR) + (size_t)(grp * 16 + i) * D + 8 * q;
        float zf = 0.f; asm volatile("" : "+v"(zf));
        f32x4 acc = (f32x4){zf, zf, zf, zf}; float ssq = 0.f;
#pragma unroll 1
        for (int sb = 0; sb < 32; sb += 8) {
            v4u a[8];
#pragma unroll
            for (int u = 0; u < 8; ++u) a[u] = *(const v4u*)(xp + 32 * (sb + u));
#pragma unroll
            for (int u = 0; u < 8; ++u) { const bf16x8 bh = *(const LAS bf16x8*)(img + (((sb + u) * 2 + 0) * 64 + lane) * 16), bl = *(const LAS bf16x8*)(img + (((sb + u) * 2 + 1) * 64 + lane) * 16);
                const bf16x8 av = __builtin_bit_cast(bf16x8, a[u]);
                acc = __builtin_amdgcn_mfma_f32_16x16x32_bf16(av, bh, acc, 0, 0, 0); acc = __builtin_amdgcn_mfma_f32_16x16x32_bf16(av, bl, acc, 0, 0, 0);
                const float x0 = bflo(a[u].x), x1 = bfhi(a[u].x), x2 = bflo(a[u].y), x3 = bfhi(a[u].y), x4 = bflo(a[u].z), x5 = bfhi(a[u].z), x6 = bflo(a[u].w), x7 = bfhi(a[u].w);
                ssq += (x0 * x0 + x1 * x1) + (x2 * x2 + x3 * x3) + ((x4 * x4 + x5 * x5) + (x6 * x6 + x7 * x7)); }
        }
        ssq += __shfl_xor(ssq, 16); ssq += __shfl_xor(ssq, 32);
        const float rstd = 1.0f / sqrtf(ssq * (1.0f / D) + EPS);
        const float bm = F.in[I_BMG][l * 16 + i];
#pragma unroll
        for (int r = 0; r < 4; ++r) WSP(float, WS_MG)[(size_t)(grp * 16 + 4 * q + r) * 16 + i] = acc[r] * __shfl(rstd, 4 * q + r) + bm;
    }
    __syncthreads();
}
__device__ __forceinline__ void ph_topk(Frame& F) {
    PH_IDS;
    LAS unsigned long long* keys = (LAS unsigned long long*)(F.lds + 0);
    for (int item = F.bx; item < BATCH * NE; item += F.G) {
        const int b = item >> 4, e = item & 15;
        __syncthreads();
        for (int s = tid; s < SEQ; s += NTHREADS) { const float v = WSP(float, WS_AFF)[((size_t)b * SEQ + s) * 16 + e];
            keys[s] = ((unsigned long long)__float_as_uint(v) << 32) | (unsigned long long)(0xFFFFFFFFu - (unsigned)s);
            WSP(int, WS_INV)[((size_t)b * SEQ + s) * 16 + e] = -1; }
        __syncthreads();
        for (int k = 2; k <= SEQ; k <<= 1)
            for (int j = k >> 1; j > 0; j >>= 1) {
#pragma unroll
                for (int pp = 0; pp < 2; ++pp) { const int p = tid + NTHREADS * pp; const int i = ((p & ~(j - 1)) << 1) | (p & (j - 1)), ix = i | j;
                    const unsigned long long x = keys[i], y = keys[ix]; const bool up = ((i & k) == 0);
                    if ((x < y) == up) { keys[i] = y; keys[ix] = x; } }
                __syncthreads();
            }
        if (tid < CAP) { const unsigned long long kk = keys[tid]; const int s = (int)(0xFFFFFFFFu - (unsigned)(kk & 0xFFFFFFFFull));
            WSP(int, WS_IDX)[item * CAP + tid] = b * SEQ + s; WSP(float, WS_GATEV)[item * CAP + tid] = __uint_as_float((unsigned)(kk >> 32)); }
        asm volatile("s_waitcnt vmcnt(0)" ::: "memory");
        __syncthreads();
        if (tid < CAP) { const unsigned long long kk = keys[tid]; const int s = (int)(0xFFFFFFFFu - (unsigned)(kk & 0xFFFFFFFFull)); WSP(int, WS_INV)[((size_t)b * SEQ + s) * 16 + e] = tid; }
    }
    __syncthreads();
}
__device__ __forceinline__ void ph_combine(Frame& F, int l) {
    PH_IDS;
    const bool lastl = (l + 1 == DEPTH);
    const int gw = F.bx * NWAVES + wave, NGW = F.G * NWAVES;
    f32x4 v[2][4]; int myinv[2];
#pragma unroll
    for (int r = 0; r < 2; ++r) { myinv[r] = WSP(int, WS_INV)[(size_t)(gw + r * NGW) * 16 + (lane & 15)];
#pragma unroll
        for (int j = 0; j < 4; ++j) v[r][j] = ldx4(WSP(bf16, WS_XR) + (size_t)(gw + r * NGW) * D + 256 * j + 4 * lane); }
#pragma unroll 1
    for (int row = gw; row < T; row += 2 * NGW) {
        f32x4 vn[2][4]; int ninv[2];
        const int nrow = (row + 2 * NGW < T) ? row + 2 * NGW : row;
#pragma unroll
        for (int r = 0; r < 2; ++r) { ninv[r] = WSP(int, WS_INV)[(size_t)(nrow + r * NGW) * 16 + (lane & 15)];
#pragma unroll
            for (int j = 0; j < 4; ++j) vn[r][j] = ldx4(WSP(bf16, WS_XR) + (size_t)(nrow + r * NGW) * D + 256 * j + 4 * lane); }
        v2u y[2][4][4]; float fl[2][4]; unsigned rest[2];
#pragma unroll
        for (int r = 0; r < 2; ++r) { const int b = (row + r * NGW) / SEQ;
            unsigned mask = (unsigned)__builtin_amdgcn_ballot_w64(myinv[r] >= 0) & 0xffffu;
#pragma unroll
            for (int k = 0; k < 4; ++k) { const bool hit = mask != 0u; const int e = hit ? __builtin_ctz(mask) : 0; const int sl = __builtin_amdgcn_readlane(myinv[r], e);
                const bf16* yr = WSP(bf16, WS_YE) + ((size_t)(b * 16 + e) * CAP + (hit ? sl : 0)) * D; fl[r][k] = hit ? 1.0f : 0.0f; mask &= mask - 1u;
#pragma unroll
                for (int j = 0; j < 4; ++j) y[r][k][j] = *(const v2u*)(yr + 256 * j + 4 * lane); }
            rest[r] = mask; }
#pragma unroll
        for (int r = 0; r < 2; ++r) {
#pragma unroll
            for (int k = 0; k < 4; ++k)
#pragma unroll
                for (int j = 0; j < 4; ++j) { const v2u yy = y[r][k][j]; const float f = fl[r][k]; v[r][j].x += f * bflo(yy.x); v[r][j].y += f * bfhi(yy.x); v[r][j].z += f * bflo(yy.y); v[r][j].w += f * bfhi(yy.y); }
            unsigned mask = rest[r]; const int b = (row + r * NGW) / SEQ;
            while (mask) { const int e = __builtin_ctz(mask); mask &= mask - 1u; const int sl = __builtin_amdgcn_readlane(myinv[r], e);
                const bf16* yr = WSP(bf16, WS_YE) + ((size_t)(b * 16 + e) * CAP + sl) * D;
#pragma unroll
                for (int j = 0; j < 4; ++j) { const v2u yy = *(const v2u*)(yr + 256 * j + 4 * lane); v[r][j].x += bflo(yy.x); v[r][j].y += bfhi(yy.x); v[r][j].z += bflo(yy.y); v[r][j].w += bfhi(yy.y); } } }
        if (!lastl) {
#pragma unroll
            for (int r = 0; r < 2; ++r)
#pragma unroll
                for (int j = 0; j < 4; ++j) { v2u o; o.x = pk2(v[r][j].x, v[r][j].y); o.y = pk2(v[r][j].z, v[r][j].w); *(v2u*)(WSP(bf16, WS_XR) + (size_t)(row + r * NGW) * D + 256 * j + 4 * lane) = o; }
            prep1_rows<2>(F, lane, l + 1, row, NGW, v);
        } else {
#pragma unroll
            for (int r = 0; r < 2; ++r) { f32x4 h[4]; rms_row(v[r], F.in[I_NF], lane, h);
#pragma unroll
                for (int j = 0; j < 4; ++j) *(f32x4*)(F.X + (size_t)(row + r * NGW) * D + 256 * j + 4 * lane) = h[j]; } }
#pragma unroll
        for (int r = 0; r < 2; ++r) { myinv[r] = ninv[r];
#pragma unroll
            for (int j = 0; j < 4; ++j) v[r][j] = vn[r][j]; }
    }
    __syncthreads();
}

__device__ __forceinline__ void ph_mlstm_naive(Frame& F, int l) {
    PH_IDS;
    constexpr int TB = 64;
    LAS float* qs = (LAS float*)(F.lds + 0);
    LAS float* ks = (LAS float*)(F.lds + 32768);
    LAS float* vs = (LAS float*)(F.lds + 65536);
    LAS float* gl = (LAS float*)(F.lds + 98304);
    const float* cw = F.in[I_CW] + (size_t)l * CONVW * 2 * MW; const float* cb = F.in[I_CB] + (size_t)l * 2 * MW;
    const bf16* zqk = WSP(bf16, WS_ZQK); const bf16* zmv = WSP(bf16, WS_ZMV); const float* mg = WSP(float, WS_MG);
    for (int item = F.bx; item < BATCH * MH * 2; item += F.G) {
        const int dir = item & 1, h = (item >> 1) & 3, b = item >> 3;
        float* outp = WSP(float, dir ? WS_HB : WS_HF);
        const int v = tid >> 2, kq = tid & 3;
        float C[32], n[32];
#pragma unroll
        for (int i = 0; i < 32; ++i) { C[i] = 0.f; n[i] = 0.f; }
        float m = 0.f;
        for (int blk = 0; blk < SEQ / TB; ++blk) {
            const int ta = dir ? (SEQ - TB - blk * TB) : blk * TB;
            __syncthreads();
            for (int i = tid; i < TB * 256; i += NTHREADS) { const int tt = i >> 8, c = i & 255; const int col = (c < 128) ? (h * 128 + c) : (512 + h * 128 + (c - 128));
                float a = cb[col];
#pragma unroll
                for (int j = 0; j < CONVW; ++j) { const int ts = ta + tt + j - 2; if (ts >= 0 && ts < SEQ) a += cw[j * 2 * MW + col] * bf2f(zqk[((size_t)b * SEQ + ts) * 1024 + col]); }
                a = a * sigmoidf_(a);
                if (c < 128) qs[tt * 128 + c] = a; else ks[tt * 128 + (c - 128)] = a * 0.08838834764831845f; }
            for (int i = tid; i < TB * 128; i += NTHREADS) { const int tt = i >> 7, c = i & 127; vs[i] = bf2f(zmv[((size_t)b * SEQ + ta + tt) * 512 + h * 128 + c]); }
            if (tid < TB) { const float ip = mg[((size_t)b * SEQ + ta + tid) * 16 + dir * 8 + h], fp = mg[((size_t)b * SEQ + ta + tid) * 16 + dir * 8 + 4 + h];
                gl[tid * 2 + 0] = fminf(fp, 0.f) - log1pf(__expf(-fabsf(fp))); gl[tid * 2 + 1] = ip; }
            __syncthreads();
            for (int u = 0; u < TB; ++u) {
                const int tt = dir ? (TB - 1 - u) : u;
                const float lf = gl[tt * 2], li = gl[tt * 2 + 1];
                const float mn = fmaxf(lf + m, li), fs = __expf(lf + m - mn), is = __expf(li - mn); m = mn;
                const float iv = is * vs[tt * 128 + v];
                float hp = 0.f, dp = 0.f;
#pragma unroll
                for (int q4 = 0; q4 < 8; ++q4) { const f32x4 kx = *(const LAS f32x4*)(ks + tt * 128 + kq * 32 + q4 * 4), qx = *(const LAS f32x4*)(qs + tt * 128 + kq * 32 + q4 * 4);
#pragma unroll
                    for (int c = 0; c < 4; ++c) { const int i = q4 * 4 + c; C[i] = fs * C[i] + iv * kx[c]; n[i] = fs * n[i] + is * kx[c]; hp += C[i] * qx[c]; dp += n[i] * qx[c]; } }
                hp += __shfl_xor(hp, 1); hp += __shfl_xor(hp, 2); dp += __shfl_xor(dp, 1); dp += __shfl_xor(dp, 2);
                if (kq == 0) outp[((size_t)b * SEQ + ta + tt) * 512 + h * 128 + v] = hp / fmaxf(fabsf(dp), __expf(-m));
            }
        }
    }
    __syncthreads();
}
__device__ __forceinline__ void ph_mnorm(Frame& F, int l) {
    PH_IDS;
    const int gw = F.bx * NWAVES + wave, NGW = F.G * NWAVES;
    const float* ng = F.in[I_MNG] + (size_t)l * MW + 8 * lane;
    const f32x4 g0 = *(const f32x4*)ng, g1 = *(const f32x4*)(ng + 4);
    for (int tk = gw; tk < T; tk += NGW) {
        const size_t off = (size_t)tk * 512 + 8 * lane;
        const v4u af = *(const v4u*)(WSP(bf16, WS_HF) + off), ab = *(const v4u*)(WSP(bf16, WS_HB) + off);
        const f32x4 a0 = (f32x4){bflo(af.x), bfhi(af.x), bflo(af.y), bfhi(af.y)}, a1 = (f32x4){bflo(af.z), bfhi(af.z), bflo(af.w), bfhi(af.w)}, b0 = (f32x4){bflo(ab.x), bfhi(ab.x), bflo(ab.y), bfhi(ab.y)}, b1 = (f32x4){bflo(ab.z), bfhi(ab.z), bflo(ab.w), bfhi(ab.w)};
        const v4u o = *(const v4u*)(WSP(bf16, WS_ZMO) + off);
        f32x4 x0 = a0 + b0, x1 = a1 + b1;
        float sm = (x0.x + x0.y) + (x0.z + x0.w) + (x1.x + x1.y) + (x1.z + x1.w);
        sm = row_ror_add<8>(sm); sm = row_ror_add<4>(sm); sm = row_ror_add<2>(sm); sm = row_ror_add<1>(sm);
        const float mu = sm * (1.0f / 128.0f);
        x0 = x0 - mu; x1 = x1 - mu;
        float vs = (x0.x * x0.x + x0.y * x0.y) + (x0.z * x0.z + x0.w * x0.w) + (x1.x * x1.x + x1.y * x1.y) + (x1.z * x1.z + x1.w * x1.w);
        vs = row_ror_add<8>(vs); vs = row_ror_add<4>(vs); vs = row_ror_add<2>(vs); vs = row_ror_add<1>(vs);
        const float rs = 1.0f / sqrtf(vs * (1.0f / 128.0f) + EPS);
        v4u w; w.x = pk2(x0.x * rs * g0.x * bflo(o.x), x0.y * rs * g0.y * bfhi(o.x)); w.y = pk2(x0.z * rs * g0.z * bflo(o.y), x0.w * rs * g0.w * bfhi(o.y));
        w.z = pk2(x1.x * rs * g1.x * bflo(o.z), x1.y * rs * g1.y * bfhi(o.z)); w.w = pk2(x1.z * rs * g1.z * bflo(o.w), x1.w * rs * g1.w * bfhi(o.w));
        *(v4u*)(WSP(bf16, WS_HM) + (size_t)tk * 1024 + 8 * lane) = w;
    }
}
__device__ __forceinline__ void ph_attn_naive(Frame& F, int l) {
    PH_IDS;
    LAS float* Ks = (LAS float*)(F.lds + 0);
    LAS float* Vs = (LAS float*)(F.lds + 32768);
    LAS float* Os = (LAS float*)(F.lds + 65536);
    const float lam_init = __uint_as_float(__builtin_amdgcn_readfirstlane(__float_as_uint(0.8f - 0.6f * __expf(-0.3f * (float)l))));
    const float* lam = F.in[I_LAM] + (size_t)l * 4 * ADH;
    const float s01 = wave_sum(lam[lane] * lam[64 + lane]), s23 = wave_sum(lam[128 + lane] * lam[192 + lane]);
    const float lam_full = __expf(s01) - __expf(s23) + lam_init;
    const float* ng = F.in[I_DNG] + (size_t)l * ADV;
    const bf16* zdq = WSP(bf16, WS_ZDQ); const bf16* zdk = WSP(bf16, WS_ZDK); const bf16* zdv = WSP(bf16, WS_ZDV);
    const int r = tid & 63, part = tid >> 6, hi = part >> 2, dq = part & 3;
    for (int unit = F.bx; unit < BATCH * AH * (SEQ / 64); unit += F.G) {
        const int qb = unit & 31, h = (unit >> 5) & 3, b = unit >> 7;
        const int tq = qb * 64 + r;
        const float slope2 = __builtin_amdgcn_exp2f(-2.0f * (float)(h + 1)) * LOG2E;
        float q[64];
        { const bf16* qp = zdq + ((size_t)b * SEQ + tq) * 512 + h * 128 + hi * 64;
#pragma unroll
          for (int d8 = 0; d8 < 8; ++d8) { const v4u w = *(const v4u*)(qp + d8 * 8); q[d8 * 8 + 0] = bflo(w.x); q[d8 * 8 + 1] = bfhi(w.x); q[d8 * 8 + 2] = bflo(w.y); q[d8 * 8 + 3] = bfhi(w.y);
              q[d8 * 8 + 4] = bflo(w.z); q[d8 * 8 + 5] = bfhi(w.z); q[d8 * 8 + 6] = bflo(w.w); q[d8 * 8 + 7] = bfhi(w.w); } }
        float o[32];
#pragma unroll
        for (int c = 0; c < 32; ++c) o[c] = 0.f;
        float m = -1e30f, lsum = 0.f;
        for (int kt = 0; kt < SEQ / 64; ++kt) {
            __syncthreads();
            for (int i = tid; i < 64 * 16; i += NTHREADS) { const int kr = i >> 4, c8 = i & 15; const size_t g = ((size_t)b * SEQ + kt * 64 + kr) * 512 + h * 128 + c8 * 8;
                const v4u kw = *(const v4u*)(zdk + g), vw = *(const v4u*)(zdv + g);
                LAS float* kd = Ks + kr * 128 + c8 * 8; LAS float* vd = Vs + kr * 128 + c8 * 8;
                kd[0] = bflo(kw.x); kd[1] = bfhi(kw.x); kd[2] = bflo(kw.y); kd[3] = bfhi(kw.y); kd[4] = bflo(kw.z); kd[5] = bfhi(kw.z); kd[6] = bflo(kw.w); kd[7] = bfhi(kw.w);
                vd[0] = bflo(vw.x); vd[1] = bfhi(vw.x); vd[2] = bflo(vw.y); vd[3] = bfhi(vw.y); vd[4] = bflo(vw.z); vd[5] = bfhi(vw.z); vd[6] = bflo(vw.w); vd[7] = bfhi(vw.w); }
            __syncthreads();
            for (int j = 0; j < 64; ++j) {
                float s = 0.f;
#pragma unroll
                for (int d4 = 0; d4 < 16; ++d4) { const f32x4 kx = *(const LAS f32x4*)(Ks + j * 128 + hi * 64 + d4 * 4); s += q[d4 * 4] * kx.x + q[d4 * 4 + 1] * kx.y + q[d4 * 4 + 2] * kx.z + q[d4 * 4 + 3] * kx.w; }
                s -= slope2 * fabsf((float)(tq - (kt * 64 + j)));
                if (s > m) { const float corr = __builtin_amdgcn_exp2f(m - s); lsum *= corr;
#pragma unroll
                    for (int c = 0; c < 32; ++c) o[c] *= corr;
                    m = s; }
                const float p = __builtin_amdgcn_exp2f(s - m); lsum += p;
#pragma unroll
                for (int c4 = 0; c4 < 8; ++c4) { const f32x4 vx = *(const LAS f32x4*)(Vs + j * 128 + dq * 32 + c4 * 4); o[c4 * 4] += p * vx.x; o[c4 * 4 + 1] += p * vx.y; o[c4 * 4 + 2] += p * vx.z; o[c4 * 4 + 3] += p * vx.w; }
            }
        }
        __syncthreads();
        { const float il = 1.0f / lsum;
#pragma unroll
          for (int c = 0; c < 32; ++c) Os[(r * 2 + hi) * 128 + dq * 32 + c] = o[c] * il; }
        __syncthreads();
        float dv[16]; float ss = 0.f;
#pragma unroll
        for (int c = 0; c < 16; ++c) { dv[c] = Os[(r * 2 + 0) * 128 + part * 16 + c] - lam_full * Os[(r * 2 + 1) * 128 + part * 16 + c]; ss += dv[c] * dv[c]; }
        __syncthreads();
        Ks[r * 8 + part] = ss;
        __syncthreads();
        float tot = 0.f;
#pragma unroll
        for (int p8 = 0; p8 < 8; ++p8) tot += Ks[r * 8 + p8];
        const float rs = 1.0f / sqrtf(tot * (1.0f / 128.0f) + EPS) * (1.0f - lam_init);
        bf16* op = WSP(bf16, WS_HD) + ((size_t)b * SEQ + tq) * 512 + h * 128 + part * 16;
        v4u w0, w1;
        w0.x = pk2(dv[0] * rs * ng[part * 16 + 0], dv[1] * rs * ng[part * 16 + 1]); w0.y = pk2(dv[2] * rs * ng[part * 16 + 2], dv[3] * rs * ng[part * 16 + 3]);
        w0.z = pk2(dv[4] * rs * ng[part * 16 + 4], dv[5] * rs * ng[part * 16 + 5]); w0.w = pk2(dv[6] * rs * ng[part * 16 + 6], dv[7] * rs * ng[part * 16 + 7]);
        w1.x = pk2(dv[8] * rs * ng[part * 16 + 8], dv[9] * rs * ng[part * 16 + 9]); w1.y = pk2(dv[10] * rs * ng[part * 16 + 10], dv[11] * rs * ng[part * 16 + 11]);
        w1.z = pk2(dv[12] * rs * ng[part * 16 + 12], dv[13] * rs * ng[part * 16 + 13]); w1.w = pk2(dv[14] * rs * ng[part * 16 + 14], dv[15] * rs * ng[part * 16 + 15]);
        *(v4u*)op = w0; *(v4u*)(op + 8) = w1;
    }
    __syncthreads();
}

namespace attn {
typedef float f32x16 __attribute__((ext_vector_type(16)));
typedef short s16x4 __attribute__((ext_vector_type(4)));
typedef short v4i16_t __attribute__((ext_vector_type(4)));
constexpr int KVT = 64, NT = SEQ / KVT, SLOT = 32768;
__device__ __forceinline__ int crow(int r, int h) { return (r & 3) + 8 * (r >> 2) + 4 * h; }
__device__ __forceinline__ s16x4 vtr(const LAS unsigned char* p) { return __builtin_bit_cast(s16x4, __builtin_amdgcn_ds_read_tr16_b64_v4i16((LAS v4i16_t*)p)); }
__device__ __forceinline__ float max3f(float a, float b, float c) { float r; asm("v_max3_f32 %0, %1, %2, %3" : "=v"(r) : "v"(a), "v"(b), "v"(c)); return r; }
__device__ __forceinline__ float swapmax(float v) { auto rr = __builtin_amdgcn_permlane32_swap(__float_as_uint(v), __float_as_uint(v), false, false); return fmaxf(__uint_as_float(rr[0]), __uint_as_float(rr[1])); }
__device__ __forceinline__ float swapsum(float v) { auto rr = __builtin_amdgcn_permlane32_swap(__float_as_uint(v), __float_as_uint(v), false, false); return __uint_as_float(rr[0]) + __uint_as_float(rr[1]); }
__device__ __forceinline__ unsigned cvtpk(float lo, float hi) { typedef float f2 __attribute__((ext_vector_type(2))); typedef __bf16 b2 __attribute__((ext_vector_type(2))); f2 v = {lo, hi}; b2 b = __builtin_convertvector(v, b2); return __builtin_bit_cast(unsigned, b); }

__device__ __forceinline__ void unit(LAS unsigned char* lds, int tid, int b, int h, int qb, const bf16* zdq, const bf16* zdk, const bf16* zdv, bf16* hd,
                                     const float* ng, float lam_full, unsigned oml) {
    const int lane = tid & 63, wave = __builtin_amdgcn_readfirstlane(tid >> 6), hf = wave >> 2, w4 = wave & 3, r32 = lane & 31, hh = lane >> 5;
    const int tq = qb * 128 + w4 * 32 + r32;
    const float slope2 = __builtin_amdgcn_exp2f(-2.0f * (float)(h + 1)) * LOG2E;
    bf16x8 qf[4];
    { const bf16* qp = zdq + ((size_t)b * SEQ + tq) * 512 + h * 128 + hf * 64 + hh * 8;
#pragma unroll
      for (int ks = 0; ks < 4; ++ks) qf[ks] = *(const bf16x8*)(qp + ks * 16); }
    const char* kg = (const char*)(zdk + (size_t)b * SEQ * 512 + h * 128); const char* vg = (const char*)(zdv + (size_t)b * SEQ * 512 + h * 128);
    unsigned koff[2], voff[2];
#pragma unroll
    for (int e = 0; e < 2; ++e) { const int kv = 8 * wave + 4 * e + (lane >> 4), cc = lane & 15;
        koff[e] = (unsigned)(kv * 1024 + ((cc ^ (kv & 15)) * 16)); voff[e] = (unsigned)(kv * 1024 + ((cc ^ ((kv & 3) << 2)) * 16)); }
    const unsigned ldsa = (unsigned)(uintptr_t)lds;
#define AT_GLDS(gsrc, ldst) do { unsigned _keep; asm volatile("s_mov_b32 %0, m0\n\ts_mov_b32 m0, %2\n\ts_nop 0\n\tglobal_load_lds_dwordx4 %1, off\n\ts_mov_b32 m0, %0" : "=&s"(_keep) : "v"(gsrc), "s"(ldst) : "memory"); } while (0)
#define AT_STAGE(t, slot) do { _Pragma("unroll") for (int _e = 0; _e < 2; ++_e) { \
        const unsigned _kd = (unsigned)__builtin_amdgcn_readfirstlane((int)(ldsa + (slot) * SLOT + (2 * wave + _e) * 1024)); \
        AT_GLDS(kg + (size_t)(t) * (KVT * 1024) + koff[_e], _kd); AT_GLDS(vg + (size_t)(t) * (KVT * 1024) + voff[_e], _kd + 16384u); } } while (0)
    int kx[4], vb[4];
#pragma unroll
    for (int ks = 0; ks < 4; ++ks) kx[ks] = r32 * 256 + (((hf * 8 + 2 * ks + hh) ^ (r32 & 15)) * 16);
    { const int li = lane & 15, q_ = li >> 2, p_ = li & 3, g1 = (lane >> 4) & 1;
#pragma unroll
      for (int db = 0; db < 4; ++db) vb[db] = 16384 + (4 * hh + q_) * 256 + ((((db ^ q_) << 2) + 2 * g1 + (p_ >> 1)) * 16) + (p_ & 1) * 8; }
    f32x16 cc;
#pragma unroll
    for (int r = 0; r < 16; ++r) cc[r] = slope2 * (float)crow(r, hh);
    f32x16 o[4];
#pragma unroll
    for (int db = 0; db < 4; ++db)
#pragma unroll
        for (int r = 0; r < 16; ++r) o[db][r] = 0.f;
    float m = 0.f, l = 0.f;
    int ktd = (qb * 128 + w4 * 32) >> 6;
    const int t0 = 2 * qb;
#define AT_SEQ(i) (((i) < NT - t0) ? t0 + (i) : NT - 1 - (i))
    AT_STAGE(AT_SEQ(0), 0); AT_STAGE(AT_SEQ(1), 1); AT_STAGE(AT_SEQ(2), 2);
    asm volatile("" : "+v"(qf[0]), "+v"(qf[1]), "+v"(qf[2]), "+v"(qf[3]));
    asm volatile("s_waitcnt vmcnt(4)" ::: "memory");
    __builtin_amdgcn_s_barrier();
    if (hf == 1) __builtin_amdgcn_s_barrier();
    asm volatile("" ::: "memory");
    f32x16 s0, s1;
    bf16x8 k0[4], k1[4];
#define AT_KLOAD(slq) do { _Pragma("unroll") for (int ks = 0; ks < 4; ++ks) { k0[ks] = *(const LAS bf16x8*)((slq) + kx[ks]); k1[ks] = *(const LAS bf16x8*)((slq) + kx[ks] + 8192); } } while (0)
#define AT_QK(ktq) do { asm volatile("" : "+s"(ktd)); const bool dg_ = ((ktq) == ktd), lf_ = ((ktq) < ktd); const float sg_ = lf_ ? slope2 : -slope2; \
        { const float z = dg_ ? 0.f : (lf_ ? 1.f : -1.f), cm0 = (dg_ ? 0.f : sg_ * (float)((ktq) * 64 - tq)) - m, cm1 = cm0 + (dg_ ? 0.f : 32.0f * sg_); \
          _Pragma("unroll") for (int r = 0; r < 16; ++r) { s0[r] = cc[r] * z + cm0; s1[r] = cc[r] * z + cm1; } }        \
        __builtin_amdgcn_sched_barrier(0); \
        _Pragma("unroll") for (int ks = 0; ks < 4; ++ks) { s0 = __builtin_amdgcn_mfma_f32_32x32x16_bf16(k0[ks], qf[ks], s0, 0, 0, 0); s1 = __builtin_amdgcn_mfma_f32_32x32x16_bf16(k1[ks], qf[ks], s1, 0, 0, 0); } } while (0)
    AT_KLOAD(lds);
    AT_QK(AT_SEQ(0));
    int slot = 0;
    for (int ti = 0; ti < NT; ++ti) {
        const int kt = AT_SEQ(ti);
        const int s2 = (slot == 0) ? 3 : slot - 1;
        const LAS unsigned char* sl = lds + slot * SLOT;
        if (hf == 1 && ti + 3 < NT) { AT_STAGE(AT_SEQ(ti + 3), s2); }
        asm volatile("" : "+s"(ktd));
        const bool diag = (kt == ktd), left = (kt < ktd);
        (void)left;
        if (diag) {
            const float dq = (float)(tq - kt * 64 - 4 * hh);
#pragma unroll
            for (int r = 0; r < 16; ++r) { const float kk = (float)((r & 3) + 8 * (r >> 2)); s0[r] -= slope2 * fabsf(dq - kk); s1[r] -= slope2 * fabsf(dq - kk - 32.0f); }
        }
        float mxa = max3f(s0[0], s0[1], s0[2]), mxb = max3f(s1[0], s1[1], s1[2]), mxc = max3f(s0[3], s0[4], s0[5]), mxd = max3f(s1[3], s1[4], s1[5]);
        mxa = max3f(mxa, s0[6], s0[7]); mxb = max3f(mxb, s1[6], s1[7]); mxc = max3f(mxc, s0[8], s0[9]); mxd = max3f(mxd, s1[8], s1[9]);
        mxa = max3f(mxa, s0[10], s0[11]); mxb = max3f(mxb, s1[10], s1[11]); mxc = max3f(mxc, s0[12], s0[13]); mxd = max3f(mxd, s1[12], s1[13]);
        mxa = max3f(mxa, s0[14], s0[15]); mxb = max3f(mxb, s1[14], s1[15]);
        const float mx = swapmax(max3f(max3f(mxa, mxb, mxc), mxd, mxd));
        const bool dead = (ti > 0) && __all(mx < -40.0f);
        bf16x8 pf[4];
        if (!dead) {
        if (ti == 0 || __any(mx > 8.0f)) {
            const float delta = (ti == 0) ? mx : fmaxf(mx, 0.f);
#pragma unroll
            for (int r = 0; r < 16; ++r) { s0[r] -= delta; s1[r] -= delta; }
            if (ti > 0) { const float alpha = __builtin_amdgcn_exp2f(-delta); l *= alpha;
#pragma unroll
                for (int db = 0; db < 4; ++db)
#pragma unroll
                    for (int r = 0; r < 16; ++r) o[db][r] *= alpha; }
            m += delta;
        }
        float lsa = 0.f, lsb = 0.f, lsc = 0.f, lsd = 0.f;
#pragma unroll
        for (int r = 0; r < 16; r += 2) { s0[r] = __builtin_amdgcn_exp2f(s0[r]); s1[r] = __builtin_amdgcn_exp2f(s1[r]); s0[r + 1] = __builtin_amdgcn_exp2f(s0[r + 1]); s1[r + 1] = __builtin_amdgcn_exp2f(s1[r + 1]);
            lsa += s0[r]; lsb += s1[r]; lsc += s0[r + 1]; lsd += s1[r + 1]; }
        l += (lsa + lsb) + (lsc + lsd);
        {
            v4u w;
            w.x = cvtpk(s0[0], s0[1]); w.y = cvtpk(s0[2], s0[3]); w.z = cvtpk(s0[4], s0[5]); w.w = cvtpk(s0[6], s0[7]); pf[0] = __builtin_bit_cast(bf16x8, w);
            w.x = cvtpk(s0[8], s0[9]); w.y = cvtpk(s0[10], s0[11]); w.z = cvtpk(s0[12], s0[13]); w.w = cvtpk(s0[14], s0[15]); pf[1] = __builtin_bit_cast(bf16x8, w);
            w.x = cvtpk(s1[0], s1[1]); w.y = cvtpk(s1[2], s1[3]); w.z = cvtpk(s1[4], s1[5]); w.w = cvtpk(s1[6], s1[7]); pf[2] = __builtin_bit_cast(bf16x8, w);
            w.x = cvtpk(s1[8], s1[9]); w.y = cvtpk(s1[10], s1[11]); w.z = cvtpk(s1[12], s1[13]); w.w = cvtpk(s1[14], s1[15]); pf[3] = __builtin_bit_cast(bf16x8, w);
        }
        } else {
#pragma unroll
            for (int f = 0; f < 4; ++f) pf[f] = (bf16x8){0, 0, 0, 0, 0, 0, 0, 0};
        }
        if (hf == 1) { if (ti + 3 < NT) asm volatile("s_waitcnt vmcnt(4)" ::: "memory"); else asm volatile("s_waitcnt vmcnt(0)" ::: "memory"); }
        asm volatile("s_waitcnt lgkmcnt(0)" ::: "memory");
        __builtin_amdgcn_s_barrier();
        if (PROBE_REP & 16384) __builtin_amdgcn_s_barrier();
        asm volatile("" ::: "memory");
        if (hf == 0 && ti + 3 < NT) { AT_STAGE(AT_SEQ(ti + 3), s2); }
        if (ti + 1 < NT) { AT_KLOAD(lds + ((slot == 3) ? 0 : slot + 1) * SLOT); }
        __builtin_amdgcn_sched_barrier(0);
#define AT_VLOAD(dst, db) do { _Pragma("unroll") for (int _f = 0; _f < 4; ++_f) { dst##lo[_f] = vtr(sl + vb[db] + _f * 4096); dst##hi[_f] = vtr(sl + vb[db] + _f * 4096 + 2048); } } while (0)
#define AT_VMMA(src, db) do { _Pragma("unroll") for (int _f = 0; _f < 4; ++_f) { const bf16x8 vf = (bf16x8){src##lo[_f][0], src##lo[_f][1], src##lo[_f][2], src##lo[_f][3], src##hi[_f][0], src##hi[_f][1], src##hi[_f][2], src##hi[_f][3]}; \
            o[db] = __builtin_amdgcn_mfma_f32_32x32x16_bf16(vf, pf[_f], o[db], 0, 0, 0); if (PROBE_REP & 32768) { bf16x8 pz = (bf16x8){0,0,0,0,0,0,0,0}; asm volatile("" : "+v"(pz)); o[db] = __builtin_amdgcn_mfma_f32_32x32x16_bf16(vf, pz, o[db], 0, 0, 0); } } } while (0)
        if (!dead) {
            s16x4 valo[4], vahi[4], vb_lo[4], vb_hi[4];
            AT_VLOAD(va, 0); __builtin_amdgcn_sched_barrier(0);
            AT_VLOAD(vb_, 1); __builtin_amdgcn_sched_barrier(0);
            AT_VMMA(va, 0); __builtin_amdgcn_sched_barrier(0);
            AT_VLOAD(va, 2); __builtin_amdgcn_sched_barrier(0);
            AT_VMMA(vb_, 1); __builtin_amdgcn_sched_barrier(0);
            AT_VLOAD(vb_, 3); __builtin_amdgcn_sched_barrier(0);
            AT_VMMA(va, 2); __builtin_amdgcn_sched_barrier(0);
            AT_VMMA(vb_, 3); __builtin_amdgcn_sched_barrier(0);
        }
#undef AT_VLOAD
#undef AT_VMMA
        __builtin_amdgcn_sched_barrier(0);
        if (ti + 1 < NT) { const int ktn = AT_SEQ(ti + 1); AT_QK(ktn); }
        if (hf == 0) { if (ti + 3 < NT) asm volatile("s_waitcnt vmcnt(4)" ::: "memory"); else asm volatile("s_waitcnt vmcnt(0)" ::: "memory"); }
        asm volatile("s_waitcnt lgkmcnt(0)" ::: "memory");
        __builtin_amdgcn_s_barrier();
        if (PROBE_REP & 16384) __builtin_amdgcn_s_barrier();
        asm volatile("" ::: "memory");
        slot = (slot == 3) ? 0 : slot + 1;
    }
    if (hf == 0) __builtin_amdgcn_s_barrier();
    asm volatile("" ::: "memory");
#undef AT_QK
#undef AT_KLOAD
#undef AT_STAGE
#undef AT_GLDS
#undef AT_SEQ
    l = swapsum(l);
    const float il = 1.0f / l;
    __builtin_amdgcn_s_barrier();
    LAS float* xch = (LAS float*)lds + w4 * (64 * 64);
    if (hf == 1) {
#pragma unroll
        for (int db = 0; db < 4; ++db)
#pragma unroll
            for (int r = 0; r < 16; ++r) xch[(db * 16 + r) * 64 + lane] = o[db][r] * il;
    }
    asm volatile("s_waitcnt lgkmcnt(0)" ::: "memory");
    __builtin_amdgcn_s_barrier();
    asm volatile("" ::: "memory");
    if (hf == 0) {
        float ss = 0.f; float lfv, omv; asm volatile("v_mov_b32 %0, %2\n\tv_mov_b32 %1, %3" : "=&v"(lfv), "=&v"(omv) : "s"(lam_full), "s"(oml));
#pragma unroll
        for (int db = 0; db < 4; ++db)
#pragma unroll
            for (int r = 0; r < 16; ++r) { const float v = o[db][r] * il - lfv * xch[(db * 16 + r) * 64 + lane]; o[db][r] = v; ss += v * v; }
        ss = swapsum(ss);
        const float rs = omv / sqrtf(ss * (1.0f / 128.0f) + EPS);
        const int le = lane_id_volatile(), tqe = qb * 128 + w4 * 32 + (le & 31), hhe = le >> 5;
        bf16* op = hd + ((size_t)b * SEQ + tqe) * 1024 + 512 + h * 128 + 4 * hhe;
#pragma unroll
        for (int db = 0; db < 4; ++db)
#pragma unroll
            for (int r4 = 0; r4 < 4; ++r4) { const int d = db * 32 + 8 * r4; const f32x4 g = *(const f32x4*)(ng + d + 4 * hhe);
                v2u w; w.x = pk2(o[db][4 * r4] * rs * g.x, o[db][4 * r4 + 1] * rs * g.y); w.y = pk2(o[db][4 * r4 + 2] * rs * g.z, o[db][4 * r4 + 3] * rs * g.w);
                *(v2u*)(op + d) = w; }
    }
    asm volatile("s_waitcnt lgkmcnt(0)" ::: "memory");
    __builtin_amdgcn_s_barrier();
}
}
namespace mls {
using attn::f32x16; using attn::s16x4; using attn::vtr; using attn::cvtpk; using attn::swapsum; using attn::crow;
constexpr int QS = 0, KS = 32768, VS = 65536, CB = 98304, AUX = 132096;
constexpr int A_FS = 0, A_ET = 512, A_SIN = 1024, A_EMT = 1536, A_WS = 2048, A_NV = 2560, A_NP = 3072, A_SC = 5120, A_CW = 5632;
__device__ __forceinline__ int swz(int row) { return ((row & 3) << 2) | ((row >> 2) & 3); }
__device__ __forceinline__ int offs(int row, int ch) { return row * 256 + ((ch ^ swz(row)) << 4); }
__device__ __forceinline__ bf16x8 rdrow(const LAS unsigned char* lds, int buf, int RB, int i, int ks) { return *(const LAS bf16x8*)(lds + buf + (RB ^ (ks << 5)) + i * 8192); }
__device__ __forceinline__ bf16x8 trB(const LAS unsigned char* lds, int buf, int TB, int rowc, int c0) {
    const s16x4 lo = vtr(lds + buf + (TB ^ (c0 << 4)) + rowc * 256), hi = vtr(lds + buf + (TB ^ ((c0 | 2) << 4)) + (rowc + 8) * 256);
    return (bf16x8){lo[0], lo[1], lo[2], lo[3], hi[0], hi[1], hi[2], hi[3]};
}
__device__ __forceinline__ bf16x8 trC(const LAS unsigned char* lds, int buf, int TC, int ss, int c0) {
    const s16x4 lo = vtr(lds + buf + (TC ^ (c0 << 4)) + (16 * ss) * 256), hi = vtr(lds + buf + (TC ^ ((c0 | 1) << 4)) + (16 * ss + 4) * 256);
    return (bf16x8){lo[0], lo[1], lo[2], lo[3], hi[0], hi[1], hi[2], hi[3]};
}
__device__ __forceinline__ void mm8(f32x16& acc, const LAS unsigned char* lds, int bufA, int ia, int bufB, int ib, int RB) {
    bf16x8 a[2], b[2];
    a[0] = rdrow(lds, bufA, RB, ia, 0); b[0] = rdrow(lds, bufB, RB, ib, 0);
#pragma unroll
    for (int ks = 0; ks < 8; ++ks) {
        if (ks + 1 < 8) { a[(ks + 1) & 1] = rdrow(lds, bufA, RB, ia, ks + 1); b[(ks + 1) & 1] = rdrow(lds, bufB, RB, ib, ks + 1); }
        acc = __builtin_amdgcn_mfma_f32_32x32x16_bf16(a[ks & 1], b[ks & 1], acc, 0, 0, 0);
        __builtin_amdgcn_sched_barrier(0);
    }
}
template <int CTRL, int RM> __device__ __forceinline__ float dpp_f(float idv, float v) { return __int_as_float(__builtin_amdgcn_update_dpp(__float_as_int(idv), __float_as_int(v), CTRL, RM, 0xf, false)); }
__device__ __forceinline__ float scan_add(float x, int) {
    x += dpp_f<0x111, 0xf>(0.f, x); x += dpp_f<0x112, 0xf>(0.f, x); x += dpp_f<0x114, 0xf>(0.f, x); x += dpp_f<0x118, 0xf>(0.f, x);
    x += dpp_f<0x142, 0xa>(0.f, x); x += dpp_f<0x143, 0xc>(0.f, x); return x;
}
__device__ __forceinline__ float scan_max(float x, int) {
    const float ni = -3.0e38f;
    x = fmaxf(x, dpp_f<0x111, 0xf>(ni, x)); x = fmaxf(x, dpp_f<0x112, 0xf>(ni, x)); x = fmaxf(x, dpp_f<0x114, 0xf>(ni, x)); x = fmaxf(x, dpp_f<0x118, 0xf>(ni, x));
    x = fmaxf(x, dpp_f<0x142, 0xa>(ni, x)); x = fmaxf(x, dpp_f<0x143, 0xc>(ni, x)); return x;
}
__device__ __forceinline__ void item(LAS unsigned char* lds, int tid, int b, int h, int dir, const bf16* zqk, const bf16* zmv, const float* mg, const float* cw, const float* cb, bf16* outp) {
    const int lane = tid & 63, wave = __builtin_amdgcn_readfirstlane(tid >> 6);
    LAS float* aux = (LAS float*)(lds + AUX);
    { unsigned zz = 0u; asm volatile("" : "+v"(zz)); for (int i = tid; i < 32768 / 16; i += NTHREADS) *(LAS v4u*)(lds + CB + i * 16) = (v4u){zz, zz, zz, zz}; }
    if (tid < 128) aux[A_NV / 4 + tid] = 0.f;
    if (tid < 4 * 128) aux[A_NP / 4 + tid] = 0.f;
    if (tid < 8) aux[A_SC / 4 + tid] = 1.f;
    for (int i = tid; i < 6 * 256; i += NTHREADS) { const int j = i >> 8, c = i & 255; const int col = (c < 128) ? (h * 128 + c) : (512 + h * 128 + (c - 128)); aux[A_CW / 4 + i] = (j < 5) ? cw[j * 1024 + col] : cb[col]; }
    f32x16 X[2];
#pragma unroll
    for (int kb = 0; kb < 2; ++kb)
#pragma unroll
        for (int r = 0; r < 16; ++r) X[kb][r] = 0.f;
    float mstate = 0.f;
    __syncthreads();
#pragma unroll 1
    for (int c = 0; c < SEQ / 128; ++c) {
        const int c0 = dir ? (SEQ - 128 - c * 128) : c * 128;
        int tl = tid; asm volatile("" : "+v"(tl));
        if (tl >= 128 && tl < 256) { const int k = tl - 128; aux[A_NV / 4 + k] = aux[A_SC / 4 + ((c + 1) & 1)] * aux[A_NV / 4 + k] + (aux[A_NP / 4 + k] + aux[A_NP / 4 + 128 + k]) + (aux[A_NP / 4 + 256 + k] + aux[A_NP / 4 + 384 + k]); }
        {
          const int cq = tl & 31, rg = tl >> 5; const int col = (cq < 16) ? (h * 128 + cq * 8) : (512 + h * 128 + (cq - 16) * 8);
          const float ksc = (cq < 16) ? 1.0f : 0.08838834764831845f;
          const int base = dir ? (c0 + 118 - 8 * rg) : (c0 + 8 * rg - 2);
          v4u xr[12], vr[4];
#pragma unroll
          for (int i = 0; i < 12; ++i) { const int ts = dir ? base + 11 - i : base + i; xr[i] = (v4u){0u, 0u, 0u, 0u}; if (ts >= 0 && ts < SEQ) xr[i] = *(const v4u*)(zqk + ((size_t)b * SEQ + ts) * 1024 + col); }
#pragma unroll
          for (int n = 0; n < 4; ++n) { const int i = tl + NTHREADS * n, u = i >> 4, ch = i & 15; const int pos = dir ? (c0 + 127 - u) : (c0 + u);
              vr[n] = *(const v4u*)(zmv + ((size_t)b * SEQ + pos) * 512 + h * 128 + ch * 8); }
          const LAS float* cwl = aux + A_CW / 4 + cq * 8;
          float xu[12][8];
#define ML_UNP(r_) do { xu[r_][0] = bflo(xr[r_].x); xu[r_][1] = bfhi(xr[r_].x); xu[r_][2] = bflo(xr[r_].y); xu[r_][3] = bfhi(xr[r_].y); xu[r_][4] = bflo(xr[r_].z); xu[r_][5] = bfhi(xr[r_].z); xu[r_][6] = bflo(xr[r_].w); xu[r_][7] = bfhi(xr[r_].w); } while (0)
#pragma unroll
          for (int n = 0; n < 8; ++n) {
              if (n == 0) { ML_UNP(0); ML_UNP(1); ML_UNP(2); ML_UNP(3); }
              ML_UNP(n + 4);
              float a[8];
              { const f32x4 b0 = *(const LAS f32x4*)(cwl + 5 * 256), b1 = *(const LAS f32x4*)(cwl + 5 * 256 + 4); a[0] = b0.x; a[1] = b0.y; a[2] = b0.z; a[3] = b0.w; a[4] = b1.x; a[5] = b1.y; a[6] = b1.z; a[7] = b1.w; }
#pragma unroll
              for (int j = 0; j < CONVW; ++j) { const LAS float* wp = cwl + (dir ? (CONVW - 1 - j) : j) * 256; const f32x4 w0 = *(const LAS f32x4*)wp, w1 = *(const LAS f32x4*)(wp + 4);
                  a[0] += w0.x * xu[n + j][0]; a[1] += w0.y * xu[n + j][1]; a[2] += w0.z * xu[n + j][2]; a[3] += w0.w * xu[n + j][3]; a[4] += w1.x * xu[n + j][4]; a[5] += w1.y * xu[n + j][5]; a[6] += w1.z * xu[n + j][6]; a[7] += w1.w * xu[n + j][7]; }
#pragma unroll
              for (int e = 0; e < 8; ++e) a[e] = a[e] * sigmoidf_(a[e]) * ksc;
              v4u o; o.x = pk2(a[0], a[1]); o.y = pk2(a[2], a[3]); o.z = pk2(a[4], a[5]); o.w = pk2(a[6], a[7]);
              *(LAS v4u*)(lds + ((cq < 16) ? QS : KS) + offs(8 * rg + n, cq & 15)) = o;
              __builtin_amdgcn_sched_barrier(0); }
#undef ML_UNP
#pragma unroll
          for (int n = 0; n < 4; ++n) { const int i = tl + NTHREADS * n, u = i >> 4, ch = i & 15; *(LAS v4u*)(lds + VS + offs(u, ch)) = vr[n]; } }
        if (wave == 0) {
            int ln_ = lane; asm volatile("" : "+v"(ln_));
            const int u0 = 2 * ln_, u1 = u0 + 1; const int p0 = dir ? (c0 + 127 - u0) : (c0 + u0), p1 = dir ? (c0 + 127 - u1) : (c0 + u1);
            const float* g0 = mg + ((size_t)b * SEQ + p0) * 16 + dir * 8 + h; const float* g1p = mg + ((size_t)b * SEQ + p1) * 16 + dir * 8 + h;
            const float ip0 = g0[0], fp0 = g0[4], ip1 = g1p[0], fp1 = g1p[4];
            const float lf0 = fminf(fp0, 0.f) - log1pf(__expf(-fabsf(fp0))), lf1 = fminf(fp1, 0.f) - log1pf(__expf(-fabsf(fp1)));
            const float incl = scan_add(lf0 + lf1, lane);
            const float bc1 = incl, bc0 = incl - lf1;
            const float fs0 = ip0 - bc0, fs1 = ip1 - bc1;
            const float pmx = scan_max(fmaxf(fs0, fs1), lane);
            const float prev = dpp_f<0x138, 0xf>(-3.0e38f, pmx);
            const float dm0 = fmaxf(prev, fs0), dm1 = pmx;
            const float gtot = __uint_as_float(__builtin_amdgcn_readlane(__float_as_uint(bc1), 63)), dlast = __uint_as_float(__builtin_amdgcn_readlane(__float_as_uint(pmx), 63));
            const float M0 = fmaxf(mstate, dm0), M1 = fmaxf(mstate, dm1), Ml = fmaxf(mstate, dlast);
            aux[A_FS / 4 + u0] = fs0; aux[A_FS / 4 + u1] = fs1;
            aux[A_ET / 4 + u0] = -M0; aux[A_ET / 4 + u1] = -M1;
            aux[A_SIN / 4 + u0] = __expf(mstate - M0); aux[A_SIN / 4 + u1] = __expf(mstate - M1);
            aux[A_EMT / 4 + u0] = __expf(-(bc0 + M0)); aux[A_EMT / 4 + u1] = __expf(-(bc1 + M1));
            aux[A_WS / 4 + u0] = __expf(fs0 - Ml); aux[A_WS / 4 + u1] = __expf(fs1 - Ml);
            if (lane == 0) aux[A_SC / 4 + (c & 1)] = __expf(mstate - Ml);
            mstate = gtot + Ml;
        }
        __syncthreads();
        {
            int lb = lane; asm volatile("" : "+v"(lb));
            const int r32 = lb & 31, hh = lb >> 5;
            int RB, RB2, TB;
            { const int sw = swz(r32), li = lb & 15, q_ = li >> 2, p_ = li & 3, x = 2 * ((lb >> 4) & 1) + (p_ >> 1);
              RB = r32 * 256 + ((hh ^ sw) << 4); RB2 = r32 * 256 + (((8 * hh) ^ sw) << 4);
              TB = (4 * hh + q_) * 256 + (((q_ << 2) | (x ^ hh)) << 4) + 8 * (p_ & 1); }
            const int j = wave & 3, vh = wave >> 2, t = 32 * j + r32;
            f32x16 acc[2];
#pragma unroll
            for (int vb2 = 0; vb2 < 2; ++vb2) {
#pragma unroll
                for (int r = 0; r < 16; ++r) acc[vb2][r] = 0.f;
                mm8(acc[vb2], lds, CB, 2 * vh + vb2, QS, j, RB);
                asm volatile("" : "+v"(RB));
            }
            const float sin = aux[A_SIN / 4 + t], et = aux[A_ET / 4 + t];
#pragma unroll
            for (int vb2 = 0; vb2 < 2; ++vb2)
#pragma unroll
                for (int r = 0; r < 16; ++r) acc[vb2][r] *= sin;
            float dn = 0.f;
#pragma unroll
            for (int cq = 0; cq < 8; ++cq) { const int ch = 8 * hh + cq; const v4u qv = *(const LAS v4u*)(lds + QS + (RB2 ^ (cq << 4)) + j * 8192); const f32x4 n0 = *(const LAS f32x4*)(aux + A_NV / 4 + 8 * ch), n1 = *(const LAS f32x4*)(aux + A_NV / 4 + 8 * ch + 4);
                dn += n0.x * bflo(qv.x) + n0.y * bfhi(qv.x) + n0.z * bflo(qv.y) + n0.w * bfhi(qv.y) + n1.x * bflo(qv.z) + n1.y * bfhi(qv.z) + n1.z * bflo(qv.w) + n1.w * bfhi(qv.w);
                if (cq & 1) { asm volatile("" : "+v"(dn)); __builtin_amdgcn_sched_barrier(0); } }
            float dsum = 0.f;
            for (int i = 0; i <= j; ++i) {
                f32x16 sc;
#pragma unroll
                for (int r = 0; r < 16; ++r) sc[r] = 0.f;
                mm8(sc, lds, KS, i, QS, j, RB);
                asm volatile("" : "+v"(RB));
                bf16x8 vfr[4];
#pragma unroll
                for (int vb2 = 0; vb2 < 2; ++vb2) { vfr[2 * vb2] = trB(lds, VS, TB, 32 * i, 4 * (2 * vh + vb2)); vfr[2 * vb2 + 1] = trB(lds, VS, TB, 32 * i + 16, 4 * (2 * vh + vb2)); }
                __builtin_amdgcn_sched_barrier(0);
#pragma unroll
                for (int r4 = 0; r4 < 4; ++r4) { const f32x4 fs = *(const LAS f32x4*)(aux + A_FS / 4 + 32 * i + 8 * r4 + 4 * hh);
#pragma unroll
                    for (int e = 0; e < 4; ++e) { const int r = 4 * r4 + e; const float p = __expf(et + fs[e]); const bool ok = (i < j) || (8 * r4 + 4 * hh + e <= r32);
                        const float w = ok ? sc[r] * p : 0.f; sc[r] = w; dsum += w; } }
                v4u w0, w1;
                w0.x = cvtpk(sc[0], sc[1]); w0.y = cvtpk(sc[2], sc[3]); w0.z = cvtpk(sc[4], sc[5]); w0.w = cvtpk(sc[6], sc[7]);
                w1.x = cvtpk(sc[8], sc[9]); w1.y = cvtpk(sc[10], sc[11]); w1.z = cvtpk(sc[12], sc[13]); w1.w = cvtpk(sc[14], sc[15]);
                const bf16x8 wf0 = __builtin_bit_cast(bf16x8, w0), wf1 = __builtin_bit_cast(bf16x8, w1);
                __builtin_amdgcn_sched_barrier(0);
#pragma unroll
                for (int vb2 = 0; vb2 < 2; ++vb2) {
                    acc[vb2] = __builtin_amdgcn_mfma_f32_32x32x16_bf16(vfr[2 * vb2], wf0, acc[vb2], 0, 0, 0);
                    acc[vb2] = __builtin_amdgcn_mfma_f32_32x32x16_bf16(vfr[2 * vb2 + 1], wf1, acc[vb2], 0, 0, 0);
                    __builtin_amdgcn_sched_barrier(0);
                }
            }
            const float den = swapsum(dn) * sin + swapsum(dsum);
            const float scale = 1.0f / fmaxf(fabsf(den), aux[A_EMT / 4 + t]);
            const int pos = dir ? (c0 + 127 - t) : (c0 + t);
            bf16* op = outp + ((size_t)b * SEQ + pos) * 512 + h * 128 + 4 * hh;
#pragma unroll
            for (int vb2 = 0; vb2 < 2; ++vb2)
#pragma unroll
                for (int r4 = 0; r4 < 4; ++r4) { v2u o4; o4.x = cvtpk(acc[vb2][4 * r4] * scale, acc[vb2][4 * r4 + 1] * scale); o4.y = cvtpk(acc[vb2][4 * r4 + 2] * scale, acc[vb2][4 * r4 + 3] * scale);
                    *(v2u*)(op + 32 * (2 * vh + vb2) + 8 * r4) = o4; }
        }
        __syncthreads();
        {
            int lb = lane; asm volatile("" : "+v"(lb));
            const int hh = lb >> 5;
            int TC;
            { const int li = lb & 15, q_ = li >> 2, p_ = li & 3, x = 2 * ((lb >> 4) & 1) + (p_ >> 1);
              TC = (8 * hh + q_) * 256 + (((q_ << 2) | (x ^ (2 * hh))) << 4) + 8 * (p_ & 1); }
            const int vs = wave & 3, kh = wave >> 2;
            const float sp = aux[A_SC / 4 + (c & 1)];
#pragma unroll
            for (int kb = 0; kb < 2; ++kb)
#pragma unroll
                for (int r = 0; r < 16; ++r) X[kb][r] *= sp;
            {
                bf16x8 vr_[2], k0_[2], k1_[2]; f32x4 wa_[2], wb_[2];
                vr_[0] = trC(lds, VS, TC, 0, 4 * vs); k0_[0] = trC(lds, KS, TC, 0, 8 * kh); k1_[0] = trC(lds, KS, TC, 0, 8 * kh + 4);
                wa_[0] = *(const LAS f32x4*)(aux + A_WS / 4 + 8 * hh); wb_[0] = *(const LAS f32x4*)(aux + A_WS / 4 + 8 * hh + 4);
#pragma unroll
                for (int ss = 0; ss < 8; ++ss) { const int cu = ss & 1, nx = cu ^ 1;
                    if (ss + 1 < 8) { vr_[nx] = trC(lds, VS, TC, ss + 1, 4 * vs); k0_[nx] = trC(lds, KS, TC, ss + 1, 8 * kh); k1_[nx] = trC(lds, KS, TC, ss + 1, 8 * kh + 4);
                        wa_[nx] = *(const LAS f32x4*)(aux + A_WS / 4 + 16 * (ss + 1) + 8 * hh); wb_[nx] = *(const LAS f32x4*)(aux + A_WS / 4 + 16 * (ss + 1) + 8 * hh + 4); }
                    const v4u vv = __builtin_bit_cast(v4u, vr_[cu]); const f32x4 wa = wa_[cu], wb = wb_[cu]; v4u vw;
                    vw.x = cvtpk(bflo(vv.x) * wa.x, bfhi(vv.x) * wa.y); vw.y = cvtpk(bflo(vv.y) * wa.z, bfhi(vv.y) * wa.w); vw.z = cvtpk(bflo(vv.z) * wb.x, bfhi(vv.z) * wb.y); vw.w = cvtpk(bflo(vv.w) * wb.z, bfhi(vv.w) * wb.w);
                    const bf16x8 vf = __builtin_bit_cast(bf16x8, vw);
                    X[0] = __builtin_amdgcn_mfma_f32_32x32x16_bf16(k0_[cu], vf, X[0], 0, 0, 0);
                    X[1] = __builtin_amdgcn_mfma_f32_32x32x16_bf16(k1_[cu], vf, X[1], 0, 0, 0);
                    __builtin_amdgcn_sched_barrier(0);
                }
            }
            { int t2 = tid; asm volatile("" : "+v"(t2)); const int k = t2 & 127, sq = t2 >> 7; float a = 0.f;
#pragma unroll 8
              for (int s2 = 0; s2 < 32; ++s2) { const int sI = 32 * sq + s2; a += aux[A_WS / 4 + sI] * bf2f(*(const LAS unsigned short*)(lds + KS + offs(sI, k >> 3) + (k & 7) * 2)); }
              aux[A_NP / 4 + sq * 128 + k] = a; }
        }
        __syncthreads();
        { int lb = lane; asm volatile("" : "+v"(lb)); const int r32 = lb & 31, hh = lb >> 5;
          const int vs = wave & 3, kh = wave >> 2, v = 32 * vs + r32;
#pragma unroll
          for (int kb = 0; kb < 2; ++kb)
#pragma unroll
              for (int r4 = 0; r4 < 4; ++r4) { v2u w; w.x = cvtpk(X[kb][4 * r4], X[kb][4 * r4 + 1]); w.y = cvtpk(X[kb][4 * r4 + 2], X[kb][4 * r4 + 3]);
                  *(LAS v2u*)(lds + CB + offs(v, 8 * kh + 4 * kb + r4) + 8 * hh) = w; } }
    }
    __syncthreads();
}
}
constexpr int CW_QUEUE = 2048;
__device__ __forceinline__ void ph_mixers(Frame& F, int l, int qslot) {
    PH_IDS;
    static_assert(DEPTH == 2, "lam_init literals");
    const float lam_init = (l == 0) ? 0.2f : 0.35550906759096927f;
    const float* lam = F.in[I_LAM] + (size_t)l * 4 * ADH;
    const float s01 = wave_sum_fast(lam[lane] * lam[64 + lane]), s23 = wave_sum_fast(lam[128 + lane] * lam[192 + lane]);
    const float lam_full = __uint_as_float(__builtin_amdgcn_readfirstlane(__float_as_uint(__expf(s01) - __expf(s23) + lam_init)));
    const unsigned oml = (l == 0) ? 0x3f4ccccdu : 0x3f24fd5cu;
    const float* cw = F.in[I_CW] + (size_t)l * CONVW * 2 * MW; const float* cb = F.in[I_CB] + (size_t)l * 2 * MW;
    unsigned* head = (unsigned*)(F.ws + WS_CTL) + CW_QUEUE + 64 * qslot;
    volatile LAS unsigned* qw = (volatile LAS unsigned*)(F.lds + MISC_OFF + 64);
    constexpr int NML = BATCH * MH * 2, NAT = BATCH * AH * (SEQ / 128);
    constexpr int NCV0 = (CV_NITEMS - CV_WIN) / 128, NCV1 = CV_WIN / 128;
    static_assert((CV_NITEMS - CV_WIN) % 128 == 0 && CV_WIN % 128 == 0 && 3 * (NCV0 + NCV1) <= NAT + NCV0 + NCV1, "conversion items are 128 tiles; the (2 attention, 1 conversion) groups fit");
    const int NCV = NCV0 + ((l + 1 < DEPTH) ? NCV1 : 0);
    for (;;) {
        __syncthreads();
        if (tid == 0) qw[0] = __hip_atomic_fetch_add(head, 1u, __ATOMIC_RELAXED, __HIP_MEMORY_SCOPE_AGENT);
        __syncthreads();
        int it = (int)qw[0];
        if (PROBE_REP & 8) { if (it >= NML + 2 * (NAT + NCV)) break; if (it >= NML + NAT + NCV) it -= NAT + NCV; }
        else if (PROBE_REP & 4) { if (it >= 2 * NML + NAT + NCV) break; if (it >= NML + NAT + NCV) it -= NML + NAT + NCV; }
        else if (it >= NML + NAT + NCV) break;
        const int tq_ = F.wv * 64 + lane_id_volatile();
        if (it < NML) { const int dir = it & 1, h = (it >> 1) & 3, b = it >> 3; int t1 = tq_; asm volatile("" : "+v"(t1));
            mls::item(F.lds, t1, b, h, dir, WSP(bf16, WS_ZQK), WSP(bf16, WS_ZMV), WSP(float, WS_MG), cw, cb, WSP(bf16, dir ? WS_HB : WS_HF)); }
        else {
            const int j = it - NML; int u, ci = -1;
            if (j < 3 * NCV) { if (j % 3 == 2) ci = j / 3; u = j - j / 3; } else u = j - NCV;
            if (ci >= 0) {
                int t2 = tq_; asm volatile("" : "+v"(t2));
                const int l2 = (ci >= NCV0) ? l + 1 : l, first = (ci >= NCV0) ? (ci - NCV0) * 128 : CV_WIN + ci * 128;
                cv_run(F, l2, t2 & 63, (LAS float*)(F.lds + (t2 >> 6) * 16384), first, 128, __builtin_amdgcn_readfirstlane(t2 >> 6), NWAVES); }
            else { const int qb = u & 15, b = (u >> 4) & 15, h = 3 - (u >> 8);
            int t3 = tq_; asm volatile("" : "+v"(t3));
            attn::unit(F.lds, t3, b, h, qb, WSP(bf16, WS_ZDQ), WSP(bf16, WS_ZDK), WSP(bf16, WS_ZDV), WSP(bf16, WS_HM), F.in[I_DNG] + (size_t)l * ADV, lam_full, oml); } }
    }
}

constexpr int NPH = 1 + DEPTH * 10;
__global__ void __launch_bounds__(NTHREADS, 2) fwd(Args args) {
    extern __shared__ __attribute__((aligned(16))) unsigned char lds_raw[];
    Frame F;
    F.lds = (LAS unsigned char*)lds_raw;
    F.G = gridDim.x; F.bx = blockIdx.x; F.wv = __builtin_amdgcn_readfirstlane(threadIdx.x >> 6);
#pragma unroll
    for (int i = 0; i < 18; ++i) F.in[i] = args.in[i];
    F.X = args.out; F.ws = args.ws;
    volatile LAS unsigned* MISC = (volatile LAS unsigned*)(F.lds + MISC_OFF);
    for (int u = threadIdx.x; u < (LDS_BYTES - LDSCTL_OFF) / 4; u += NTHREADS) ((LAS unsigned*)(F.lds + LDSCTL_OFF))[u] = 0u;
    __syncthreads();
    const int lo = args.ph_lo, hi = args.ph_hi;
    XcdBarrier bar; bar.bar = (unsigned*)(F.ws + WS_CTL) + CW_BAR; bar.x = 0; bar.st = nullptr;
    if (hi - lo > 1) bar = xcd_barrier_post((unsigned*)(F.ws + WS_CTL) + CW_BAR, MISC + 8);
#define IN(k) (lo <= (k) && (k) < hi)
#define SEAM(k) do { if (IN(k) && IN((k) + 1)) { xcd_barrier(bar); if (PROBE_REP & 4096) xcd_barrier(bar); } } while (0)
    LAS unsigned char* ring = F.lds;

    if (IN(0)) { ph_convert(F, 0); ph_prep_first(F);
        if (PROBE_REP & 1) { __syncthreads(); ph_convert(F, 0); ph_prep_first(F); } }
    SEAM(0);
    for (int l = 0; l < DEPTH; ++l) {
        const int p0 = 1 + l * 10;
        if (IN(p0 + 0)) {
            ph_mgate(F, l);
            pg8::StdOrder S; S.init(T, NIN - 2560, F.G, F.bx);
            pg8::EpiInproj E{WSP(bf16, WS_ZQK), WSP(bf16, WS_ZMV), WSP(bf16, WS_ZMO), WSP(bf16, WS_ZDQ), WSP(bf16, WS_ZDK), WSP(bf16, WS_ZDV), WSP(bf16, WS_ZG), WSP(float, WS_RSTD1)};
            pg8::gemm_phase(ring, WSP(bf16, WS_XR), WSP(bf16, WS_WIN), D, S, E, F.wv);
            pg8::StdOrderG S2; S2.init(T, 2560, F.G, F.bx);
            pg8::EpiGate8 E2{WSP(bf16, WS_ZMO), WSP(bf16, WS_ZG), WSP(float, WS_RSTD1)};
            pg8::gemm_phase(ring, WSP(bf16, WS_MIX), (const pg8::bf16_t*)(F.ws + WS_WIN8), D / 2, S2, E2, F.wv);
        }
        SEAM(p0 + 0);
        if (IN(p0 + 1)) { ph_mixers(F, l, l); }
        SEAM(p0 + 1);
        if (IN(p0 + 2)) { for (int rep = 0; rep < ((PROBE_REP & 16) ? 2 : 1); ++rep) ph_mnorm(F, l); }
        SEAM(p0 + 2);
        if (IN(p0 + 3)) {
            pg8::UpOrder S; S.init(T, D, F.G, F.bx);
            pg8::EpiUp E{WSP(bf16, WS_MIX), WSP(bf16, WS_ZG)}; pg8::gemm_phase(ring, WSP(bf16, WS_HM), WSP(bf16, l == 0 ? WS_WA : WS_WA_L1), MW, S, E, F.wv, 1024);
        }
        SEAM(p0 + 3);
        if (IN(p0 + 4)) {
            pg8::StdOrder S; S.init(T, D, F.G, F.bx);
            pg8::EpiResid E{WSP(bf16, WS_XR)}; pg8::gemm_phase(ring, WSP(bf16, WS_MIX), WSP(bf16, l == 0 ? WS_WO : WS_WO_L1), D, S, E, F.wv);
        }
        SEAM(p0 + 4);
        if (IN(p0 + 5)) { for (int rep = 0; rep < ((PROBE_REP & 64) ? 2 : 1); ++rep) ph_prep2(F, l); }
        SEAM(p0 + 5);
        if (IN(p0 + 6)) { for (int rep = 0; rep < ((PROBE_REP & 128) ? 2 : 1); ++rep) ph_topk(F); }
        SEAM(p0 + 6);
        if (IN(p0 + 7)) {
            pg8::G1Order S{WSP(int, WS_IDX), F.G, F.bx};
            pg8::EpiG1 E{F.ws + WS_HID}; for (int rep = 0; rep < ((PROBE_REP & 256) ? 2 : 1); ++rep) pg8::gemm_phase(ring, WSP(bf16, WS_XB), WSP(bf16, l == 0 ? WS_WGU : WS_WGU_L1), D / 2, S, E, F.wv);
        }
        SEAM(p0 + 7);
        if (IN(p0 + 8)) {
            pg8::G2Order S{F.G, F.bx};
            pg8::EpiG2 E{WSP(bf16, WS_YE), WSP(float, WS_GATEV)}; for (int rep = 0; rep < ((PROBE_REP & 512) ? 2 : 1); ++rep) pg8::gemm_phase(ring, WSP(bf16, WS_HID), WSP(bf16, l == 0 ? WS_WD : WS_WD_L1), DFF / 2, S, E, F.wv);
        }
        SEAM(p0 + 8);
        if (IN(p0 + 9)) { ph_combine(F, l); }
        SEAM(p0 + 9);
    }
#undef IN
#undef SEAM
}

extern "C" void kernel_launch(void* const* d_in, const int* in_sizes, int n_in, void* d_out, int out_size, void* d_ws, size_t ws_size, hipStream_t stream) {
    static int grid = 0;
    if (grid == 0) {
        if (n_in != 18 || out_size != T * D || ws_size < WS_END2) { fprintf(stderr, "kernel_launch: unexpected shapes (n_in %d, out %d, ws %zu)\n", n_in, out_size, ws_size); grid = -1; return; }
        int dev = 0, cus = 0, per_cu = 0;
        if (hipGetDevice(&dev) != hipSuccess || hipDeviceGetAttribute(&cus, hipDeviceAttributeMultiprocessorCount, dev) != hipSuccess) { grid = -1; return; }
        if (hipFuncSetAttribute((const void*)fwd, hipFuncAttributeMaxDynamicSharedMemorySize, LDS_BYTES) != hipSuccess) { fprintf(stderr, "kernel_launch: hipFuncSetAttribute failed\n"); grid = -1; return; }
        if (hipOccupancyMaxActiveBlocksPerMultiprocessor(&per_cu, (const void*)fwd, NTHREADS, LDS_BYTES) != hipSuccess || per_cu < 1) fprintf(stderr, "kernel_launch: occupancy query says %d\n", per_cu);
        (void)hipGetLastError();
        grid = cus;
    }
    if (grid < 0) return;
    (void)hipMemsetAsync((char*)d_ws + WS_CTL, 0, CTL_ZERO_BYTES, stream);
    Args a{};
    for (int i = 0; i < 18; ++i) a.in[i] = (const float*)d_in[i];
    a.out = (float*)d_out; a.ws = (unsigned char*)d_ws;
#if MK_ONE_LAUNCH
    a.ph_lo = 0; a.ph_hi = NPH;
    hipLaunchKernelGGL(fwd, dim3(grid), dim3(NTHREADS), LDS_BYTES, stream, a);
#else
    for (int p = 0; p < NPH; ++p) { a.ph_lo = p; a.ph_hi = p + 1; hipLaunchKernelGGL(fwd, dim3(grid), dim3(NTHREADS), LDS_BYTES, stream, a); }
#endif
}
```

```cpp
#include <hip/hip_runtime.h>
#include <cstdio>
#include <cstdint>

#ifndef PROBE_REP
#define PROBE_REP 0
#endif
#ifndef NAIVE_MLSTM
#define NAIVE_MLSTM 0
#endif
#ifndef NAIVE_ATTN
#define NAIVE_ATTN 0
#endif
#ifndef MK_ONE_LAUNCH
#define MK_ONE_LAUNCH 1
#endif

constexpr int D = 1024, BATCH = 16, SEQ = 2048, T = BATCH * SEQ, DEPTH = 2;
constexpr int MH = 4, MDH = 128, MW = 512, CONVW = 5, NMG = 16;
constexpr int AH = 4, ADH = 64, ADV = 128;
constexpr int IN_COLS = 5648, OFF_MG = 2048, OFF_DQ = 2064;
constexpr int NE = 16, CAP = 256, DFF = 2048;
constexpr int NIN = 5632;
constexpr float EPS = 1e-6f;
constexpr float LOG2E = 1.4426950408889634f;
constexpr int NWAVES = 8, NTHREADS = 512;

#define GAS __attribute__((address_space(1)))
#define LAS __attribute__((address_space(3)))
typedef unsigned short bf16;
typedef unsigned v4u __attribute__((ext_vector_type(4)));
typedef unsigned v2u __attribute__((ext_vector_type(2)));
typedef float f32x4 __attribute__((ext_vector_type(4)));
typedef float f32x2 __attribute__((ext_vector_type(2)));
typedef short bf16x8 __attribute__((ext_vector_type(8)));

__device__ __forceinline__ float bf2f(unsigned short b) { return __uint_as_float(((unsigned)b) << 16); }
__device__ __forceinline__ float bflo(unsigned w) { return __uint_as_float(w << 16); }
__device__ __forceinline__ float bfhi(unsigned w) { return __uint_as_float(w & 0xffff0000u); }
__device__ __forceinline__ unsigned f2bf(float f) { unsigned u = __float_as_uint(f); return (u + 0x7fffu + ((u >> 16) & 1u)) >> 16; }
typedef __bf16 bf16x2_n_ __attribute__((ext_vector_type(2)));
__device__ __forceinline__ unsigned pk2(float lo, float hi) { const f32x2 x = (f32x2){lo, hi}; const bf16x2_n_ v = __builtin_convertvector(x, bf16x2_n_); return __builtin_bit_cast(unsigned, v); }
__device__ __forceinline__ float wave_sum(float v) {
#pragma unroll
    for (int o = 1; o < 64; o <<= 1) v += __shfl_xor(v, o);
    return v;
}
__device__ __forceinline__ float sigmoidf_(float x) { return __builtin_amdgcn_rcpf(1.0f + __builtin_amdgcn_exp2f(-x * LOG2E)); }

namespace pg8 {
#define PG8_LAS __attribute__((address_space(3)))
typedef unsigned short bf16_t;
typedef unsigned u32x4 __attribute__((ext_vector_type(4)));
typedef int v4i __attribute__((ext_vector_type(4)));
constexpr int BM = 256, BK = 64, HALF = 128, HTB = HALF * BK * 2, STAGE_BYTES = 8 * HTB, NXCD = 8, WGM = 8;

__host__ __device__ __forceinline__ int lds_byte(int r, int c) { const int st = (r >> 4) * 2 + (c >> 5), rr = r & 15, cc = c & 31, ob = rr * 64 + cc * 2; return st * 1024 + (ob ^ (((ob >> 9) & 1) << 5)); }
__host__ __device__ __forceinline__ void stage_rc(int b, int& R, int& C) { const int st = b / 1024, sb = b % 1024, swz = sb ^ (((sb >> 9) & 1) << 5); R = (st >> 1) * 16 + swz / 64; C = (st & 1) * 32 + (swz % 64) / 2; }
__host__ __device__ __forceinline__ int perm32(int rho) { const int n = rho >> 4, i = rho & 15; return 8 * (i >> 2) + 4 * n + (i & 3); }

struct Unit { int pm, pn, bt, kofs; };

struct StdOrder {
    int nM, nN, nwg, G, c;
    __device__ void init(int M, int N, int G_, int c_) { nM = M / BM; nN = N / BM; nwg = nM * nN; G = G_; c = c_; }
    __device__ bool next(int i, Unit& u) const {
        const long L = (long)i * G + c; if (L >= nwg) return false;
        int wgid = (int)L; { const int q = nwg / NXCD, r = nwg % NXCD, xcd = wgid % NXCD, off = wgid / NXCD; wgid = (xcd < r ? xcd * (q + 1) : r * (q + 1) + (xcd - r) * q) + off; }
        const int nig = WGM * nN, gid = wgid / nig, fm = gid * WGM, gsz = (nM - fm) < WGM ? (nM - fm) : WGM;
        u.pm = fm + ((wgid % nig) % gsz); u.pn = (wgid % nig) / gsz; u.bt = u.pn; u.kofs = 0; return true;
    }
    static constexpr bool GATHER = false;
};
struct StdOrderG : StdOrder {
    static constexpr bool GATHER = true;
    __device__ __forceinline__ int a_row(const Unit& u, int r) const { return u.pm * 256 + r; }
};
struct G1Order {
    const int* idx; int G, c;
    __device__ bool next(int i, Unit& u) const {
        if (G != 256) { const int L = i * G + c; if (L >= 4096) return false; u.pm = L >> 4; u.pn = L & 15; u.bt = (u.pm & 15) * 16 + u.pn; u.kofs = 0; return true; }
        if (i >= 16) return false;
        const int xcd = c & 7, loc = c >> 3, e = 2 * xcd + (i >> 3), r = i & 7, b = (r & 3) * 4 + (loc & 3), j = (r >> 2) * 8 + (loc >> 2);
        u.pm = b * 16 + e; u.pn = j; u.bt = e * 16 + j; u.kofs = 0; return true;
    }
    static constexpr bool GATHER = true;
    __device__ __forceinline__ int a_row(const Unit& u, int r) const { return idx[u.pm * 256 + r]; }
};
struct G2Order {
    int G, c;
    __device__ bool next(int i, Unit& u) const {
        if (G != 256) { const int L = i * G + c; if (L >= 1024) return false; u.pm = L >> 2; u.pn = L & 3; u.bt = (u.pm & 15) * 4 + u.pn; u.kofs = 0; return true; }
        if (i >= 4) return false;
        const int xcd = c & 7, loc = c >> 3, e = 2 * xcd + (i >> 1), b = (i & 1) * 8 + (loc & 7), pn = loc >> 3;
        u.pm = b * 16 + e; u.pn = pn; u.bt = e * 4 + pn; u.kofs = 0; return true;
    }
    static constexpr bool GATHER = true;
    __device__ __forceinline__ int a_row(const Unit& u, int r) const { return u.pm * 256 + r; }
};

typedef float f32x2_t_ __attribute__((ext_vector_type(2))); typedef __bf16 bf16x2_t_ __attribute__((ext_vector_type(2)));
__device__ __forceinline__ unsigned cvt_pk_bf16(float lo, float hi) { const f32x2_t_ x = (f32x2_t_){lo, hi}; const bf16x2_t_ b = __builtin_convertvector(x, bf16x2_t_); return __builtin_bit_cast(unsigned, b); }

typedef f32x4 Acc[2][2][4][2];

struct EpiInproj {
    static constexpr bool PERM = true, MIDWAY = false, F8 = false;
    bf16_t *zqk, *zmv, *zmo, *zdq, *zdk, *zdv, *zg; const float* rs;
    __device__ __forceinline__ void operator()(const Acc& acc, const Unit& u, int wr, int wc, int fr, int fq) const {
        const int pn = u.pn; bf16_t* base; int ldc, colt, act = 0;
        if (pn < 4) { base = zqk; ldc = 1024; colt = pn * 256; }
        else if (pn < 6) { base = zmv; ldc = 512; colt = (pn - 4) * 256; }
        else if (pn < 8) { base = zdq; ldc = 512; colt = (pn - 6) * 256; act = 2; }
        else if (pn < 10) { base = zdk; ldc = 512; colt = (pn - 8) * 256; }
        else { base = zdv; ldc = 512; colt = (pn - 10) * 256; }
        const int row0 = u.pm * BM + wr * 64 + fr, col0 = colt + wc * 32 + 8 * fq;
#pragma unroll
        for (int ai = 0; ai < 2; ++ai)
#pragma unroll
            for (int m = 0; m < 4; ++m) { const int row = row0 + ai * HALF + m * 16; bf16_t* rowp = base + (size_t)row * ldc + col0; const float rsc = rs[row] * ((act == 2) ? 0.125f * LOG2E : 1.0f);
#pragma unroll
                for (int bj = 0; bj < 2; ++bj) { f32x4 v0 = acc[ai][bj][m][0] * rsc, v1 = acc[ai][bj][m][1] * rsc;
                    if (act == 1) {
#pragma unroll
                        for (int j = 0; j < 4; ++j) { v0[j] = sigmoidf_(v0[j]); v1[j] = sigmoidf_(v1[j]); } }
                    u32x4 w; w.x = cvt_pk_bf16(v0[0], v0[1]); w.y = cvt_pk_bf16(v0[2], v0[3]); w.z = cvt_pk_bf16(v1[0], v1[1]); w.w = cvt_pk_bf16(v1[2], v1[3]);
                    *(u32x4*)(rowp + bj * HALF) = w; } }
    }
};
#define RCPG(x) __builtin_amdgcn_rcpf(fmaxf((x), 1e-30f))
struct UpOrder : StdOrder {
    __device__ bool next(int i, Unit& u) const { if (!StdOrder::next(i >> 1, u)) return false; u.kofs = (i & 1) * 1024; return true; }
};
struct EpiUp {
    static constexpr bool PERM = true, MIDWAY = true, F8 = false;
    bf16_t* mix; const bf16_t* zg;
    __device__ __forceinline__ bool midway(Acc& acc, const Unit& u, int wr, int wc, int fr, int fq) const {
        if (u.kofs != 0) return false;
        const int row0 = u.pm * BM + wr * 64 + fr, col0 = u.pn * BM + wc * 32 + 8 * fq;
#pragma unroll
        for (int ai = 0; ai < 2; ++ai)
#pragma unroll
            for (int m = 0; m < 4; ++m) { const size_t row = (size_t)(row0 + ai * HALF + m * 16);
#pragma unroll
                for (int bj = 0; bj < 2; ++bj) { const int col = col0 + bj * HALF;
                    const u32x4 ga = *(const u32x4*)(zg + row * 2048 + col), gb = *(const u32x4*)(zg + row * 2048 + 1024 + col);
                    f32x4& v0 = acc[ai][bj][m][0]; f32x4& v1 = acc[ai][bj][m][1];
                    v0[0] *= bflo(ga.x) * RCPG(bflo(gb.x)); v0[1] *= bfhi(ga.x) * RCPG(bfhi(gb.x)); v0[2] *= bflo(ga.y) * RCPG(bflo(gb.y)); v0[3] *= bfhi(ga.y) * RCPG(bfhi(gb.y));
                    v1[0] *= bflo(ga.z) * RCPG(bflo(gb.z)); v1[1] *= bfhi(ga.z) * RCPG(bfhi(gb.z)); v1[2] *= bflo(ga.w) * RCPG(bflo(gb.w)); v1[3] *= bfhi(ga.w) * RCPG(bfhi(gb.w)); } }
        return true;
    }
    __device__ __forceinline__ void operator()(const Acc& acc, const Unit& u, int wr, int wc, int fr, int fq) const {
        const int row0 = u.pm * BM + wr * 64 + fr, col0 = u.pn * BM + wc * 32 + 8 * fq;
#pragma unroll
        for (int ai = 0; ai < 2; ++ai)
#pragma unroll
            for (int m = 0; m < 4; ++m) { const size_t row = (size_t)(row0 + ai * HALF + m * 16);
#pragma unroll
                for (int bj = 0; bj < 2; ++bj) { const int col = col0 + bj * HALF;
                    const u32x4 g = *(const u32x4*)(zg + row * 2048 + 1024 + col);
                    f32x4 v0 = acc[ai][bj][m][0], v1 = acc[ai][bj][m][1];
                    v0[0] *= bflo(g.x); v0[1] *= bfhi(g.x); v0[2] *= bflo(g.y); v0[3] *= bfhi(g.y);
                    v1[0] *= bflo(g.z); v1[1] *= bfhi(g.z); v1[2] *= bflo(g.w); v1[3] *= bfhi(g.w);
                    u32x4 w; w.x = cvt_pk_bf16(v0[0], v0[1]); w.y = cvt_pk_bf16(v0[2], v0[3]); w.z = cvt_pk_bf16(v1[0], v1[1]); w.w = cvt_pk_bf16(v1[2], v1[3]);
                    *(u32x4*)(mix + row * 1024 + col) = w; } }
    }
};
struct EpiResid {
    static constexpr bool PERM = true, MIDWAY = false, F8 = false;
    bf16_t* x;
    __device__ __forceinline__ void operator()(const Acc& acc, const Unit& u, int wr, int wc, int fr, int fq) const {
        const int row0 = u.pm * BM + wr * 64 + fr, col0 = u.pn * BM + wc * 32 + 8 * fq;
#pragma unroll
        for (int ai = 0; ai < 2; ++ai)
#pragma unroll
            for (int m = 0; m < 4; ++m) { bf16_t* rowp = x + (size_t)(row0 + ai * HALF + m * 16) * 1024 + col0;
#pragma unroll
                for (int bj = 0; bj < 2; ++bj) { const u32x4 o = *(const u32x4*)(rowp + bj * HALF); const f32x4 a0 = acc[ai][bj][m][0], a1 = acc[ai][bj][m][1];
                    u32x4 w; w.x = cvt_pk_bf16(a0[0] + bflo(o.x), a0[1] + bfhi(o.x)); w.y = cvt_pk_bf16(a0[2] + bflo(o.y), a0[3] + bfhi(o.y));
                    w.z = cvt_pk_bf16(a1[0] + bflo(o.z), a1[1] + bfhi(o.z)); w.w = cvt_pk_bf16(a1[2] + bflo(o.w), a1[3] + bfhi(o.w));
                    *(u32x4*)(rowp + bj * HALF) = w; } }
    }
};
constexpr int W8_LOG2 = 5, H8_LOG2 = 2;
constexpr float W8_SCALE = 32.0f, H8_SCALE = 4.0f, Y8_SCALE = 64.0f;
__device__ __forceinline__ float clamp_f8(float x) { float r; asm("v_max_f32 %0, 0xc3e00000, %1\n\tv_min_f32 %0, 0x43e00000, %0" : "=v"(r) : "v"(x)); return r; }
__device__ __forceinline__ unsigned pk4_fp8(float a, float b, float c, float d) {
    int p = __builtin_amdgcn_cvt_pk_fp8_f32(clamp_f8(a), clamp_f8(b), 0, false); p = __builtin_amdgcn_cvt_pk_fp8_f32(clamp_f8(c), clamp_f8(d), p, true); return (unsigned)p; }
struct EpiG1 {
    static constexpr bool PERM = true, MIDWAY = false, F8 = true;
    unsigned char* hid;
    __device__ __forceinline__ void operator()(const Acc& acc, const Unit& u, int wr, int wc, int fr, int fq) const {
        const int row0 = u.pm * BM + wr * 64 + fr, col0 = u.pn * 128 + wc * 32 + 8 * fq;
        constexpr float SG = 1.0f / W8_SCALE;
#pragma unroll
        for (int ai = 0; ai < 2; ++ai)
#pragma unroll
            for (int m = 0; m < 4; ++m) { unsigned char* rowp = hid + (size_t)(row0 + ai * HALF + m * 16) * DFF + col0;
                f32x4 v0, v1;
#pragma unroll
                for (int j = 0; j < 4; ++j) { const float g0 = acc[ai][0][m][0][j], g1 = acc[ai][0][m][1][j];
                    v0[j] = g0 * sigmoidf_(g0 * SG) * __builtin_amdgcn_ldexpf(acc[ai][1][m][0][j], H8_LOG2 - 2 * W8_LOG2); v1[j] = g1 * sigmoidf_(g1 * SG) * __builtin_amdgcn_ldexpf(acc[ai][1][m][1][j], H8_LOG2 - 2 * W8_LOG2); }
                v2u w; w.x = pk4_fp8(v0[0], v0[1], v0[2], v0[3]); w.y = pk4_fp8(v1[0], v1[1], v1[2], v1[3]);
                *(v2u*)rowp = w; }
    }
};
struct EpiGate8 {
    static constexpr bool PERM = true, MIDWAY = false, F8 = true;
    bf16_t *zmo, *zg; const float* rs;
    __device__ __forceinline__ void operator()(const Acc& acc, const Unit& u, int wr, int wc, int fr, int fq) const {
        bf16_t* base; int ldc, colt;
        if (u.pn < 2) { base = zmo; ldc = 512; colt = u.pn * 256; } else { base = zg; ldc = 2048; colt = (u.pn - 2) * 256; }
        const int row0 = u.pm * BM + wr * 64 + fr, col0 = colt + wc * 32 + 8 * fq;
        constexpr float SG = 1.0f / W8_SCALE;
#pragma unroll
        for (int ai = 0; ai < 2; ++ai)
#pragma unroll
            for (int m = 0; m < 4; ++m) { const int row = row0 + ai * HALF + m * 16; bf16_t* rowp = base + (size_t)row * ldc + col0; const float rsc = rs[row] * SG;
#pragma unroll
                for (int bj = 0; bj < 2; ++bj) { f32x4 v0 = acc[ai][bj][m][0], v1 = acc[ai][bj][m][1];
#pragma unroll
                    for (int j = 0; j < 4; ++j) { v0[j] = sigmoidf_(v0[j] * rsc); v1[j] = sigmoidf_(v1[j] * rsc); }
                    u32x4 w; w.x = cvt_pk_bf16(v0[0], v0[1]); w.y = cvt_pk_bf16(v0[2], v0[3]); w.z = cvt_pk_bf16(v1[0], v1[1]); w.w = cvt_pk_bf16(v1[2], v1[3]);
                    *(u32x4*)(rowp + bj * HALF) = w; } }
    }
};
struct EpiG2 {
    static constexpr bool PERM = true, MIDWAY = false, F8 = true;
    unsigned char* ye; const float* gatev;
    __device__ __forceinline__ void operator()(const Acc& acc, const Unit& u, int wr, int wc, int fr, int fq) const {
        const int row0 = u.pm * BM + wr * 64 + fr, col0 = u.pn * BM + wc * 32 + 8 * fq;
#pragma unroll
        for (int ai = 0; ai < 2; ++ai)
#pragma unroll
            for (int m = 0; m < 4; ++m) { const int row = row0 + ai * HALF + m * 16; const float g = gatev[row] * (Y8_SCALE / (W8_SCALE * H8_SCALE)); unsigned char* rowp = ye + (size_t)row * 1024 + col0;
#pragma unroll
                for (int bj = 0; bj < 2; ++bj) { const f32x4 v0 = acc[ai][bj][m][0] * g, v1 = acc[ai][bj][m][1] * g;
                    v2u w; w.x = pk4_fp8(v0[0], v0[1], v0[2], v0[3]); w.y = pk4_fp8(v1[0], v1[1], v1[2], v1[3]);
                    *(v2u*)(rowp + bj * HALF) = w; } }
    }
};

template <class Epi, class Sched>
__device__ __forceinline__ void gemm_phase(PG8_LAS unsigned char* lds, const bf16_t* Aptr, const bf16_t* Btptr, const int K, const Sched& S, const Epi& E, const int wv, const int LD = 0) {
    const int ld = LD ? LD : K;
    constexpr bool GATHER = Sched::GATHER;
    int tid_; asm volatile("v_mbcnt_lo_u32_b32 %0, -1, 0\n\tv_mbcnt_hi_u32_b32 %0, -1, %0" : "=v"(tid_)); tid_ += wv * 64;
    const int tid = tid_, wid = __builtin_amdgcn_readfirstlane(tid >> 6), lane = tid & 63, wr = wid >> 2, wc = wid & 3, fr = lane & 15, fq = lane >> 4;
    const int nt = K / BK;
    unsigned voffA[2], voffB[2];
#pragma unroll
    for (int i = 0; i < 2; ++i) { int R, C; stage_rc(tid * 16 + i * 8192, R, C); const int Rb = Epi::PERM ? ((R & ~31) + perm32(R & 31)) : R;
        voffA[i] = (unsigned)(R * ld + C) * 2u; voffB[i] = (unsigned)(Rb * ld + C) * 2u; }
    const size_t kstep = (size_t)(BK * 2);
    const size_t hstep = (size_t)HALF * ld * 2;
    const size_t tstep = 2 * hstep;
    const unsigned ldsw = (unsigned)wid * 1024u;
    const int aoff = lds_byte(wr * 64 + fr, fq * 8), boff = lds_byte(wc * 32 + fr, fq * 8);
#define PG8_SA(b, h) (((b) * 2 + (h)) * HTB)
#define PG8_SB(b, h) ((4 + (b) * 2 + (h)) * HTB)
#define PG8_STAGE(bufoff, gbase, voff) do { _Pragma("unroll") for (int _i = 0; _i < 2; ++_i) \
        __builtin_amdgcn_global_load_lds((const unsigned*)((const char*)(gbase) + (voff)[_i]), (PG8_LAS unsigned*)(lds + (bufoff) + ldsw + _i * 8192), 16, 0, 0); } while (0)
#define PG8_STAGE_A(bufoff, gbase, h) do { if constexpr (GATHER) { PG8_STAGE(bufoff, gbase, vg[h]); } else { PG8_STAGE(bufoff, (gbase) + (h) * hstep, voffA); } } while (0)
#define PG8_LDA(dst, b, h) do { _Pragma("unroll") for (int m = 0; m < 4; ++m) _Pragma("unroll") for (int k = 0; k < 2; ++k) dst[m][k] = *(const PG8_LAS bf16x8*)(lds + PG8_SA(b, h) + aoff + m * 2048 + k * 1024); } while (0)
#define PG8_LDB(dst, b, h) do { _Pragma("unroll") for (int n = 0; n < 2; ++n) _Pragma("unroll") for (int k = 0; k < 2; ++k) dst[n][k] = *(const PG8_LAS bf16x8*)(lds + PG8_SB(b, h) + boff + n * 2048 + k * 1024); } while (0)
#define PG8_CAT(x, y) __builtin_shufflevector((v4i)(x), (v4i)(y), 0, 1, 2, 3, 4, 5, 6, 7)
#define PG8_MMA(ai, bj, At, Bt) do { __builtin_amdgcn_s_setprio(1); if constexpr (Epi::F8) { _Pragma("unroll") for (int m = 0; m < 4; ++m) _Pragma("unroll") for (int n = 0; n < 2; ++n) \
        acc[ai][bj][m][n] = __builtin_amdgcn_mfma_scale_f32_16x16x128_f8f6f4(PG8_CAT(Bt[n][0], Bt[n][1]), PG8_CAT(At[m][0], At[m][1]), acc[ai][bj][m][n], 0, 0, 0, sc1, 0, sc1); } \
    else { _Pragma("unroll") for (int m = 0; m < 4; ++m) _Pragma("unroll") for (int n = 0; n < 2; ++n) _Pragma("unroll") for (int k = 0; k < 2; ++k) \
        acc[ai][bj][m][n] = __builtin_amdgcn_mfma_f32_16x16x32_bf16(Bt[n][k], At[m][k], acc[ai][bj][m][n], 0, 0, 0); } __builtin_amdgcn_s_setprio(0); } while (0)
#define PG8_WAIT_V(n) asm volatile("s_waitcnt vmcnt(" #n ")" ::: "memory")
#define PG8_WAIT_L(n) asm volatile("s_waitcnt lgkmcnt(" #n ")" ::: "memory")
#define PG8_BAR __builtin_amdgcn_s_barrier()
#define PG8_SCHED __builtin_amdgcn_sched_barrier(0)
#define PG8_GOFFS(u) do { _Pragma("unroll") for (int _h = 0; _h < 2; ++_h) _Pragma("unroll") for (int _i = 0; _i < 2; ++_i) { \
        int _R, _C; stage_rc(tid * 16 + _i * 8192, _R, _C); vg[_h][_i] = ((unsigned)S.a_row(u, _h * HALF + _R) * (unsigned)ld + (unsigned)_C) * 2u; } } while (0)
    Unit cur, nxt; int ui = 0;
    if (!S.next(0, cur)) return;
    int sc1 = 0x7f7f7f7f; asm volatile("" : "+v"(sc1));
    float zf = 0.f; asm volatile("" : "+v"(zf));
    f32x4 acc[2][2][4][2];
#pragma unroll
    for (int a = 0; a < 2; ++a)
#pragma unroll
        for (int b = 0; b < 2; ++b)
#pragma unroll
            for (int m = 0; m < 4; ++m)
#pragma unroll
                for (int n = 0; n < 2; ++n) acc[a][b][m][n] = (f32x4){zf, zf, zf, zf};
    bf16x8 At[4][2], B0[2][2], B1[2][2];
    unsigned vg[2][2] = {{0u, 0u}, {0u, 0u}};
    const char* cA = (const char*)Aptr + cur.kofs; const char* cB = (const char*)Btptr + (size_t)cur.bt * tstep + cur.kofs;
    if constexpr (GATHER) { PG8_GOFFS(cur); } else { cA += (size_t)cur.pm * tstep; }
    PG8_STAGE(PG8_SB(0, 0), cB, voffB); PG8_STAGE(PG8_SB(0, 1), cB + hstep, voffB); PG8_STAGE_A(PG8_SA(0, 0), cA, 0); PG8_STAGE_A(PG8_SA(0, 1), cA, 1);
    if (wr == 1) PG8_BAR;
    PG8_WAIT_V(2); PG8_BAR;
    PG8_STAGE(PG8_SB(1, 0), cB + kstep, voffB); PG8_STAGE_A(PG8_SA(1, 0), cA + kstep, 0); PG8_STAGE(PG8_SB(1, 1), cB + hstep + kstep, voffB);
    PG8_WAIT_V(6); PG8_BAR;
    for (;;) {
        const bool has_next = S.next(ui + 1, nxt);
        const char* nA = cA; if constexpr (!GATHER) { if (has_next) nA = (const char*)Aptr + (size_t)nxt.pm * tstep + nxt.kofs; }
        const char* nB = has_next ? (const char*)Btptr + (size_t)nxt.bt * tstep + nxt.kofs : cB;
        for (int t = 0; t < nt; t += 2) {
            const bool last = (t == nt - 2);
            const char* a1 = cA + (size_t)(t + 1) * kstep;
            const char* a2 = last ? nA : cA + (size_t)(t + 2) * kstep; const char* b2 = last ? nB : cB + (size_t)(t + 2) * kstep;
            const char* a3 = a2 + kstep; const char* b3 = b2 + kstep;
            PG8_LDB(B0, 0, 0); PG8_LDB(B1, 0, 1); PG8_SCHED; PG8_LDA(At, 0, 0); PG8_STAGE_A(PG8_SA(1, 1), a1, 1);
            if constexpr (GATHER) { if (last && has_next) { PG8_GOFFS(nxt); } }
            PG8_WAIT_V(8); PG8_WAIT_L(0); PG8_BAR; PG8_MMA(0, 0, At, B0); PG8_MMA(0, 1, At, B1); PG8_BAR; PG8_SCHED;
            PG8_LDA(At, 0, 1); PG8_STAGE(PG8_SB(0, 0), b2, voffB); PG8_STAGE(PG8_SB(0, 1), b2 + hstep, voffB); PG8_STAGE_A(PG8_SA(0, 0), a2, 0);
            PG8_WAIT_V(8); PG8_WAIT_L(0); PG8_BAR; PG8_MMA(1, 0, At, B0); PG8_MMA(1, 1, At, B1); PG8_BAR; PG8_SCHED;
            PG8_LDB(B0, 1, 0); PG8_LDB(B1, 1, 1); PG8_SCHED; PG8_LDA(At, 1, 0); PG8_STAGE_A(PG8_SA(0, 1), a2, 1);
            PG8_WAIT_V(8); PG8_WAIT_L(0); PG8_BAR; PG8_MMA(0, 0, At, B0); PG8_MMA(0, 1, At, B1); PG8_BAR; PG8_SCHED;
            PG8_LDA(At, 1, 1); PG8_STAGE(PG8_SB(1, 0), b3, voffB); PG8_STAGE(PG8_SB(1, 1), b3 + hstep, voffB); PG8_STAGE_A(PG8_SA(1, 0), a3, 0);
            PG8_WAIT_V(8); PG8_WAIT_L(0); PG8_BAR; PG8_MMA(1, 0, At, B0); PG8_MMA(1, 1, At, B1); PG8_BAR; PG8_SCHED;
        }
        if (wr == 0) PG8_BAR;
        bool keep = false;
        if constexpr (Epi::MIDWAY) keep = E.midway(acc, cur, wr, wc, fr, fq);
        if (!keep) E(acc, cur, wr, wc, fr, fq);
        if (!has_next) break;
        if (!keep) {
#pragma unroll
        for (int a = 0; a < 2; ++a)
#pragma unroll
            for (int b = 0; b < 2; ++b)
#pragma unroll
                for (int m = 0; m < 4; ++m)
#pragma unroll
                    for (int n = 0; n < 2; ++n) acc[a][b][m][n] = (f32x4){zf, zf, zf, zf};
        }
        cur = nxt; cA = nA; cB = nB; ++ui;
        if (wr == 1) PG8_BAR;
    }
    PG8_WAIT_V(0);
    PG8_BAR;
#undef PG8_SA
#undef PG8_SB
#undef PG8_STAGE
#undef PG8_STAGE_A
#undef PG8_LDA
#undef PG8_LDB
#undef PG8_MMA
#undef PG8_CAT
#undef PG8_WAIT_V
#undef PG8_WAIT_L
#undef PG8_BAR
#undef PG8_SCHED
#undef PG8_GOFFS
}
}

constexpr size_t MiB = 1u << 20;
constexpr size_t WS_CTL = 0, CTL_ZERO_BYTES = 1 * MiB;
constexpr size_t WS_MG = 1 * MiB, WS_AFF = 3 * MiB, WS_INV = 5 * MiB, WS_IDX = 7 * MiB, WS_GATEV = 7 * MiB + 256 * 1024, WS_RSTD1 = 7 * MiB + 512 * 1024;
constexpr size_t WS_WIN = 8 * MiB, WS_WA = 19 * MiB, WS_WB = 20 * MiB, WS_WO = 21 * MiB, WS_WGU = 24 * MiB, WS_WD = 152 * MiB;
constexpr size_t WS_WGU_L1 = 88 * MiB, WS_WD_L1 = 184 * MiB, WS_WA_L1 = 888 * MiB, WS_WO_L1 = 890 * MiB;
constexpr size_t WS_XB = 216 * MiB;
constexpr size_t WS_WIN8 = WS_WIN + (size_t)3584 * 2048;
constexpr size_t WS_ZQK = 280 * MiB, WS_ZMV = 344 * MiB, WS_ZMO = 376 * MiB, WS_ZDQ = 408 * MiB, WS_ZDK = 440 * MiB, WS_ZDV = 472 * MiB, WS_ZG = 504 * MiB;
constexpr size_t WS_HM = 632 * MiB, WS_HD = 664 * MiB, WS_MIX = 696 * MiB, WS_HF = 760 * MiB, WS_HB = 824 * MiB, WS_END = 888 * MiB;
constexpr size_t WS_XR = 892 * MiB, WS_END2 = 956 * MiB;
constexpr size_t WS_HID = 280 * MiB, WS_YE = 536 * MiB;
constexpr int CW_BAR = 4096;

constexpr int RING_BYTES = 131072;
constexpr int LDSCTL_OFF = RING_BYTES, MISC_OFF = LDSCTL_OFF + 320;
constexpr int LDS_BYTES = 147456;

#define XB_TMO      128
#define XB_XCNT(j)  (256  + 64 * (j))
#define XB_XSUB(j)  (1280 + 64 * (j))
#define XB_XGEN(j)  (2304 + 64 * (j))
#define XB_TOP      3328
#define XB_TOPGEN   3392
#define XCD_BAR_WORDS 3456
#define XB_SPIN_CAP (1u << 22)
__device__ __forceinline__ unsigned xb_ld(unsigned* p)              { return __hip_atomic_load(p, __ATOMIC_RELAXED, __HIP_MEMORY_SCOPE_AGENT); }
__device__ __forceinline__ unsigned xb_add(unsigned* p, unsigned v) { return __hip_atomic_fetch_add(p, v, __ATOMIC_RELAXED, __HIP_MEMORY_SCOPE_AGENT); }
__device__ __forceinline__ unsigned xb_xcc_id() { return (unsigned)__builtin_amdgcn_s_getreg((3 << 11) | 20) & 0xFu; }
#define XB_SPIN(cond, bar) do { unsigned _sp = 0; while (cond) { __builtin_amdgcn_s_sleep(1); \
    if ((++_sp & 255u) == 0u) { if (xb_ld(&(bar)[XB_TMO])) break; if (_sp > XB_SPIN_CAP) { atomicAdd(&(bar)[XB_TMO], 1u); break; } } } } while (0)
struct XcdBarrier { unsigned* bar; unsigned x; volatile LAS unsigned* st; };
__device__ __forceinline__ XcdBarrier xcd_barrier_post(unsigned* bar, volatile LAS unsigned* st) {
    XcdBarrier b; b.bar = bar; b.x = xb_xcc_id(); b.st = st;
    if (threadIdx.x == 0) (void)xb_add(&bar[XB_XCNT(b.x)], 1u);
    return b;
}
__device__ __forceinline__ void xcd_barrier_complete(unsigned* bar, unsigned x, unsigned& nloc, unsigned& nx) {
    const unsigned G = gridDim.x * gridDim.y * gridDim.z;
    unsigned sum, cnt, mine, sp = 0u;
    for (;;) {
        sum = 0u; cnt = 0u; mine = 0u;
#pragma unroll
        for (unsigned j = 0; j < 16; ++j) { const unsigned c = xb_ld(&bar[XB_XCNT(j)]); sum += c; cnt += (c > 0u) ? 1u : 0u; mine = (j == x) ? c : mine; }
        if (sum == G) break;
        __builtin_amdgcn_s_sleep(1);
        if ((++sp & 255u) == 0u) { if (xb_ld(&bar[XB_TMO])) break; if (sp > XB_SPIN_CAP) { atomicAdd(&bar[XB_TMO], 1u); break; } }
    }
    nloc = mine > 0u ? mine : 1u; nx = cnt > 0u ? cnt : 1u;
}
__device__ __forceinline__ void xcd_barrier(const XcdBarrier& b) {
    asm volatile("s_waitcnt vmcnt(0)" ::: "memory");
    __syncthreads();
    if (threadIdx.x == 0) {
        unsigned* bar = b.bar;
        __builtin_amdgcn_s_waitcnt(0);
        unsigned nloc = b.st[0], nx = b.st[1];
        if (nloc == 0u) { xcd_barrier_complete(bar, b.x, nloc, nx); b.st[0] = nloc; b.st[1] = nx; }
        const unsigned old = xb_add(&bar[XB_XSUB(b.x)], 1u);
        const unsigned gen = old / nloc;
        if (old + 1u == (gen + 1u) * nloc) {
            __builtin_amdgcn_fence(__ATOMIC_RELEASE, "agent");
            asm volatile("s_waitcnt vmcnt(0)" ::: "memory");
            const unsigned og = xb_add(&bar[XB_TOP], 1u);
            const unsigned tg = og / nx;
            if (og + 1u == (tg + 1u) * nx) xb_add(&bar[XB_TOPGEN], 1u);
            else XB_SPIN(xb_ld(&bar[XB_TOPGEN]) == tg, bar);
            __builtin_amdgcn_fence(__ATOMIC_ACQUIRE, "agent");
            xb_add(&bar[XB_XGEN(b.x)], 1u);
            asm volatile("s_waitcnt vmcnt(0)" ::: "memory");
        } else {
            XB_SPIN(xb_ld(&bar[XB_XGEN(b.x)]) == gen, bar);
            __builtin_amdgcn_fence(__ATOMIC_ACQUIRE, "agent");
            asm volatile("s_waitcnt vmcnt(0)" ::: "memory");
        }
    }
    __syncthreads();
}

struct Args { const float* in[18]; float* out; unsigned char* ws; int ph_lo, ph_hi; };
enum { I_X = 0, I_NMG, I_WIN, I_BMG, I_CW, I_CB, I_MNG, I_LAM, I_DNG, I_WUA, I_WUB, I_WOUT, I_NFG, I_WR, I_WGE, I_WUE, I_WDE, I_NF };

struct Frame {
    LAS unsigned char* lds;
    int G, bx, wv;
    const float* in[18];
    float* X;
    unsigned char* ws;
};
#define WSP(type, off) ((type*)(F.ws + (off)))
__device__ __forceinline__ int lane_id_volatile() { int l; asm volatile("v_mbcnt_lo_u32_b32 %0, -1, 0\n\tv_mbcnt_hi_u32_b32 %0, -1, %0" : "=v"(l)); return l; }
#define PH_IDS int tid = F.wv * 64 + lane_id_volatile(); const int lane = tid & 63; const int wave = __builtin_amdgcn_readfirstlane(tid >> 6); (void)lane; (void)wave

struct CvItem { const float* W; bf16* WT; int pitch, Kdst, k0, f8; const float* gk; };
__device__ __forceinline__ void cv_load(const CvItem& c, int lane, f32x4 (&v)[16]) {
    const int rsh = c.f8 ? 3 : 4, lr = lane >> rsh, lc = (lane & ((1 << rsh) - 1)) * 4, rpi = 64 >> rsh;
    const float* src = c.W + (size_t)(c.k0 + lr) * c.pitch + lc; const size_t step = (size_t)rpi * c.pitch;
#pragma unroll
    for (int i = 0; i < 16; ++i) v[i] = __builtin_nontemporal_load((const f32x4*)(src + i * step));
}
__device__ __forceinline__ void cv_store(const CvItem& c, int lane, const f32x4 (&v)[16], LAS float* scr) {
    if (c.f8) {
#pragma unroll
        for (int i = 0; i < 16; ++i) { const int k = 8 * i + (lane >> 3), n = (lane & 7) * 4; *(LAS f32x4*)(scr + k * 32 + (n ^ (((k >> 4) & 7) << 2))) = v[i]; }
        asm volatile("s_waitcnt lgkmcnt(0)" ::: "memory");
        float gs[16];
        if (c.gk) {
#pragma unroll
            for (int j4 = 0; j4 < 4; ++j4) { const f32x4 g4 = *(const f32x4*)(c.gk + c.k0 + 16 * (lane & 7) + 4 * j4); gs[4 * j4] = g4.x; gs[4 * j4 + 1] = g4.y; gs[4 * j4 + 2] = g4.z; gs[4 * j4 + 3] = g4.w; } }
        else {
#pragma unroll
            for (int j = 0; j < 16; ++j) gs[j] = 1.0f; }
#pragma unroll
        for (int it = 0; it < 4; ++it) { const int n = it * 8 + (lane >> 3), kc = lane & 7; const LAS float* sp = scr + (16 * kc) * 32 + (n ^ (kc << 2));
            float f[16];
#pragma unroll
            for (int j = 0; j < 16; ++j) f[j] = __builtin_amdgcn_ldexpf(sp[j * 32] * gs[j], pg8::W8_LOG2);
            v4u o; o.x = pg8::pk4_fp8(f[0], f[1], f[2], f[3]); o.y = pg8::pk4_fp8(f[4], f[5], f[6], f[7]); o.z = pg8::pk4_fp8(f[8], f[9], f[10], f[11]); o.w = pg8::pk4_fp8(f[12], f[13], f[14], f[15]);
            *(v4u*)((unsigned char*)c.WT + (size_t)n * c.Kdst + c.k0 + 16 * kc) = o; }
        asm volatile("s_waitcnt lgkmcnt(0)" ::: "memory");
        return;
    }
#pragma unroll
    for (int i = 0; i < 16; ++i) { const int k = 4 * i + (lane >> 4), n = (lane & 15) * 4; *(LAS f32x4*)(scr + k * 64 + (n ^ (((k >> 3) & 7) << 2))) = v[i]; }
    asm volatile("s_waitcnt lgkmcnt(0)" ::: "memory");
    float gb[8];
    if (c.gk) { const f32x4 g0 = *(const f32x4*)(c.gk + c.k0 + 8 * (lane & 7)), g1 = *(const f32x4*)(c.gk + c.k0 + 8 * (lane & 7) + 4); gb[0] = g0.x; gb[1] = g0.y; gb[2] = g0.z; gb[3] = g0.w; gb[4] = g1.x; gb[5] = g1.y; gb[6] = g1.z; gb[7] = g1.w; }
    else {
#pragma unroll
        for (int j = 0; j < 8; ++j) gb[j] = 1.0f; }
#pragma unroll
    for (int it = 0; it < 8; ++it) { const int n = it * 8 + (lane >> 3), kc = lane & 7; const LAS float* sp = scr + (8 * kc) * 64 + (n ^ (kc << 2));
        v4u o; o.x = pk2(sp[0 * 64] * gb[0], sp[1 * 64] * gb[1]); o.y = pk2(sp[2 * 64] * gb[2], sp[3 * 64] * gb[3]); o.z = pk2(sp[4 * 64] * gb[4], sp[5 * 64] * gb[5]); o.w = pk2(sp[6 * 64] * gb[6], sp[7 * 64] * gb[7]);
        *(v4u*)(c.WT + (size_t)n * c.Kdst + c.k0 + 8 * kc) = o; }
    asm volatile("s_waitcnt lgkmcnt(0)" ::: "memory");
}
__device__ __forceinline__ CvItem cv_decode(Frame& F, int l, int it) {
    constexpr int J0 = 16 * 32, J1 = 16 * 56, J2 = 8 * 16, J3 = 8 * 16, J4 = 16 * 16, J5 = 16 * 16 * 32, J6 = J5;
    const float* w_in = F.in[I_WIN] + (size_t)l * D * IN_COLS;
    int r = it; CvItem c; c.f8 = 0; c.gk = nullptr;
    if (r < J0 + J1) c.gk = F.in[I_NMG] + (size_t)l * D;
    if (r < J0) { if (r < 16 * 24) { const int kb = r / 24, nb = r % 24; c.W = w_in + nb * 64; c.pitch = IN_COLS; c.WT = WSP(bf16, WS_WIN) + (size_t)(nb * 64) * D; c.Kdst = D; c.k0 = kb * 64; return c; }
        r -= 16 * 24; const int kb = r / 16, nb = r % 16;
        c.W = w_in + 1536 + nb * 32; c.pitch = IN_COLS; c.f8 = 1; c.WT = (bf16*)(F.ws + WS_WIN8 + (size_t)(nb * 32) * D); c.Kdst = D; c.k0 = kb * 128; return c; } r -= J0;
    if (r < J1) { if (r < 16 * 24) { const int kb = r / 24, nb = r % 24; c.W = w_in + OFF_DQ + nb * 64; c.pitch = IN_COLS; c.WT = WSP(bf16, WS_WIN) + (size_t)(1536 + nb * 64) * D; c.Kdst = D; c.k0 = kb * 64; return c; }
        r -= 16 * 24; const int kb = r / 64, nb = r % 64;
        c.W = w_in + OFF_DQ + 1536 + nb * 32; c.pitch = IN_COLS; c.f8 = 1; c.WT = (bf16*)(F.ws + WS_WIN8 + (size_t)(512 + nb * 32) * D); c.Kdst = D; c.k0 = kb * 128; return c; } r -= J1;
    if (r < J2) { const int kb = r / 16, nb = r % 16; c.W = F.in[I_WUA] + (size_t)l * MW * D + nb * 64; c.pitch = D; c.WT = WSP(bf16, l == 0 ? WS_WA : WS_WA_L1) + (size_t)(nb * 64) * 1024; c.Kdst = 1024; c.k0 = kb * 64; return c; } r -= J2;
    if (r < J3) { const int kb = r / 16, nb = r % 16; c.W = F.in[I_WUB] + (size_t)l * MW * D + nb * 64; c.pitch = D; c.WT = WSP(bf16, l == 0 ? WS_WA : WS_WA_L1) + (size_t)(nb * 64) * 1024 + 512; c.Kdst = 1024; c.k0 = kb * 64; return c; } r -= J3;
    if (r < J4) { const int kb = r / 16, nb = r % 16; c.W = F.in[I_WOUT] + (size_t)l * D * D + nb * 64; c.pitch = D; c.WT = WSP(bf16, l == 0 ? WS_WO : WS_WO_L1) + (size_t)(nb * 64) * D; c.Kdst = D; c.k0 = kb * 64; return c; } r -= J4;
    if (r < J5 + J6) { const int up = r >= J5; if (up) r -= J5; const int e = r / 512, q = r % 512, kb = q / 64, nb = q % 64, col = nb * 32;
        c.W = (up ? F.in[I_WUE] : F.in[I_WGE]) + ((size_t)l * NE + e) * D * DFF + col; c.pitch = DFF; c.f8 = 1;
        c.WT = (bf16*)(F.ws + (l == 0 ? WS_WGU : WS_WGU_L1) + (size_t)((e * 16 + (col >> 7)) * 256 + up * 128 + (col & 127)) * D); c.Kdst = D; c.k0 = kb * 128; return c; } r -= J5 + J6;
    { const int e = r / 512, q = r % 512, kb = q / 32, nb = q % 32;
      c.W = F.in[I_WDE] + ((size_t)l * NE + e) * DFF * D + nb * 32; c.pitch = D; c.f8 = 1; c.WT = (bf16*)(F.ws + (l == 0 ? WS_WD : WS_WD_L1) + (size_t)(e * 1024 + nb * 32) * DFF); c.Kdst = DFF; c.k0 = kb * 128; return c; }
}
constexpr int CV_GU0 = 16 * 32 + 16 * 56 + 8 * 16 + 8 * 16 + 16 * 16, CV_GU1 = CV_GU0 + 2 * 16 * 16 * 32, CV_NITEMS = CV_GU1 + 16 * 32 * 16;
__device__ __forceinline__ void cv_run(Frame& F, int l, int lane, LAS float* scr, int first, int count, int wi, int nw) {
    f32x4 va[16], vb[16];
    int it = wi;
    if (it >= count) return;
    CvItem ca = cv_decode(F, l, first + it), cbn = ca;
    cv_load(ca, lane, va);
#pragma unroll 1
    for (;;) {
        const bool hb = (it + nw < count);
        if (hb) { cbn = cv_decode(F, l, first + it + nw); cv_load(cbn, lane, vb); }
        cv_store(ca, lane, va, scr);
        if (!hb) break;
        it += nw;
        const bool ha = (it + nw < count);
        if (ha) { ca = cv_decode(F, l, first + it + nw); cv_load(ca, lane, va); }
        cv_store(cbn, lane, vb, scr);
        if (!ha) break;
        it += nw;
    }
}
constexpr int CV_WIN = 16 * 32 + 16 * 56;
__device__ __forceinline__ void ph_convert(Frame& F, int l) {
    PH_IDS;
    LAS float* scr = (LAS float*)(F.lds + wave * 16384);
    const int gw = F.bx * NWAVES + wave, NGW = F.G * NWAVES;
    cv_run(F, l, lane, scr, 0, CV_WIN, gw, NGW);
}

__device__ __forceinline__ void stage_w16(int tid, LAS float* w16, const float* src, int pitch) {
    __syncthreads();
    f32x4 w[8];
#pragma unroll
    for (int n = 0; n < 8; ++n) { const int i = tid + NTHREADS * n, k = i >> 2, q = i & 3; w[n] = *(const f32x4*)(src + (size_t)k * pitch + q * 4); }
#pragma unroll
    for (int n = 0; n < 8; ++n) { const int i = tid + NTHREADS * n, k = i >> 2, q = i & 3; *(LAS f32x4*)(w16 + ((((k >> 8) * 4 + (k & 3)) * 4 + q) * 64 + ((k & 255) >> 2)) * 4) = w[n]; }
    __syncthreads();
}
template <int N> __device__ __forceinline__ float row_ror_add(float x) { return x + __int_as_float(__builtin_amdgcn_update_dpp(0, __float_as_int(x), 0x120 + N, 0xf, 0xf, false)); }
template <int N> __device__ __forceinline__ float row_ror_max(float x) { return fmaxf(x, __int_as_float(__builtin_amdgcn_update_dpp(0, __float_as_int(x), 0x120 + N, 0xf, 0xf, false))); }
__device__ __forceinline__ float xrow_sum(float v) {
    auto a = __builtin_amdgcn_permlane16_swap(__float_as_uint(v), __float_as_uint(v), false, false); v = __uint_as_float(a[0]) + __uint_as_float(a[1]);
    auto b = __builtin_amdgcn_permlane32_swap(__float_as_uint(v), __float_as_uint(v), false, false); return __uint_as_float(b[0]) + __uint_as_float(b[1]); }
__device__ __forceinline__ float xrow_max(float v) {
    auto a = __builtin_amdgcn_permlane16_swap(__float_as_uint(v), __float_as_uint(v), false, false); v = fmaxf(__uint_as_float(a[0]), __uint_as_float(a[1]));
    auto b = __builtin_amdgcn_permlane32_swap(__float_as_uint(v), __float_as_uint(v), false, false); return fmaxf(__uint_as_float(b[0]), __uint_as_float(b[1])); }
__device__ __forceinline__ float wave_sum_fast(float v) { v = row_ror_add<8>(v); v = row_ror_add<4>(v); v = row_ror_add<2>(v); v = row_ror_add<1>(v); return xrow_sum(v); }
template <int R> __device__ __forceinline__ void proj16(const f32x4 (&h)[R][4], const LAS float* w16, int lane, float (&t)[R][4]) {
    float p[R][16];
#pragma unroll
    for (int r = 0; r < R; ++r)
#pragma unroll
        for (int j = 0; j < 16; ++j) p[r][j] = 0.f;
    int lane4 = 4 * lane; asm volatile("" : "+v"(lane4) : "v"(h[0][0][0]), "v"(h[R - 1][0][0]));
#pragma unroll
    for (int jj = 0; jj < 4; ++jj)
#pragma unroll
        for (int c = 0; c < 4; ++c) {
#pragma unroll
            for (int q = 0; q < 4; ++q) { const f32x4 w = *(const LAS f32x4*)(w16 + ((jj * 4 + c) * 4 + q) * 256 + lane4);
#pragma unroll
                for (int r = 0; r < R; ++r) { const float hv = h[r][jj][c]; p[r][4 * q + 0] += hv * w.x; p[r][4 * q + 1] += hv * w.y; p[r][4 * q + 2] += hv * w.z; p[r][4 * q + 3] += hv * w.w; } }
            if (c & 1) {
#pragma unroll
                for (int r = 0; r < R; ++r) asm volatile("" : "+v"(p[r][0]), "+v"(p[r][1]), "+v"(p[r][2]), "+v"(p[r][3]), "+v"(p[r][4]), "+v"(p[r][5]), "+v"(p[r][6]), "+v"(p[r][7]), "+v"(p[r][8]), "+v"(p[r][9]), "+v"(p[r][10]), "+v"(p[r][11]), "+v"(p[r][12]), "+v"(p[r][13]), "+v"(p[r][14]), "+v"(p[r][15]) :: "memory"); } }
#pragma unroll
    for (int r = 0; r < R; ++r) {
        float q8[8];
#pragma unroll
        for (int j = 0; j < 8; ++j) { auto rr = __builtin_amdgcn_permlane32_swap(__float_as_uint(p[r][j]), __float_as_uint(p[r][j + 8]), false, false); q8[j] = __uint_as_float(rr[0]) + __uint_as_float(rr[1]); }
#pragma unroll
        for (int m = 0; m < 4; ++m) { auto rr = __builtin_amdgcn_permlane16_swap(__float_as_uint(q8[m]), __float_as_uint(q8[m + 4]), false, false); float v = __uint_as_float(rr[0]) + __uint_as_float(rr[1]);
            v = row_ror_add<8>(v); v = row_ror_add<4>(v); v = row_ror_add<2>(v); v = row_ror_add<1>(v); t[r][m] = v; } }
}
__device__ __forceinline__ f32x4 ldx4(const bf16* p) { const v2u w = *(const v2u*)p; return (f32x4){bflo(w.x), bfhi(w.x), bflo(w.y), bfhi(w.y)}; }
__device__ __forceinline__ void store_bf16_row(bf16* dst, const f32x4 (&h)[4], int lane) {
#pragma unroll
    for (int j = 0; j < 4; ++j) { v2u o; o.x = pk2(h[j].x, h[j].y); o.y = pk2(h[j].z, h[j].w); *(v2u*)(dst + 256 * j + 4 * lane) = o; }
}
__device__ __forceinline__ void rms_row(const f32x4 (&v)[4], const float* g, int lane, f32x4 (&h)[4]) {
    float s = 0.f;
#pragma unroll
    for (int j = 0; j < 4; ++j) s += (v[j].x * v[j].x + v[j].y * v[j].y) + (v[j].z * v[j].z + v[j].w * v[j].w);
    const float rstd = 1.0f / sqrtf(wave_sum_fast(s) * (1.0f / D) + EPS);
#pragma unroll
    for (int j = 0; j < 4; ++j) { const f32x4 gg = *(const f32x4*)(g + 256 * j + 4 * lane); h[j] = v[j] * rstd * gg; }
}
template <int R> __device__ __forceinline__ void prep1_rows(Frame& F, int lane, int l, int row0, int rstep, const f32x4 (&v)[R][4]) {
    (void)l;
#pragma unroll
    for (int r = 0; r < R; ++r) {
        float ss = 0.f;
#pragma unroll
        for (int j = 0; j < 4; ++j) ss += (v[r][j].x * v[r][j].x + v[r][j].y * v[r][j].y) + (v[r][j].z * v[r][j].z + v[r][j].w * v[r][j].w);
        const float rstd = 1.0f / sqrtf(wave_sum_fast(ss) * (1.0f / D) + EPS);
        if (lane == 0) WSP(float, WS_RSTD1)[row0 + r * rstep] = rstd;
#pragma unroll
        for (int j = 0; j < 4; ++j) *(unsigned*)(F.ws + WS_MIX + (size_t)(row0 + r * rstep) * D + 256 * j + 4 * lane) = pg8::pk4_fp8(v[r][j].x, v[r][j].y, v[r][j].z, v[r][j].w); }
}
__device__ __forceinline__ void ph_prep_first(Frame& F) {
    PH_IDS;
    const int gw = F.bx * NWAVES + wave, NGW = F.G * NWAVES;
    f32x4 v[2][4];
#pragma unroll
    for (int r = 0; r < 2; ++r)
#pragma unroll
        for (int j = 0; j < 4; ++j) v[r][j] = *(const f32x4*)(F.in[I_X] + (size_t)(gw + r * NGW) * D + 256 * j + 4 * lane);
#pragma unroll 1
    for (int row = gw; row < T; row += 2 * NGW) {
        f32x4 vn[2][4];
        const int nrow = (row + 2 * NGW < T) ? row + 2 * NGW : row;
#pragma unroll
        for (int r = 0; r < 2; ++r)
#pragma unroll
            for (int j = 0; j < 4; ++j) { vn[r][j] = *(const f32x4*)(F.in[I_X] + (size_t)(nrow + r * NGW) * D + 256 * j + 4 * lane); { v2u o; o.x = pk2(v[r][j].x, v[r][j].y); o.y = pk2(v[r][j].z, v[r][j].w); *(v2u*)(WSP(bf16, WS_XR) + (size_t)(row + r * NGW) * D + 256 * j + 4 * lane) = o; } }
        prep1_rows<2>(F, lane, 0, row, NGW, v);
#pragma unroll
        for (int r = 0; r < 2; ++r)
#pragma unroll
            for (int j = 0; j < 4; ++j) v[r][j] = vn[r][j];
    }
    __syncthreads();
}
__device__ __forceinline__ void stage_wmf(int tid, LAS unsigned char* img, const float* src, int pitch, const float* g) {
    __syncthreads();
    for (int idx = tid; idx < 32 * 64; idx += NTHREADS) { const int s = idx >> 6, ln = idx & 63, j = ln & 15, q = ln >> 4;
        unsigned hi[4], lo[4];
#pragma unroll
        for (int t2 = 0; t2 < 4; ++t2) { const int k = 32 * s + 8 * q + 2 * t2;
            const float w0 = src[(size_t)k * pitch + j] * g[k], w1 = src[(size_t)(k + 1) * pitch + j] * g[k + 1];
            const unsigned h0 = f2bf(w0), h1 = f2bf(w1); hi[t2] = h0 | (h1 << 16);
            lo[t2] = f2bf(w0 - bf2f((unsigned short)h0)) | (f2bf(w1 - bf2f((unsigned short)h1)) << 16); }
        *(LAS v4u*)(img + ((s * 2 + 0) * 64 + ln) * 16) = (v4u){hi[0], hi[1], hi[2], hi[3]};
        *(LAS v4u*)(img + ((s * 2 + 1) * 64 + ln) * 16) = (v4u){lo[0], lo[1], lo[2], lo[3]}; }
    __syncthreads();
}
__device__ __forceinline__ void ph_prep2(Frame& F, int l) {
    PH_IDS;
    LAS unsigned char* img = (LAS unsigned char*)(F.lds + 0);
    stage_wmf(tid, img, F.in[I_WR] + (size_t)l * D * NE, NE, F.in[I_NFG] + (size_t)l * D);
    const int gw = F.bx * NWAVES + wave, NGW = F.G * NWAVES;
#pragma unroll 1
    for (int grp = gw; grp < T / 16; grp += NGW) {
        const int i = lane & 15, q = lane >> 4;
        const bf16* xp = WSP(bf16, WS_XR) + (size_t)(grp * 16 + i) * D + 8 * q;
        float zf = 0.f; asm volatile("" : "+v"(zf));
        f32x4 acc = (f32x4){zf, zf, zf, zf}; float ssq = 0.f;
#pragma unroll 1
        for (int sb = 0; sb < 32; sb += 8) {
            v4u a[8];
#pragma unroll
            for (int u = 0; u < 8; ++u) a[u] = *(const v4u*)(xp + 32 * (sb + u));
#pragma unroll
            for (int u = 0; u < 8; ++u) { const bf16x8 bh = *(const LAS bf16x8*)(img + (((sb + u) * 2 + 0) * 64 + lane) * 16), bl = *(const LAS bf16x8*)(img + (((sb + u) * 2 + 1) * 64 + lane) * 16);
                const bf16x8 av = __builtin_bit_cast(bf16x8, a[u]);
                acc = __builtin_amdgcn_mfma_f32_16x16x32_bf16(av, bh, acc, 0, 0, 0); acc = __builtin_amdgcn_mfma_f32_16x16x32_bf16(av, bl, acc, 0, 0, 0);
                const float x0 = bflo(a[u].x), x1 = bfhi(a[u].x), x2 = bflo(a[u].y), x3 = bfhi(a[u].y), x4 = bflo(a[u].z), x5 = bfhi(a[u].z), x6 = bflo(a[u].w), x7 = bfhi(a[u].w);
                ssq += (x0 * x0 + x1 * x1) + (x2 * x2 + x3 * x3) + ((x4 * x4 + x5 * x5) + (x6 * x6 + x7 * x7)); }
        }
        ssq += __shfl_xor(ssq, 16); ssq += __shfl_xor(ssq, 32);
        const float rstd = 1.0f / sqrtf(ssq * (1.0f / D) + EPS);
#pragma unroll
        for (int r = 0; r < 4; ++r) { float t = acc[r] * __shfl(rstd, 4 * q + r);
            float mx = row_ror_max<8>(t); mx = row_ror_max<4>(mx); mx = row_ror_max<2>(mx); mx = row_ror_max<1>(mx);
            const float e = __expf(t - mx);
            float se = row_ror_add<8>(e); se = row_ror_add<4>(se); se = row_ror_add<2>(se); se = row_ror_add<1>(se);
            WSP(float, WS_AFF)[(size_t)(grp * 16 + 4 * q + r) * 16 + i] = e / se; }
    }
    f32x4 v[2][4];
#pragma unroll
    for (int r = 0; r < 2; ++r)
#pragma unroll
        for (int j = 0; j < 4; ++j) v[r][j] = ldx4(WSP(bf16, WS_XR) + (size_t)(gw + r * NGW) * D + 256 * j + 4 * lane);
#pragma unroll 1
    for (int row = gw; row < T; row += 2 * NGW) {
        f32x4 vn[2][4], h[2][4];
        const int nrow = (row + 2 * NGW < T) ? row + 2 * NGW : row;
#pragma unroll
        for (int r = 0; r < 2; ++r)
#pragma unroll
            for (int j = 0; j < 4; ++j) vn[r][j] = ldx4(WSP(bf16, WS_XR) + (size_t)(nrow + r * NGW) * D + 256 * j + 4 * lane);
#pragma unroll
        for (int r = 0; r < 2; ++r) { rms_row(v[r], F.in[I_NFG] + (size_t)l * D, lane, h[r]);
#pragma unroll
            for (int j = 0; j < 4; ++j) *(unsigned*)(F.ws + WS_XB + (size_t)(row + r * NGW) * D + 256 * j + 4 * lane) = pg8::pk4_fp8(h[r][j].x, h[r][j].y, h[r][j].z, h[r][j].w); }
#pragma unroll
        for (int r = 0; r < 2; ++r)
#pragma unroll
            for (int j = 0; j < 4; ++j) v[r][j] = vn[r][j];
    }
    __syncthreads();
}
__device__ __forceinline__ void ph_mgate(Frame& F, int l) {
    PH_IDS;
    LAS unsigned char* img = (LAS unsigned char*)(F.lds + 0);
    stage_wmf(tid, img, F.in[I_WIN] + (size_t)l * D * IN_COLS + OFF_MG, IN_COLS, F.in[I_NMG] + (size_t)l * D);
    const int gw = F.bx * NWAVES + wave, NGW = F.G * NWAVES;
#pragma unroll 1
    for (int grp = gw; grp < T / 16; grp += NGW) {
        const int i = lane & 15, q = lane >> 4;
        const bf16* xp = WSP(bf16, WS_XR) + (size_t)(grp * 16 + i) * D + 8 * q;
        float zf = 0.f; asm volatile("" : "+v"(zf));
        f32x4 acc = (f32x4){zf, zf, zf, zf}; float ssq = 0.f;
#pragma unroll 1
        for (int sb = 0; sb < 32; sb += 8) {
            v4u a[8];
#pragma unroll
            for (int u = 0; u < 8; ++u) a[u] = *(const v4u*)(xp + 32 * (sb + u));
#pragma unroll
            for (int u = 0; u < 8; ++u) { const bf16x8 bh = *(const LAS bf16x8*)(img + (((sb + u) * 2 + 0) * 64 + lane) * 16), bl = *(const LAS bf16x8*)(img + (((sb + u) * 2 + 1) * 64 + lane) * 16);
                const bf16x8 av = __builtin_bit_cast(bf16x8, a[u]);
                acc = __builtin_amdgcn_mfma_f32_16x16x32_bf16(av, bh, acc, 0, 0, 0); acc = __builtin_amdgcn_mfma_f32_16x16x32_bf16(av, bl, acc, 0, 0, 0);
                const float x0 = bflo(a[u].x), x1 = bfhi(a[u].x), x2 = bflo(a[u].y), x3 = bfhi(a[u].y), x4 = bflo(a[u].z), x5 = bfhi(a[u].z), x6 = bflo(a[u].w), x7 = bfhi(a[u].w);
                ssq += (x0 * x0 + x1 * x1) + (x2 * x2 + x3 * x3) + ((x4 * x4 + x5 * x5) + (x6 * x6 + x7 * x7)); }
        }
        ssq += __shfl_xor(ssq, 16); ssq += __shfl_xor(ssq, 32);
        const float rstd = 1.0f / sqrtf(ssq * (1.0f / D) + EPS);
        const float bm = F.in[I_BMG][l * 16 + i];
#pragma unroll
        for (int r = 0; r < 4; ++r) WSP(float, WS_MG)[(size_t)(grp * 16 + 4 * q + r) * 16 + i] = acc[r] * __shfl(rstd, 4 * q + r) + bm;
    }
    __syncthreads();
}
__device__ __forceinline__ void ph_topk(Frame& F) {
    PH_IDS;
    LAS unsigned long long* keys = (LAS unsigned long long*)(F.lds + 0);
    for (int item = F.bx; item < BATCH * NE; item += F.G) {
        const int b = item >> 4, e = item & 15;
        __syncthreads();
        for (int s = tid; s < SEQ; s += NTHREADS) { const float v = WSP(float, WS_AFF)[((size_t)b * SEQ + s) * 16 + e];
            keys[s] = ((unsigned long long)__float_as_uint(v) << 32) | (unsigned long long)(0xFFFFFFFFu - (unsigned)s);
            WSP(int, WS_INV)[((size_t)b * SEQ + s) * 16 + e] = -1; }
        __syncthreads();
        for (int k = 2; k <= SEQ; k <<= 1)
            for (int j = k >> 1; j > 0; j >>= 1) {
#pragma unroll
                for (int pp = 0; pp < 2; ++pp) { const int p = tid + NTHREADS * pp; const int i = ((p & ~(j - 1)) << 1) | (p & (j - 1)), ix = i | j;
                    const unsigned long long x = keys[i], y = keys[ix]; const bool up = ((i & k) == 0);
                    if ((x < y) == up) { keys[i] = y; keys[ix] = x; } }
                __syncthreads();
            }
        if (tid < CAP) { const unsigned long long kk = keys[tid]; const int s = (int)(0xFFFFFFFFu - (unsigned)(kk & 0xFFFFFFFFull));
            WSP(int, WS_IDX)[item * CAP + tid] = b * SEQ + s; WSP(float, WS_GATEV)[item * CAP + tid] = __uint_as_float((unsigned)(kk >> 32)); }
        asm volatile("s_waitcnt vmcnt(0)" ::: "memory");
        __syncthreads();
        if (tid < CAP) { const unsigned long long kk = keys[tid]; const int s = (int)(0xFFFFFFFFu - (unsigned)(kk & 0xFFFFFFFFull)); WSP(int, WS_INV)[((size_t)b * SEQ + s) * 16 + e] = tid; }
    }
    __syncthreads();
}
__device__ __forceinline__ void ph_combine(Frame& F, int l) {
    PH_IDS;
    const bool lastl = (l + 1 == DEPTH);
    const int gw = F.bx * NWAVES + wave, NGW = F.G * NWAVES;
    f32x4 v[2][4]; int myinv[2];
#pragma unroll
    for (int r = 0; r < 2; ++r) { myinv[r] = WSP(int, WS_INV)[(size_t)(gw + r * NGW) * 16 + (lane & 15)];
#pragma unroll
        for (int j = 0; j < 4; ++j) v[r][j] = ldx4(WSP(bf16, WS_XR) + (size_t)(gw + r * NGW) * D + 256 * j + 4 * lane); }
#pragma unroll 1
    for (int row = gw; row < T; row += 2 * NGW) {
        f32x4 vn[2][4]; int ninv[2];
        const int nrow = (row + 2 * NGW < T) ? row + 2 * NGW : row;
#pragma unroll
        for (int r = 0; r < 2; ++r) { ninv[r] = WSP(int, WS_INV)[(size_t)(nrow + r * NGW) * 16 + (lane & 15)];
#pragma unroll
            for (int j = 0; j < 4; ++j) vn[r][j] = ldx4(WSP(bf16, WS_XR) + (size_t)(nrow + r * NGW) * D + 256 * j + 4 * lane); }
        unsigned y[2][4][4]; float fl[2][4]; unsigned rest[2];
#pragma unroll
        for (int r = 0; r < 2; ++r) { const int b = (row + r * NGW) / SEQ;
            unsigned mask = (unsigned)__builtin_amdgcn_ballot_w64(myinv[r] >= 0) & 0xffffu;
#pragma unroll
            for (int k = 0; k < 4; ++k) { const bool hit = mask != 0u; const int e = hit ? __builtin_ctz(mask) : 0; const int sl = __builtin_amdgcn_readlane(myinv[r], e);
                const unsigned char* yr = F.ws + WS_YE + ((size_t)(b * 16 + e) * CAP + (hit ? sl : 0)) * D; fl[r][k] = hit ? (1.0f / pg8::Y8_SCALE) : 0.0f; mask &= mask - 1u;
#pragma unroll
                for (int j = 0; j < 4; ++j) y[r][k][j] = *(const unsigned*)(yr + 256 * j + 4 * lane); }
            rest[r] = mask; }
#pragma unroll
        for (int r = 0; r < 2; ++r) {
#pragma unroll
            for (int k = 0; k < 4; ++k)
#pragma unroll
                for (int j = 0; j < 4; ++j) { const unsigned yy = y[r][k][j]; const float f = fl[r][k]; const f32x2 lo = __builtin_amdgcn_cvt_pk_f32_fp8((int)yy, false), hi = __builtin_amdgcn_cvt_pk_f32_fp8((int)yy, true);
                    v[r][j].x += f * lo.x; v[r][j].y += f * lo.y; v[r][j].z += f * hi.x; v[r][j].w += f * hi.y; }
            unsigned mask = rest[r]; const int b = (row + r * NGW) / SEQ;
            while (mask) { const int e = __builtin_ctz(mask); mask &= mask - 1u; const int sl = __builtin_amdgcn_readlane(myinv[r], e);
                const unsigned char* yr = F.ws + WS_YE + ((size_t)(b * 16 + e) * CAP + sl) * D;
#pragma unroll
                for (int j = 0; j < 4; ++j) { const unsigned yy = *(const unsigned*)(yr + 256 * j + 4 * lane); const f32x2 lo = __builtin_amdgcn_cvt_pk_f32_fp8((int)yy, false), hi = __builtin_amdgcn_cvt_pk_f32_fp8((int)yy, true);
                    const float f = 1.0f / pg8::Y8_SCALE; v[r][j].x += f * lo.x; v[r][j].y += f * lo.y; v[r][j].z += f * hi.x; v[r][j].w += f * hi.y; } } }
        if (!lastl) {
#pragma unroll
            for (int r = 0; r < 2; ++r)
#pragma unroll
                for (int j = 0; j < 4; ++j) { v2u o; o.x = pk2(v[r][j].x, v[r][j].y); o.y = pk2(v[r][j].z, v[r][j].w); *(v2u*)(WSP(bf16, WS_XR) + (size_t)(row + r * NGW) * D + 256 * j + 4 * lane) = o; }
            prep1_rows<2>(F, lane, l + 1, row, NGW, v);
        } else {
#pragma unroll
            for (int r = 0; r < 2; ++r) { f32x4 h[4]; rms_row(v[r], F.in[I_NF], lane, h);
#pragma unroll
                for (int j = 0; j < 4; ++j) *(f32x4*)(F.X + (size_t)(row + r * NGW) * D + 256 * j + 4 * lane) = h[j]; } }
#pragma unroll
        for (int r = 0; r < 2; ++r) { myinv[r] = ninv[r];
#pragma unroll
            for (int j = 0; j < 4; ++j) v[r][j] = vn[r][j]; }
    }
    __syncthreads();
}

__device__ __forceinline__ void ph_mlstm_naive(Frame& F, int l) {
    PH_IDS;
    constexpr int TB = 64;
    LAS float* qs = (LAS float*)(F.lds + 0);
    LAS float* ks = (LAS float*)(F.lds + 32768);
    LAS float* vs = (LAS float*)(F.lds + 65536);
    LAS float* gl = (LAS float*)(F.lds + 98304);
    const float* cw = F.in[I_CW] + (size_t)l * CONVW * 2 * MW; const float* cb = F.in[I_CB] + (size_t)l * 2 * MW;
    const bf16* zqk = WSP(bf16, WS_ZQK); const bf16* zmv = WSP(bf16, WS_ZMV); const float* mg = WSP(float, WS_MG);
    for (int item = F.bx; item < BATCH * MH * 2; item += F.G) {
        const int dir = item & 1, h = (item >> 1) & 3, b = item >> 3;
        float* outp = WSP(float, dir ? WS_HB : WS_HF);
        const int v = tid >> 2, kq = tid & 3;
        float C[32], n[32];
#pragma unroll
        for (int i = 0; i < 32; ++i) { C[i] = 0.f; n[i] = 0.f; }
        float m = 0.f;
        for (int blk = 0; blk < SEQ / TB; ++blk) {
            const int ta = dir ? (SEQ - TB - blk * TB) : blk * TB;
            __syncthreads();
            for (int i = tid; i < TB * 256; i += NTHREADS) { const int tt = i >> 8, c = i & 255; const int col = (c < 128) ? (h * 128 + c) : (512 + h * 128 + (c - 128));
                float a = cb[col];
#pragma unroll
                for (int j = 0; j < CONVW; ++j) { const int ts = ta + tt + j - 2; if (ts >= 0 && ts < SEQ) a += cw[j * 2 * MW + col] * bf2f(zqk[((size_t)b * SEQ + ts) * 1024 + col]); }
                a = a * sigmoidf_(a);
                if (c < 128) qs[tt * 128 + c] = a; else ks[tt * 128 + (c - 128)] = a * 0.08838834764831845f; }
            for (int i = tid; i < TB * 128; i += NTHREADS) { const int tt = i >> 7, c = i & 127; vs[i] = bf2f(zmv[((size_t)b * SEQ + ta + tt) * 512 + h * 128 + c]); }
            if (tid < TB) { const float ip = mg[((size_t)b * SEQ + ta + tid) * 16 + dir * 8 + h], fp = mg[((size_t)b * SEQ + ta + tid) * 16 + dir * 8 + 4 + h];
                gl[tid * 2 + 0] = fminf(fp, 0.f) - log1pf(__expf(-fabsf(fp))); gl[tid * 2 + 1] = ip; }
            __syncthreads();
            for (int u = 0; u < TB; ++u) {
                const int tt = dir ? (TB - 1 - u) : u;
                const float lf = gl[tt * 2], li = gl[tt * 2 + 1];
                const float mn = fmaxf(lf + m, li), fs = __expf(lf + m - mn), is = __expf(li - mn); m = mn;
                const float iv = is * vs[tt * 128 + v];
                float hp = 0.f, dp = 0.f;
#pragma unroll
                for (int q4 = 0; q4 < 8; ++q4) { const f32x4 kx = *(const LAS f32x4*)(ks + tt * 128 + kq * 32 + q4 * 4), qx = *(const LAS f32x4*)(qs + tt * 128 + kq * 32 + q4 * 4);
#pragma unroll
                    for (int c = 0; c < 4; ++c) { const int i = q4 * 4 + c; C[i] = fs * C[i] + iv * kx[c]; n[i] = fs * n[i] + is * kx[c]; hp += C[i] * qx[c]; dp += n[i] * qx[c]; } }
                hp += __shfl_xor(hp, 1); hp += __shfl_xor(hp, 2); dp += __shfl_xor(dp, 1); dp += __shfl_xor(dp, 2);
                if (kq == 0) outp[((size_t)b * SEQ + ta + tt) * 512 + h * 128 + v] = hp / fmaxf(fabsf(dp), __expf(-m));
            }
        }
    }
    __syncthreads();
}
__device__ __forceinline__ void ph_mnorm(Frame& F, int l) {
    PH_IDS;
    const int gw = F.bx * NWAVES + wave, NGW = F.G * NWAVES;
    const float* ng = F.in[I_MNG] + (size_t)l * MW + 8 * lane;
    const f32x4 g0 = *(const f32x4*)ng, g1 = *(const f32x4*)(ng + 4);
    for (int tk = gw; tk < T; tk += NGW) {
        const size_t off = (size_t)tk * 512 + 8 * lane;
        const v4u af = *(const v4u*)(WSP(bf16, WS_HF) + off), ab = *(const v4u*)(WSP(bf16, WS_HB) + off);
        const f32x4 a0 = (f32x4){bflo(af.x), bfhi(af.x), bflo(af.y), bfhi(af.y)}, a1 = (f32x4){bflo(af.z), bfhi(af.z), bflo(af.w), bfhi(af.w)}, b0 = (f32x4){bflo(ab.x), bfhi(ab.x), bflo(ab.y), bfhi(ab.y)}, b1 = (f32x4){bflo(ab.z), bfhi(ab.z), bflo(ab.w), bfhi(ab.w)};
        const v4u o = *(const v4u*)(WSP(bf16, WS_ZMO) + off);
        f32x4 x0 = a0 + b0, x1 = a1 + b1;
        float sm = (x0.x + x0.y) + (x0.z + x0.w) + (x1.x + x1.y) + (x1.z + x1.w);
        sm = row_ror_add<8>(sm); sm = row_ror_add<4>(sm); sm = row_ror_add<2>(sm); sm = row_ror_add<1>(sm);
        const float mu = sm * (1.0f / 128.0f);
        x0 = x0 - mu; x1 = x1 - mu;
        float vs = (x0.x * x0.x + x0.y * x0.y) + (x0.z * x0.z + x0.w * x0.w) + (x1.x * x1.x + x1.y * x1.y) + (x1.z * x1.z + x1.w * x1.w);
        vs = row_ror_add<8>(vs); vs = row_ror_add<4>(vs); vs = row_ror_add<2>(vs); vs = row_ror_add<1>(vs);
        const float rs = 1.0f / sqrtf(vs * (1.0f / 128.0f) + EPS);
        v4u w; w.x = pk2(x0.x * rs * g0.x * bflo(o.x), x0.y * rs * g0.y * bfhi(o.x)); w.y = pk2(x0.z * rs * g0.z * bflo(o.y), x0.w * rs * g0.w * bfhi(o.y));
        w.z = pk2(x1.x * rs * g1.x * bflo(o.z), x1.y * rs * g1.y * bfhi(o.z)); w.w = pk2(x1.z * rs * g1.z * bflo(o.w), x1.w * rs * g1.w * bfhi(o.w));
        *(v4u*)(WSP(bf16, WS_HM) + (size_t)tk * 1024 + 8 * lane) = w;
    }
}
__device__ __forceinline__ void ph_attn_naive(Frame& F, int l) {
    PH_IDS;
    LAS float* Ks = (LAS float*)(F.lds + 0);
    LAS float* Vs = (LAS float*)(F.lds + 32768);
    LAS float* Os = (LAS float*)(F.lds + 65536);
    const float lam_init = __uint_as_float(__builtin_amdgcn_readfirstlane(__float_as_uint(0.8f - 0.6f * __expf(-0.3f * (float)l))));
    const float* lam = F.in[I_LAM] + (size_t)l * 4 * ADH;
    const float s01 = wave_sum(lam[lane] * lam[64 + lane]), s23 = wave_sum(lam[128 + lane] * lam[192 + lane]);
    const float lam_full = __expf(s01) - __expf(s23) + lam_init;
    const float* ng = F.in[I_DNG] + (size_t)l * ADV;
    const bf16* zdq = WSP(bf16, WS_ZDQ); const bf16* zdk = WSP(bf16, WS_ZDK); const bf16* zdv = WSP(bf16, WS_ZDV);
    const int r = tid & 63, part = tid >> 6, hi = part >> 2, dq = part & 3;
    for (int unit = F.bx; unit < BATCH * AH * (SEQ / 64); unit += F.G) {
        const int qb = unit & 31, h = (unit >> 5) & 3, b = unit >> 7;
        const int tq = qb * 64 + r;
        const float slope2 = __builtin_amdgcn_exp2f(-2.0f * (float)(h + 1)) * LOG2E;
        float q[64];
        { const bf16* qp = zdq + ((size_t)b * SEQ + tq) * 512 + h * 128 + hi * 64;
#pragma unroll
          for (int d8 = 0; d8 < 8; ++d8) { const v4u w = *(const v4u*)(qp + d8 * 8); q[d8 * 8 + 0] = bflo(w.x); q[d8 * 8 + 1] = bfhi(w.x); q[d8 * 8 + 2] = bflo(w.y); q[d8 * 8 + 3] = bfhi(w.y);
              q[d8 * 8 + 4] = bflo(w.z); q[d8 * 8 + 5] = bfhi(w.z); q[d8 * 8 + 6] = bflo(w.w); q[d8 * 8 + 7] = bfhi(w.w); } }
        float o[32];
#pragma unroll
        for (int c = 0; c < 32; ++c) o[c] = 0.f;
        float m = -1e30f, lsum = 0.f;
        for (int kt = 0; kt < SEQ / 64; ++kt) {
            __syncthreads();
            for (int i = tid; i < 64 * 16; i += NTHREADS) { const int kr = i >> 4, c8 = i & 15; const size_t g = ((size_t)b * SEQ + kt * 64 + kr) * 512 + h * 128 + c8 * 8;
                const v4u kw = *(const v4u*)(zdk + g), vw = *(const v4u*)(zdv + g);
                LAS float* kd = Ks + kr * 128 + c8 * 8; LAS float* vd = Vs + kr * 128 + c8 * 8;
                kd[0] = bflo(kw.x); kd[1] = bfhi(kw.x); kd[2] = bflo(kw.y); kd[3] = bfhi(kw.y); kd[4] = bflo(kw.z); kd[5] = bfhi(kw.z); kd[6] = bflo(kw.w); kd[7] = bfhi(kw.w);
                vd[0] = bflo(vw.x); vd[1] = bfhi(vw.x); vd[2] = bflo(vw.y); vd[3] = bfhi(vw.y); vd[4] = bflo(vw.z); vd[5] = bfhi(vw.z); vd[6] = bflo(vw.w); vd[7] = bfhi(vw.w); }
            __syncthreads();
            for (int j = 0; j < 64; ++j) {
                float s = 0.f;
#pragma unroll
                for (int d4 = 0; d4 < 16; ++d4) { const f32x4 kx = *(const LAS f32x4*)(Ks + j * 128 + hi * 64 + d4 * 4); s += q[d4 * 4] * kx.x + q[d4 * 4 + 1] * kx.y + q[d4 * 4 + 2] * kx.z + q[d4 * 4 + 3] * kx.w; }
                s -= slope2 * fabsf((float)(tq - (kt * 64 + j)));
                if (s > m) { const float corr = __builtin_amdgcn_exp2f(m - s); lsum *= corr;
#pragma unroll
                    for (int c = 0; c < 32; ++c) o[c] *= corr;
                    m = s; }
                const float p = __builtin_amdgcn_exp2f(s - m); lsum += p;
#pragma unroll
                for (int c4 = 0; c4 < 8; ++c4) { const f32x4 vx = *(const LAS f32x4*)(Vs + j * 128 + dq * 32 + c4 * 4); o[c4 * 4] += p * vx.x; o[c4 * 4 + 1] += p * vx.y; o[c4 * 4 + 2] += p * vx.z; o[c4 * 4 + 3] += p * vx.w; }
            }
        }
        __syncthreads();
        { const float il = 1.0f / lsum;
#pragma unroll
          for (int c = 0; c < 32; ++c) Os[(r * 2 + hi) * 128 + dq * 32 + c] = o[c] * il; }
        __syncthreads();
        float dv[16]; float ss = 0.f;
#pragma unroll
        for (int c = 0; c < 16; ++c) { dv[c] = Os[(r * 2 + 0) * 128 + part * 16 + c] - lam_full * Os[(r * 2 + 1) * 128 + part * 16 + c]; ss += dv[c] * dv[c]; }
        __syncthreads();
        Ks[r * 8 + part] = ss;
        __syncthreads();
        float tot = 0.f;
#pragma unroll
        for (int p8 = 0; p8 < 8; ++p8) tot += Ks[r * 8 + p8];
        const float rs = 1.0f / sqrtf(tot * (1.0f / 128.0f) + EPS) * (1.0f - lam_init);
        bf16* op = WSP(bf16, WS_HD) + ((size_t)b * SEQ + tq) * 512 + h * 128 + part * 16;
        v4u w0, w1;
        w0.x = pk2(dv[0] * rs * ng[part * 16 + 0], dv[1] * rs * ng[part * 16 + 1]); w0.y = pk2(dv[2] * rs * ng[part * 16 + 2], dv[3] * rs * ng[part * 16 + 3]);
        w0.z = pk2(dv[4] * rs * ng[part * 16 + 4], dv[5] * rs * ng[part * 16 + 5]); w0.w = pk2(dv[6] * rs * ng[part * 16 + 6], dv[7] * rs * ng[part * 16 + 7]);
        w1.x = pk2(dv[8] * rs * ng[part * 16 + 8], dv[9] * rs * ng[part * 16 + 9]); w1.y = pk2(dv[10] * rs * ng[part * 16 + 10], dv[11] * rs * ng[part * 16 + 11]);
        w1.z = pk2(dv[12] * rs * ng[part * 16 + 12], dv[13] * rs * ng[part * 16 + 13]); w1.w = pk2(dv[14] * rs * ng[part * 16 + 14], dv[15] * rs * ng[part * 16 + 15]);
        *(v4u*)op = w0; *(v4u*)(op + 8) = w1;
    }
    __syncthreads();
}

namespace attn {
typedef float f32x16 __attribute__((ext_vector_type(16)));
typedef short s16x4 __attribute__((ext_vector_type(4)));
typedef short v4i16_t __attribute__((ext_vector_type(4)));
constexpr int KVT = 64, NT = SEQ / KVT, SLOT = 32768;
__device__ __forceinline__ int crow(int r, int h) { return (r & 3) + 8 * (r >> 2) + 4 * h; }
__device__ __forceinline__ s16x4 vtr(const LAS unsigned char* p) { return __builtin_bit_cast(s16x4, __builtin_amdgcn_ds_read_tr16_b64_v4i16((LAS v4i16_t*)p)); }
__device__ __forceinline__ float max3f(float a, float b, float c) { float r; asm("v_max3_f32 %0, %1, %2, %3" : "=v"(r) : "v"(a), "v"(b), "v"(c)); return r; }
__device__ __forceinline__ float swapmax(float v) { auto rr = __builtin_amdgcn_permlane32_swap(__float_as_uint(v), __float_as_uint(v), false, false); return fmaxf(__uint_as_float(rr[0]), __uint_as_float(rr[1])); }
__device__ __forceinline__ float swapsum(float v) { auto rr = __builtin_amdgcn_permlane32_swap(__float_as_uint(v), __float_as_uint(v), false, false); return __uint_as_float(rr[0]) + __uint_as_float(rr[1]); }
__device__ __forceinline__ unsigned cvtpk(float lo, float hi) { typedef float f2 __attribute__((ext_vector_type(2))); typedef __bf16 b2 __attribute__((ext_vector_type(2))); f2 v = {lo, hi}; b2 b = __builtin_convertvector(v, b2); return __builtin_bit_cast(unsigned, b); }

__device__ __forceinline__ void unit(LAS unsigned char* lds, int tid, int b, int h, int qb, const bf16* zdq, const bf16* zdk, const bf16* zdv, bf16* hd,
                                     const float* ng, float lam_full, unsigned oml) {
    const int lane = tid & 63, wave = __builtin_amdgcn_readfirstlane(tid >> 6), hf = wave >> 2, w4 = wave & 3, r32 = lane & 31, hh = lane >> 5;
    const int tq = qb * 128 + w4 * 32 + r32;
    const float slope2 = __builtin_amdgcn_exp2f(-2.0f * (float)(h + 1)) * LOG2E;
    bf16x8 qf[4];
    { const bf16* qp = zdq + ((size_t)b * SEQ + tq) * 512 + h * 128 + hf * 64 + hh * 8;
#pragma unroll
      for (int ks = 0; ks < 4; ++ks) qf[ks] = *(const bf16x8*)(qp + ks * 16); }
    const char* kg = (const char*)(zdk + (size_t)b * SEQ * 512 + h * 128); const char* vg = (const char*)(zdv + (size_t)b * SEQ * 512 + h * 128);
    unsigned koff[2], voff[2];
#pragma unroll
    for (int e = 0; e < 2; ++e) { const int kv = 8 * wave + 4 * e + (lane >> 4), cc = lane & 15;
        koff[e] = (unsigned)(kv * 1024 + ((cc ^ (kv & 15)) * 16)); voff[e] = (unsigned)(kv * 1024 + ((cc ^ ((kv & 3) << 2)) * 16)); }
    const unsigned ldsa = (unsigned)(uintptr_t)lds;
#define AT_GLDS(gsrc, ldst) do { unsigned _keep; asm volatile("s_mov_b32 %0, m0\n\ts_mov_b32 m0, %2\n\ts_nop 0\n\tglobal_load_lds_dwordx4 %1, off\n\ts_mov_b32 m0, %0" : "=&s"(_keep) : "v"(gsrc), "s"(ldst) : "memory"); } while (0)
#define AT_STAGE(t, slot) do { _Pragma("unroll") for (int _e = 0; _e < 2; ++_e) { \
        const unsigned _kd = (unsigned)__builtin_amdgcn_readfirstlane((int)(ldsa + (slot) * SLOT + (2 * wave + _e) * 1024)); \
        AT_GLDS(kg + (size_t)(t) * (KVT * 1024) + koff[_e], _kd); AT_GLDS(vg + (size_t)(t) * (KVT * 1024) + voff[_e], _kd + 16384u); } } while (0)
    int kx[4], vb[4];
#pragma unroll
    for (int ks = 0; ks < 4; ++ks) kx[ks] = r32 * 256 + (((hf * 8 + 2 * ks + hh) ^ (r32 & 15)) * 16);
    { const int li = lane & 15, q_ = li >> 2, p_ = li & 3, g1 = (lane >> 4) & 1;
#pragma unroll
      for (int db = 0; db < 4; ++db) vb[db] = 16384 + (4 * hh + q_) * 256 + ((((db ^ q_) << 2) + 2 * g1 + (p_ >> 1)) * 16) + (p_ & 1) * 8; }
    f32x16 cc;
#pragma unroll
    for (int r = 0; r < 16; ++r) cc[r] = slope2 * (float)crow(r, hh);
    f32x16 o[4];
#pragma unroll
    for (int db = 0; db < 4; ++db)
#pragma unroll
        for (int r = 0; r < 16; ++r) o[db][r] = 0.f;
    float m = 0.f, l = 0.f;
    int ktd = (qb * 128 + w4 * 32) >> 6;
    const int t0 = 2 * qb;
#define AT_SEQ(i) (((i) < NT - t0) ? t0 + (i) : NT - 1 - (i))
    AT_STAGE(AT_SEQ(0), 0); AT_STAGE(AT_SEQ(1), 1); AT_STAGE(AT_SEQ(2), 2);
    asm volatile("" : "+v"(qf[0]), "+v"(qf[1]), "+v"(qf[2]), "+v"(qf[3]));
    asm volatile("s_waitcnt vmcnt(4)" ::: "memory");
    __builtin_amdgcn_s_barrier();
    if (hf == 1) __builtin_amdgcn_s_barrier();
    asm volatile("" ::: "memory");
    f32x16 s0, s1;
    bf16x8 k0[4], k1[4];
#define AT_KLOAD(slq) do { _Pragma("unroll") for (int ks = 0; ks < 4; ++ks) { k0[ks] = *(const LAS bf16x8*)((slq) + kx[ks]); k1[ks] = *(const LAS bf16x8*)((slq) + kx[ks] + 8192); } } while (0)
#define AT_QK(ktq) do { asm volatile("" : "+s"(ktd)); const bool dg_ = ((ktq) == ktd), lf_ = ((ktq) < ktd); const float sg_ = lf_ ? slope2 : -slope2; \
        { const float z = dg_ ? 0.f : (lf_ ? 1.f : -1.f), cm0 = (dg_ ? 0.f : sg_ * (float)((ktq) * 64 - tq)) - m, cm1 = cm0 + (dg_ ? 0.f : 32.0f * sg_); \
          _Pragma("unroll") for (int r = 0; r < 16; ++r) { s0[r] = cc[r] * z + cm0; s1[r] = cc[r] * z + cm1; } }        \
        __builtin_amdgcn_sched_barrier(0); \
        _Pragma("unroll") for (int ks = 0; ks < 4; ++ks) { s0 = __builtin_amdgcn_mfma_f32_32x32x16_bf16(k0[ks], qf[ks], s0, 0, 0, 0); s1 = __builtin_amdgcn_mfma_f32_32x32x16_bf16(k1[ks], qf[ks], s1, 0, 0, 0); } } while (0)
    AT_KLOAD(lds);
    AT_QK(AT_SEQ(0));
    int slot = 0;
    for (int ti = 0; ti < NT; ++ti) {
        const int kt = AT_SEQ(ti);
        const int s2 = (slot == 0) ? 3 : slot - 1;
        const LAS unsigned char* sl = lds + slot * SLOT;
        if (hf == 1 && ti + 3 < NT) { AT_STAGE(AT_SEQ(ti + 3), s2); }
        asm volatile("" : "+s"(ktd));
        const bool diag = (kt == ktd), left = (kt < ktd);
        (void)left;
        if (diag) {
            const float dq = (float)(tq - kt * 64 - 4 * hh);
#pragma unroll
            for (int r = 0; r < 16; ++r) { const float kk = (float)((r & 3) + 8 * (r >> 2)); s0[r] -= slope2 * fabsf(dq - kk); s1[r] -= slope2 * fabsf(dq - kk - 32.0f); }
        }
        float mxa = max3f(s0[0], s0[1], s0[2]), mxb = max3f(s1[0], s1[1], s1[2]), mxc = max3f(s0[3], s0[4], s0[5]), mxd = max3f(s1[3], s1[4], s1[5]);
        mxa = max3f(mxa, s0[6], s0[7]); mxb = max3f(mxb, s1[6], s1[7]); mxc = max3f(mxc, s0[8], s0[9]); mxd = max3f(mxd, s1[8], s1[9]);
        mxa = max3f(mxa, s0[10], s0[11]); mxb = max3f(mxb, s1[10], s1[11]); mxc = max3f(mxc, s0[12], s0[13]); mxd = max3f(mxd, s1[12], s1[13]);
        mxa = max3f(mxa, s0[14], s0[15]); mxb = max3f(mxb, s1[14], s1[15]);
        const float mx = swapmax(max3f(max3f(mxa, mxb, mxc), mxd, mxd));
        const bool dead = (ti > 0) && __all(mx < -40.0f);
        bf16x8 pf[4];
        if (!dead) {
        if (ti == 0 || __any(mx > 8.0f)) {
            const float delta = (ti == 0) ? mx : fmaxf(mx, 0.f);
#pragma unroll
            for (int r = 0; r < 16; ++r) { s0[r] -= delta; s1[r] -= delta; }
            if (ti > 0) { const float alpha = __builtin_amdgcn_exp2f(-delta); l *= alpha;
#pragma unroll
                for (int db = 0; db < 4; ++db)
#pragma unroll
                    for (int r = 0; r < 16; ++r) o[db][r] *= alpha; }
            m += delta;
        }
        float lsa = 0.f, lsb = 0.f, lsc = 0.f, lsd = 0.f;
#pragma unroll
        for (int r = 0; r < 16; r += 2) { s0[r] = __builtin_amdgcn_exp2f(s0[r]); s1[r] = __builtin_amdgcn_exp2f(s1[r]); s0[r + 1] = __builtin_amdgcn_exp2f(s0[r + 1]); s1[r + 1] = __builtin_amdgcn_exp2f(s1[r + 1]);
            lsa += s0[r]; lsb += s1[r]; lsc += s0[r + 1]; lsd += s1[r + 1]; }
        l += (lsa + lsb) + (lsc + lsd);
        {
            v4u w;
            w.x = cvtpk(s0[0], s0[1]); w.y = cvtpk(s0[2], s0[3]); w.z = cvtpk(s0[4], s0[5]); w.w = cvtpk(s0[6], s0[7]); pf[0] = __builtin_bit_cast(bf16x8, w);
            w.x = cvtpk(s0[8], s0[9]); w.y = cvtpk(s0[10], s0[11]); w.z = cvtpk(s0[12], s0[13]); w.w = cvtpk(s0[14], s0[15]); pf[1] = __builtin_bit_cast(bf16x8, w);
            w.x = cvtpk(s1[0], s1[1]); w.y = cvtpk(s1[2], s1[3]); w.z = cvtpk(s1[4], s1[5]); w.w = cvtpk(s1[6], s1[7]); pf[2] = __builtin_bit_cast(bf16x8, w);
            w.x = cvtpk(s1[8], s1[9]); w.y = cvtpk(s1[10], s1[11]); w.z = cvtpk(s1[12], s1[13]); w.w = cvtpk(s1[14], s1[15]); pf[3] = __builtin_bit_cast(bf16x8, w);
        }
        } else {
#pragma unroll
            for (int f = 0; f < 4; ++f) pf[f] = (bf16x8){0, 0, 0, 0, 0, 0, 0, 0};
        }
        if (hf == 1) { if (ti + 3 < NT) asm volatile("s_waitcnt vmcnt(4)" ::: "memory"); else asm volatile("s_waitcnt vmcnt(0)" ::: "memory"); }
        asm volatile("s_waitcnt lgkmcnt(0)" ::: "memory");
        __builtin_amdgcn_s_barrier();
        if (PROBE_REP & 16384) __builtin_amdgcn_s_barrier();
        asm volatile("" ::: "memory");
        if (hf == 0 && ti + 3 < NT) { AT_STAGE(AT_SEQ(ti + 3), s2); }
        if (ti + 1 < NT) { AT_KLOAD(lds + ((slot == 3) ? 0 : slot + 1) * SLOT); }
        __builtin_amdgcn_sched_barrier(0);
#define AT_VLOAD(dst, db) do { _Pragma("unroll") for (int _f = 0; _f < 4; ++_f) { dst##lo[_f] = vtr(sl + vb[db] + _f * 4096); dst##hi[_f] = vtr(sl + vb[db] + _f * 4096 + 2048); } } while (0)
#define AT_VMMA(src, db) do { _Pragma("unroll") for (int _f = 0; _f < 4; ++_f) { const bf16x8 vf = (bf16x8){src##lo[_f][0], src##lo[_f][1], src##lo[_f][2], src##lo[_f][3], src##hi[_f][0], src##hi[_f][1], src##hi[_f][2], src##hi[_f][3]}; \
            o[db] = __builtin_amdgcn_mfma_f32_32x32x16_bf16(vf, pf[_f], o[db], 0, 0, 0); if (PROBE_REP & 32768) { bf16x8 pz = (bf16x8){0,0,0,0,0,0,0,0}; asm volatile("" : "+v"(pz)); o[db] = __builtin_amdgcn_mfma_f32_32x32x16_bf16(vf, pz, o[db], 0, 0, 0); } } } while (0)
        if (!dead) {
            s16x4 valo[4], vahi[4], vb_lo[4], vb_hi[4];
            AT_VLOAD(va, 0); __builtin_amdgcn_sched_barrier(0);
            AT_VLOAD(vb_, 1); __builtin_amdgcn_sched_barrier(0);
            AT_VMMA(va, 0); __builtin_amdgcn_sched_barrier(0);
            AT_VLOAD(va, 2); __builtin_amdgcn_sched_barrier(0);
            AT_VMMA(vb_, 1); __builtin_amdgcn_sched_barrier(0);
            AT_VLOAD(vb_, 3); __builtin_amdgcn_sched_barrier(0);
            AT_VMMA(va, 2); __builtin_amdgcn_sched_barrier(0);
            AT_VMMA(vb_, 3); __builtin_amdgcn_sched_barrier(0);
        }
#undef AT_VLOAD
#undef AT_VMMA
        __builtin_amdgcn_sched_barrier(0);
        if (ti + 1 < NT) { const int ktn = AT_SEQ(ti + 1); AT_QK(ktn); }
        if (hf == 0) { if (ti + 3 < NT) asm volatile("s_waitcnt vmcnt(4)" ::: "memory"); else asm volatile("s_waitcnt vmcnt(0)" ::: "memory"); }
        asm volatile("s_waitcnt lgkmcnt(0)" ::: "memory");
        __builtin_amdgcn_s_barrier();
        if (PROBE_REP & 16384) __builtin_amdgcn_s_barrier();
        asm volatile("" ::: "memory");
        slot = (slot == 3) ? 0 : slot + 1;
    }
    if (hf == 0) __builtin_amdgcn_s_barrier();
    asm volatile("" ::: "memory");
#undef AT_QK
#undef AT_KLOAD
#undef AT_STAGE
#undef AT_GLDS
#undef AT_SEQ
    l = swapsum(l);
    const float il = 1.0f / l;
    __builtin_amdgcn_s_barrier();
    LAS float* xch = (LAS float*)lds + w4 * (64 * 64);
    if (hf == 1) {
#pragma unroll
        for (int db = 0; db < 4; ++db)
#pragma unroll
            for (int r = 0; r < 16; ++r) xch[(db * 16 + r) * 64 + lane] = o[db][r] * il;
    }
    asm volatile("s_waitcnt lgkmcnt(0)" ::: "memory");
    __builtin_amdgcn_s_barrier();
    asm volatile("" ::: "memory");
    if (hf == 0) {
        float ss = 0.f; float lfv, omv; asm volatile("v_mov_b32 %0, %2\n\tv_mov_b32 %1, %3" : "=&v"(lfv), "=&v"(omv) : "s"(lam_full), "s"(oml));
#pragma unroll
        for (int db = 0; db < 4; ++db)
#pragma unroll
            for (int r = 0; r < 16; ++r) { const float v = o[db][r] * il - lfv * xch[(db * 16 + r) * 64 + lane]; o[db][r] = v; ss += v * v; }
        ss = swapsum(ss);
        const float rs = omv / sqrtf(ss * (1.0f / 128.0f) + EPS);
        const int le = lane_id_volatile(), tqe = qb * 128 + w4 * 32 + (le & 31), hhe = le >> 5;
        bf16* op = hd + ((size_t)b * SEQ + tqe) * 1024 + 512 + h * 128 + 4 * hhe;
#pragma unroll
        for (int db = 0; db < 4; ++db)
#pragma unroll
            for (int r4 = 0; r4 < 4; ++r4) { const int d = db * 32 + 8 * r4; const f32x4 g = *(const f32x4*)(ng + d + 4 * hhe);
                v2u w; w.x = pk2(o[db][4 * r4] * rs * g.x, o[db][4 * r4 + 1] * rs * g.y); w.y = pk2(o[db][4 * r4 + 2] * rs * g.z, o[db][4 * r4 + 3] * rs * g.w);
                *(v2u*)(op + d) = w; }
    }
    asm volatile("s_waitcnt lgkmcnt(0)" ::: "memory");
    __builtin_amdgcn_s_barrier();
}
}
namespace mls {
using attn::f32x16; using attn::s16x4; using attn::vtr; using attn::cvtpk; using attn::swapsum; using attn::crow;
constexpr int QS = 0, KS = 32768, VS = 65536, CB = 98304, AUX = 132096;
constexpr int A_FS = 0, A_ET = 512, A_SIN = 1024, A_EMT = 1536, A_WS = 2048, A_NV = 2560, A_NP = 3072, A_SC = 5120, A_CW = 5632;
__device__ __forceinline__ int swz(int row) { return ((row & 3) << 2) | ((row >> 2) & 3); }
__device__ __forceinline__ int offs(int row, int ch) { return row * 256 + ((ch ^ swz(row)) << 4); }
__device__ __forceinline__ bf16x8 rdrow(const LAS unsigned char* lds, int buf, int RB, int i, int ks) { return *(const LAS bf16x8*)(lds + buf + (RB ^ (ks << 5)) + i * 8192); }
__device__ __forceinline__ bf16x8 trB(const LAS unsigned char* lds, int buf, int TB, int rowc, int c0) {
    const s16x4 lo = vtr(lds + buf + (TB ^ (c0 << 4)) + rowc * 256), hi = vtr(lds + buf + (TB ^ ((c0 | 2) << 4)) + (rowc + 8) * 256);
    return (bf16x8){lo[0], lo[1], lo[2], lo[3], hi[0], hi[1], hi[2], hi[3]};
}
__device__ __forceinline__ bf16x8 trC(const LAS unsigned char* lds, int buf, int TC, int ss, int c0) {
    const s16x4 lo = vtr(lds + buf + (TC ^ (c0 << 4)) + (16 * ss) * 256), hi = vtr(lds + buf + (TC ^ ((c0 | 1) << 4)) + (16 * ss + 4) * 256);
    return (bf16x8){lo[0], lo[1], lo[2], lo[3], hi[0], hi[1], hi[2], hi[3]};
}
__device__ __forceinline__ void mm8(f32x16& acc, const LAS unsigned char* lds, int bufA, int ia, int bufB, int ib, int RB) {
    bf16x8 a[2], b[2];
    a[0] = rdrow(lds, bufA, RB, ia, 0); b[0] = rdrow(lds, bufB, RB, ib, 0);
#pragma unroll
    for (int ks = 0; ks < 8; ++ks) {
        if (ks + 1 < 8) { a[(ks + 1) & 1] = rdrow(lds, bufA, RB, ia, ks + 1); b[(ks + 1) & 1] = rdrow(lds, bufB, RB, ib, ks + 1); }
        acc = __builtin_amdgcn_mfma_f32_32x32x16_bf16(a[ks & 1], b[ks & 1], acc, 0, 0, 0);
        __builtin_amdgcn_sched_barrier(0);
    }
}
template <int CTRL, int RM> __device__ __forceinline__ float dpp_f(float idv, float v) { return __int_as_float(__builtin_amdgcn_update_dpp(__float_as_int(idv), __float_as_int(v), CTRL, RM, 0xf, false)); }
__device__ __forceinline__ float scan_add(float x, int) {
    x += dpp_f<0x111, 0xf>(0.f, x); x += dpp_f<0x112, 0xf>(0.f, x); x += dpp_f<0x114, 0xf>(0.f, x); x += dpp_f<0x118, 0xf>(0.f, x);
    x += dpp_f<0x142, 0xa>(0.f, x); x += dpp_f<0x143, 0xc>(0.f, x); return x;
}
__device__ __forceinline__ float scan_max(float x, int) {
    const float ni = -3.0e38f;
    x = fmaxf(x, dpp_f<0x111, 0xf>(ni, x)); x = fmaxf(x, dpp_f<0x112, 0xf>(ni, x)); x = fmaxf(x, dpp_f<0x114, 0xf>(ni, x)); x = fmaxf(x, dpp_f<0x118, 0xf>(ni, x));
    x = fmaxf(x, dpp_f<0x142, 0xa>(ni, x)); x = fmaxf(x, dpp_f<0x143, 0xc>(ni, x)); return x;
}
__device__ __forceinline__ void item(LAS unsigned char* lds, int tid, int b, int h, int dir, const bf16* zqk, const bf16* zmv, const float* mg, const float* cw, const float* cb, bf16* outp) {
    const int lane = tid & 63, wave = __builtin_amdgcn_readfirstlane(tid >> 6);
    LAS float* aux = (LAS float*)(lds + AUX);
    { unsigned zz = 0u; asm volatile("" : "+v"(zz)); for (int i = tid; i < 32768 / 16; i += NTHREADS) *(LAS v4u*)(lds + CB + i * 16) = (v4u){zz, zz, zz, zz}; }
    if (tid < 128) aux[A_NV / 4 + tid] = 0.f;
    if (tid < 4 * 128) aux[A_NP / 4 + tid] = 0.f;
    if (tid < 8) aux[A_SC / 4 + tid] = 1.f;
    for (int i = tid; i < 6 * 256; i += NTHREADS) { const int j = i >> 8, c = i & 255; const int col = (c < 128) ? (h * 128 + c) : (512 + h * 128 + (c - 128)); aux[A_CW / 4 + i] = (j < 5) ? cw[j * 1024 + col] : cb[col]; }
    f32x16 X[2];
#pragma unroll
    for (int kb = 0; kb < 2; ++kb)
#pragma unroll
        for (int r = 0; r < 16; ++r) X[kb][r] = 0.f;
    float mstate = 0.f;
    __syncthreads();
#pragma unroll 1
    for (int c = 0; c < SEQ / 128; ++c) {
        const int c0 = dir ? (SEQ - 128 - c * 128) : c * 128;
        int tl = tid; asm volatile("" : "+v"(tl));
        if (tl >= 128 && tl < 256) { const int k = tl - 128; aux[A_NV / 4 + k] = aux[A_SC / 4 + ((c + 1) & 1)] * aux[A_NV / 4 + k] + (aux[A_NP / 4 + k] + aux[A_NP / 4 + 128 + k]) + (aux[A_NP / 4 + 256 + k] + aux[A_NP / 4 + 384 + k]); }
        {
          const int cq = tl & 31, rg = tl >> 5; const int col = (cq < 16) ? (h * 128 + cq * 8) : (512 + h * 128 + (cq - 16) * 8);
          const float ksc = (cq < 16) ? 1.0f : 0.08838834764831845f;
          const int base = dir ? (c0 + 118 - 8 * rg) : (c0 + 8 * rg - 2);
          v4u xr[12], vr[4];
#pragma unroll
          for (int i = 0; i < 12; ++i) { const int ts = dir ? base + 11 - i : base + i; xr[i] = (v4u){0u, 0u, 0u, 0u}; if (ts >= 0 && ts < SEQ) xr[i] = *(const v4u*)(zqk + ((size_t)b * SEQ + ts) * 1024 + col); }
#pragma unroll
          for (int n = 0; n < 4; ++n) { const int i = tl + NTHREADS * n, u = i >> 4, ch = i & 15; const int pos = dir ? (c0 + 127 - u) : (c0 + u);
              vr[n] = *(const v4u*)(zmv + ((size_t)b * SEQ + pos) * 512 + h * 128 + ch * 8); }
          const LAS float* cwl = aux + A_CW / 4 + cq * 8;
          float xu[12][8];
#define ML_UNP(r_) do { xu[r_][0] = bflo(xr[r_].x); xu[r_][1] = bfhi(xr[r_].x); xu[r_][2] = bflo(xr[r_].y); xu[r_][3] = bfhi(xr[r_].y); xu[r_][4] = bflo(xr[r_].z); xu[r_][5] = bfhi(xr[r_].z); xu[r_][6] = bflo(xr[r_].w); xu[r_][7] = bfhi(xr[r_].w); } while (0)
#pragma unroll
          for (int n = 0; n < 8; ++n) {
              if (n == 0) { ML_UNP(0); ML_UNP(1); ML_UNP(2); ML_UNP(3); }
              ML_UNP(n + 4);
              float a[8];
              { const f32x4 b0 = *(const LAS f32x4*)(cwl + 5 * 256), b1 = *(const LAS f32x4*)(cwl + 5 * 256 + 4); a[0] = b0.x; a[1] = b0.y; a[2] = b0.z; a[3] = b0.w; a[4] = b1.x; a[5] = b1.y; a[6] = b1.z; a[7] = b1.w; }
#pragma unroll
              for (int j = 0; j < CONVW; ++j) { const LAS float* wp = cwl + (dir ? (CONVW - 1 - j) : j) * 256; const f32x4 w0 = *(const LAS f32x4*)wp, w1 = *(const LAS f32x4*)(wp + 4);
                  a[0] += w0.x * xu[n + j][0]; a[1] += w0.y * xu[n + j][1]; a[2] += w0.z * xu[n + j][2]; a[3] += w0.w * xu[n + j][3]; a[4] += w1.x * xu[n + j][4]; a[5] += w1.y * xu[n + j][5]; a[6] += w1.z * xu[n + j][6]; a[7] += w1.w * xu[n + j][7]; }
#pragma unroll
              for (int e = 0; e < 8; ++e) a[e] = a[e] * sigmoidf_(a[e]) * ksc;
              v4u o; o.x = pk2(a[0], a[1]); o.y = pk2(a[2], a[3]); o.z = pk2(a[4], a[5]); o.w = pk2(a[6], a[7]);
              *(LAS v4u*)(lds + ((cq < 16) ? QS : KS) + offs(8 * rg + n, cq & 15)) = o;
              __builtin_amdgcn_sched_barrier(0); }
#undef ML_UNP
#pragma unroll
          for (int n = 0; n < 4; ++n) { const int i = tl + NTHREADS * n, u = i >> 4, ch = i & 15; *(LAS v4u*)(lds + VS + offs(u, ch)) = vr[n]; } }
        if (wave == 0) {
            int ln_ = lane; asm volatile("" : "+v"(ln_));
            const int u0 = 2 * ln_, u1 = u0 + 1; const int p0 = dir ? (c0 + 127 - u0) : (c0 + u0), p1 = dir ? (c0 + 127 - u1) : (c0 + u1);
            const float* g0 = mg + ((size_t)b * SEQ + p0) * 16 + dir * 8 + h; const float* g1p = mg + ((size_t)b * SEQ + p1) * 16 + dir * 8 + h;
            const float ip0 = g0[0], fp0 = g0[4], ip1 = g1p[0], fp1 = g1p[4];
            const float lf0 = fminf(fp0, 0.f) - log1pf(__expf(-fabsf(fp0))), lf1 = fminf(fp1, 0.f) - log1pf(__expf(-fabsf(fp1)));
            const float incl = scan_add(lf0 + lf1, lane);
            const float bc1 = incl, bc0 = incl - lf1;
            const float fs0 = ip0 - bc0, fs1 = ip1 - bc1;
            const float pmx = scan_max(fmaxf(fs0, fs1), lane);
            const float prev = dpp_f<0x138, 0xf>(-3.0e38f, pmx);
            const float dm0 = fmaxf(prev, fs0), dm1 = pmx;
            const float gtot = __uint_as_float(__builtin_amdgcn_readlane(__float_as_uint(bc1), 63)), dlast = __uint_as_float(__builtin_amdgcn_readlane(__float_as_uint(pmx), 63));
            const float M0 = fmaxf(mstate, dm0), M1 = fmaxf(mstate, dm1), Ml = fmaxf(mstate, dlast);
            aux[A_FS / 4 + u0] = fs0; aux[A_FS / 4 + u1] = fs1;
            aux[A_ET / 4 + u0] = -M0; aux[A_ET / 4 + u1] = -M1;
            aux[A_SIN / 4 + u0] = __expf(mstate - M0); aux[A_SIN / 4 + u1] = __expf(mstate - M1);
            aux[A_EMT / 4 + u0] = __expf(-(bc0 + M0)); aux[A_EMT / 4 + u1] = __expf(-(bc1 + M1));
            aux[A_WS / 4 + u0] = __expf(fs0 - Ml); aux[A_WS / 4 + u1] = __expf(fs1 - Ml);
            if (lane == 0) aux[A_SC / 4 + (c & 1)] = __expf(mstate - Ml);
            mstate = gtot + Ml;
        }
        __syncthreads();
        {
            int lb = lane; asm volatile("" : "+v"(lb));
            const int r32 = lb & 31, hh = lb >> 5;
            int RB, RB2, TB;
            { const int sw = swz(r32), li = lb & 15, q_ = li >> 2, p_ = li & 3, x = 2 * ((lb >> 4) & 1) + (p_ >> 1);
              RB = r32 * 256 + ((hh ^ sw) << 4); RB2 = r32 * 256 + (((8 * hh) ^ sw) << 4);
              TB = (4 * hh + q_) * 256 + (((q_ << 2) | (x ^ hh)) << 4) + 8 * (p_ & 1); }
            const int j = wave & 3, vh = wave >> 2, t = 32 * j + r32;
            f32x16 acc[2];
#pragma unroll
            for (int vb2 = 0; vb2 < 2; ++vb2) {
#pragma unroll
                for (int r = 0; r < 16; ++r) acc[vb2][r] = 0.f;
                mm8(acc[vb2], lds, CB, 2 * vh + vb2, QS, j, RB);
                asm volatile("" : "+v"(RB));
            }
            const float sin = aux[A_SIN / 4 + t], et = aux[A_ET / 4 + t];
#pragma unroll
            for (int vb2 = 0; vb2 < 2; ++vb2)
#pragma unroll
                for (int r = 0; r < 16; ++r) acc[vb2][r] *= sin;
            float dn = 0.f;
#pragma unroll
            for (int cq = 0; cq < 8; ++cq) { const int ch = 8 * hh + cq; const v4u qv = *(const LAS v4u*)(lds + QS + (RB2 ^ (cq << 4)) + j * 8192); const f32x4 n0 = *(const LAS f32x4*)(aux + A_NV / 4 + 8 * ch), n1 = *(const LAS f32x4*)(aux + A_NV / 4 + 8 * ch + 4);
                dn += n0.x * bflo(qv.x) + n0.y * bfhi(qv.x) + n0.z * bflo(qv.y) + n0.w * bfhi(qv.y) + n1.x * bflo(qv.z) + n1.y * bfhi(qv.z) + n1.z * bflo(qv.w) + n1.w * bfhi(qv.w);
                if (cq & 1) { asm volatile("" : "+v"(dn)); __builtin_amdgcn_sched_barrier(0); } }
            float dsum = 0.f;
            for (int i = 0; i <= j; ++i) {
                f32x16 sc;
#pragma unroll
                for (int r = 0; r < 16; ++r) sc[r] = 0.f;
                mm8(sc, lds, KS, i, QS, j, RB);
                asm volatile("" : "+v"(RB));
                bf16x8 vfr[4];
#pragma unroll
                for (int vb2 = 0; vb2 < 2; ++vb2) { vfr[2 * vb2] = trB(lds, VS, TB, 32 * i, 4 * (2 * vh + vb2)); vfr[2 * vb2 + 1] = trB(lds, VS, TB, 32 * i + 16, 4 * (2 * vh + vb2)); }
                __builtin_amdgcn_sched_barrier(0);
#pragma unroll
                for (int r4 = 0; r4 < 4; ++r4) { const f32x4 fs = *(const LAS f32x4*)(aux + A_FS / 4 + 32 * i + 8 * r4 + 4 * hh);
#pragma unroll
                    for (int e = 0; e < 4; ++e) { const int r = 4 * r4 + e; const float p = __expf(et + fs[e]); const bool ok = (i < j) || (8 * r4 + 4 * hh + e <= r32);
                        const float w = ok ? sc[r] * p : 0.f; sc[r] = w; dsum += w; } }
                v4u w0, w1;
                w0.x = cvtpk(sc[0], sc[1]); w0.y = cvtpk(sc[2], sc[3]); w0.z = cvtpk(sc[4], sc[5]); w0.w = cvtpk(sc[6], sc[7]);
                w1.x = cvtpk(sc[8], sc[9]); w1.y = cvtpk(sc[10], sc[11]); w1.z = cvtpk(sc[12], sc[13]); w1.w = cvtpk(sc[14], sc[15]);
                const bf16x8 wf0 = __builtin_bit_cast(bf16x8, w0), wf1 = __builtin_bit_cast(bf16x8, w1);
                __builtin_amdgcn_sched_barrier(0);
#pragma unroll
                for (int vb2 = 0; vb2 < 2; ++vb2) {
                    acc[vb2] = __builtin_amdgcn_mfma_f32_32x32x16_bf16(vfr[2 * vb2], wf0, acc[vb2], 0, 0, 0);
                    acc[vb2] = __builtin_amdgcn_mfma_f32_32x32x16_bf16(vfr[2 * vb2 + 1], wf1, acc[vb2], 0, 0, 0);
                    __builtin_amdgcn_sched_barrier(0);
                }
            }
            const float den = swapsum(dn) * sin + swapsum(dsum);
            const float scale = 1.0f / fmaxf(fabsf(den), aux[A_EMT / 4 + t]);
            const int pos = dir ? (c0 + 127 - t) : (c0 + t);
            bf16* op = outp + ((size_t)b * SEQ + pos) * 512 + h * 128 + 4 * hh;
#pragma unroll
            for (int vb2 = 0; vb2 < 2; ++vb2)
#pragma unroll
                for (int r4 = 0; r4 < 4; ++r4) { v2u o4; o4.x = cvtpk(acc[vb2][4 * r4] * scale, acc[vb2][4 * r4 + 1] * scale); o4.y = cvtpk(acc[vb2][4 * r4 + 2] * scale, acc[vb2][4 * r4 + 3] * scale);
                    *(v2u*)(op + 32 * (2 * vh + vb2) + 8 * r4) = o4; }
        }
        __syncthreads();
        {
            int lb = lane; asm volatile("" : "+v"(lb));
            const int hh = lb >> 5;
            int TC;
            { const int li = lb & 15, q_ = li >> 2, p_ = li & 3, x = 2 * ((lb >> 4) & 1) + (p_ >> 1);
              TC = (8 * hh + q_) * 256 + (((q_ << 2) | (x ^ (2 * hh))) << 4) + 8 * (p_ & 1); }
            const int vs = wave & 3, kh = wave >> 2;
            const float sp = aux[A_SC / 4 + (c & 1)];
#pragma unroll
            for (int kb = 0; kb < 2; ++kb)
#pragma unroll
                for (int r = 0; r < 16; ++r) X[kb][r] *= sp;
            {
                bf16x8 vr_[2], k0_[2], k1_[2]; f32x4 wa_[2], wb_[2];
                vr_[0] = trC(lds, VS, TC, 0, 4 * vs); k0_[0] = trC(lds, KS, TC, 0, 8 * kh); k1_[0] = trC(lds, KS, TC, 0, 8 * kh + 4);
                wa_[0] = *(const LAS f32x4*)(aux + A_WS / 4 + 8 * hh); wb_[0] = *(const LAS f32x4*)(aux + A_WS / 4 + 8 * hh + 4);
#pragma unroll
                for (int ss = 0; ss < 8; ++ss) { const int cu = ss & 1, nx = cu ^ 1;
                    if (ss + 1 < 8) { vr_[nx] = trC(lds, VS, TC, ss + 1, 4 * vs); k0_[nx] = trC(lds, KS, TC, ss + 1, 8 * kh); k1_[nx] = trC(lds, KS, TC, ss + 1, 8 * kh + 4);
                        wa_[nx] = *(const LAS f32x4*)(aux + A_WS / 4 + 16 * (ss + 1) + 8 * hh); wb_[nx] = *(const LAS f32x4*)(aux + A_WS / 4 + 16 * (ss + 1) + 8 * hh + 4); }
                    const v4u vv = __builtin_bit_cast(v4u, vr_[cu]); const f32x4 wa = wa_[cu], wb = wb_[cu]; v4u vw;
                    vw.x = cvtpk(bflo(vv.x) * wa.x, bfhi(vv.x) * wa.y); vw.y = cvtpk(bflo(vv.y) * wa.z, bfhi(vv.y) * wa.w); vw.z = cvtpk(bflo(vv.z) * wb.x, bfhi(vv.z) * wb.y); vw.w = cvtpk(bflo(vv.w) * wb.z, bfhi(vv.w) * wb.w);
                    const bf16x8 vf = __builtin_bit_cast(bf16x8, vw);
                    X[0] = __builtin_amdgcn_mfma_f32_32x32x16_bf16(k0_[cu], vf, X[0], 0, 0, 0);
                    X[1] = __builtin_amdgcn_mfma_f32_32x32x16_bf16(k1_[cu], vf, X[1], 0, 0, 0);
                    __builtin_amdgcn_sched_barrier(0);
                }
            }
            { int t2 = tid; asm volatile("" : "+v"(t2)); const int k = t2 & 127, sq = t2 >> 7; float a = 0.f;
#pragma unroll 8
              for (int s2 = 0; s2 < 32; ++s2) { const int sI = 32 * sq + s2; a += aux[A_WS / 4 + sI] * bf2f(*(const LAS unsigned short*)(lds + KS + offs(sI, k >> 3) + (k & 7) * 2)); }
              aux[A_NP / 4 + sq * 128 + k] = a; }
        }
        __syncthreads();
        { int lb = lane; asm volatile("" : "+v"(lb)); const int r32 = lb & 31, hh = lb >> 5;
          const int vs = wave & 3, kh = wave >> 2, v = 32 * vs + r32;
#pragma unroll
          for (int kb = 0; kb < 2; ++kb)
#pragma unroll
              for (int r4 = 0; r4 < 4; ++r4) { v2u w; w.x = cvtpk(X[kb][4 * r4], X[kb][4 * r4 + 1]); w.y = cvtpk(X[kb][4 * r4 + 2], X[kb][4 * r4 + 3]);
                  *(LAS v2u*)(lds + CB + offs(v, 8 * kh + 4 * kb + r4) + 8 * hh) = w; } }
    }
    __syncthreads();
}
}
constexpr int CW_QUEUE = 2048;
__device__ __forceinline__ void ph_mixers(Frame& F, int l, int qslot) {
    PH_IDS;
    static_assert(DEPTH == 2, "lam_init literals");
    const float lam_init = (l == 0) ? 0.2f : 0.35550906759096927f;
    const float* lam = F.in[I_LAM] + (size_t)l * 4 * ADH;
    const float s01 = wave_sum_fast(lam[lane] * lam[64 + lane]), s23 = wave_sum_fast(lam[128 + lane] * lam[192 + lane]);
    const float lam_full = __uint_as_float(__builtin_amdgcn_readfirstlane(__float_as_uint(__expf(s01) - __expf(s23) + lam_init)));
    const unsigned oml = (l == 0) ? 0x3f4ccccdu : 0x3f24fd5cu;
    const float* cw = F.in[I_CW] + (size_t)l * CONVW * 2 * MW; const float* cb = F.in[I_CB] + (size_t)l * 2 * MW;
    unsigned* head = (unsigned*)(F.ws + WS_CTL) + CW_QUEUE + 64 * qslot;
    volatile LAS unsigned* qw = (volatile LAS unsigned*)(F.lds + MISC_OFF + 64);
    constexpr int NML = BATCH * MH * 2, NAT = BATCH * AH * (SEQ / 128);
    constexpr int NCV0 = (CV_NITEMS - CV_WIN) / 128, NCV1 = CV_WIN / 128;
    static_assert((CV_NITEMS - CV_WIN) % 128 == 0 && CV_WIN % 128 == 0 && 3 * (NCV0 + NCV1) <= NAT + NCV0 + NCV1, "conversion items are 128 tiles; the (2 attention, 1 conversion) groups fit");
    const int NCV = NCV0 + ((l + 1 < DEPTH) ? NCV1 : 0);
    for (;;) {
        __syncthreads();
        if (tid == 0) qw[0] = __hip_atomic_fetch_add(head, 1u, __ATOMIC_RELAXED, __HIP_MEMORY_SCOPE_AGENT);
        __syncthreads();
        int it = (int)qw[0];
        if (PROBE_REP & 8) { if (it >= NML + 2 * (NAT + NCV)) break; if (it >= NML + NAT + NCV) it -= NAT + NCV; }
        else if (PROBE_REP & 4) { if (it >= 2 * NML + NAT + NCV) break; if (it >= NML + NAT + NCV) it -= NML + NAT + NCV; }
        else if (it >= NML + NAT + NCV) break;
        const int tq_ = F.wv * 64 + lane_id_volatile();
        if (it < NML) { const int dir = it & 1, h = (it >> 1) & 3, b = it >> 3; int t1 = tq_; asm volatile("" : "+v"(t1));
            mls::item(F.lds, t1, b, h, dir, WSP(bf16, WS_ZQK), WSP(bf16, WS_ZMV), WSP(float, WS_MG), cw, cb, WSP(bf16, dir ? WS_HB : WS_HF)); }
        else {
            const int j = it - NML; int u, ci = -1;
            if (j < 3 * NCV) { if (j % 3 == 2) ci = j / 3; u = j - j / 3; } else u = j - NCV;
            if (ci >= 0) {
                int t2 = tq_; asm volatile("" : "+v"(t2));
                const int l2 = (ci >= NCV0) ? l + 1 : l, first = (ci >= NCV0) ? (ci - NCV0) * 128 : CV_WIN + ci * 128;
                cv_run(F, l2, t2 & 63, (LAS float*)(F.lds + (t2 >> 6) * 16384), first, 128, __builtin_amdgcn_readfirstlane(t2 >> 6), NWAVES); }
            else { const int qb = u & 15, b = (u >> 4) & 15, h = 3 - (u >> 8);
            int t3 = tq_; asm volatile("" : "+v"(t3));
            attn::unit(F.lds, t3, b, h, qb, WSP(bf16, WS_ZDQ), WSP(bf16, WS_ZDK), WSP(bf16, WS_ZDV), WSP(bf16, WS_HM), F.in[I_DNG] + (size_t)l * ADV, lam_full, oml); } }
    }
}

constexpr int NPH = 1 + DEPTH * 10;
__global__ void __launch_bounds__(NTHREADS, 2) fwd(Args args) {
    extern __shared__ __attribute__((aligned(16))) unsigned char lds_raw[];
    Frame F;
    F.lds = (LAS unsigned char*)lds_raw;
    F.G = gridDim.x; F.bx = blockIdx.x; F.wv = __builtin_amdgcn_readfirstlane(threadIdx.x >> 6);
#pragma unroll
    for (int i = 0; i < 18; ++i) F.in[i] = args.in[i];
    F.X = args.out; F.ws = args.ws;
    volatile LAS unsigned* MISC = (volatile LAS unsigned*)(F.lds + MISC_OFF);
    for (int u = threadIdx.x; u < (LDS_BYTES - LDSCTL_OFF) / 4; u += NTHREADS) ((LAS unsigned*)(F.lds + LDSCTL_OFF))[u] = 0u;
    __syncthreads();
    const int lo = args.ph_lo, hi = args.ph_hi;
    XcdBarrier bar; bar.bar = (unsigned*)(F.ws + WS_CTL) + CW_BAR; bar.x = 0; bar.st = nullptr;
    if (hi - lo > 1) bar = xcd_barrier_post((unsigned*)(F.ws + WS_CTL) + CW_BAR, MISC + 8);
#define IN(k) (lo <= (k) && (k) < hi)
#define SEAM(k) do { if (IN(k) && IN((k) + 1)) { xcd_barrier(bar); if (PROBE_REP & 4096) xcd_barrier(bar); } } while (0)
    LAS unsigned char* ring = F.lds;

    if (IN(0)) { ph_convert(F, 0); ph_prep_first(F);
        if (PROBE_REP & 1) { __syncthreads(); ph_convert(F, 0); ph_prep_first(F); } }
    SEAM(0);
    for (int l = 0; l < DEPTH; ++l) {
        const int p0 = 1 + l * 10;
        if (IN(p0 + 0)) {
            ph_mgate(F, l);
            pg8::StdOrder S; S.init(T, NIN - 2560, F.G, F.bx);
            pg8::EpiInproj E{WSP(bf16, WS_ZQK), WSP(bf16, WS_ZMV), WSP(bf16, WS_ZMO), WSP(bf16, WS_ZDQ), WSP(bf16, WS_ZDK), WSP(bf16, WS_ZDV), WSP(bf16, WS_ZG), WSP(float, WS_RSTD1)};
            pg8::gemm_phase(ring, WSP(bf16, WS_XR), WSP(bf16, WS_WIN), D, S, E, F.wv);
            pg8::StdOrderG S2; S2.init(T, 2560, F.G, F.bx);
            pg8::EpiGate8 E2{WSP(bf16, WS_ZMO), WSP(bf16, WS_ZG), WSP(float, WS_RSTD1)};
            pg8::gemm_phase(ring, WSP(bf16, WS_MIX), (const pg8::bf16_t*)(F.ws + WS_WIN8), D / 2, S2, E2, F.wv);
        }
        SEAM(p0 + 0);
        if (IN(p0 + 1)) { ph_mixers(F, l, l); }
        SEAM(p0 + 1);
        if (IN(p0 + 2)) { for (int rep = 0; rep < ((PROBE_REP & 16) ? 2 : 1); ++rep) ph_mnorm(F, l); }
        SEAM(p0 + 2);
        if (IN(p0 + 3)) {
            pg8::UpOrder S; S.init(T, D, F.G, F.bx);
            pg8::EpiUp E{WSP(bf16, WS_MIX), WSP(bf16, WS_ZG)}; pg8::gemm_phase(ring, WSP(bf16, WS_HM), WSP(bf16, l == 0 ? WS_WA : WS_WA_L1), MW, S, E, F.wv, 1024);
        }
        SEAM(p0 + 3);
        if (IN(p0 + 4)) {
            pg8::StdOrder S; S.init(T, D, F.G, F.bx);
            pg8::EpiResid E{WSP(bf16, WS_XR)}; pg8::gemm_phase(ring, WSP(bf16, WS_MIX), WSP(bf16, l == 0 ? WS_WO : WS_WO_L1), D, S, E, F.wv);
        }
        SEAM(p0 + 4);
        if (IN(p0 + 5)) { for (int rep = 0; rep < ((PROBE_REP & 64) ? 2 : 1); ++rep) ph_prep2(F, l); }
        SEAM(p0 + 5);
        if (IN(p0 + 6)) { for (int rep = 0; rep < ((PROBE_REP & 128) ? 2 : 1); ++rep) ph_topk(F); }
        SEAM(p0 + 6);
        if (IN(p0 + 7)) {
            pg8::G1Order S{WSP(int, WS_IDX), F.G, F.bx};
            pg8::EpiG1 E{F.ws + WS_HID}; for (int rep = 0; rep < ((PROBE_REP & 256) ? 2 : 1); ++rep) pg8::gemm_phase(ring, WSP(bf16, WS_XB), WSP(bf16, l == 0 ? WS_WGU : WS_WGU_L1), D / 2, S, E, F.wv);
        }
        SEAM(p0 + 7);
        if (IN(p0 + 8)) {
            pg8::G2Order S{F.G, F.bx};
            pg8::EpiG2 E{F.ws + WS_YE, WSP(float, WS_GATEV)}; for (int rep = 0; rep < ((PROBE_REP & 512) ? 2 : 1); ++rep) pg8::gemm_phase(ring, WSP(bf16, WS_HID), WSP(bf16, l == 0 ? WS_WD : WS_WD_L1), DFF / 2, S, E, F.wv);
        }
        SEAM(p0 + 8);
        if (IN(p0 + 9)) { ph_combine(F, l); }
        SEAM(p0 + 9);
    }
#undef IN
#undef SEAM
}

extern "C" void kernel_launch(void* const* d_in, const int* in_sizes, int n_in, void* d_out, int out_size, void* d_ws, size_t ws_size, hipStream_t stream) {
    static int grid = 0;
    if (grid == 0) {
        if (n_in != 18 || out_size != T * D || ws_size < WS_END2) { fprintf(stderr, "kernel_launch: unexpected shapes (n_in %d, out %d, ws %zu)\n", n_in, out_size, ws_size); grid = -1; return; }
        int dev = 0, cus = 0, per_cu = 0;
        if (hipGetDevice(&dev) != hipSuccess || hipDeviceGetAttribute(&cus, hipDeviceAttributeMultiprocessorCount, dev) != hipSuccess) { grid = -1; return; }
        if (hipFuncSetAttribute((const void*)fwd, hipFuncAttributeMaxDynamicSharedMemorySize, LDS_BYTES) != hipSuccess) { fprintf(stderr, "kernel_launch: hipFuncSetAttribute failed\n"); grid = -1; return; }
        if (hipOccupancyMaxActiveBlocksPerMultiprocessor(&per_cu, (const void*)fwd, NTHREADS, LDS_BYTES) != hipSuccess || per_cu < 1) fprintf(stderr, "kernel_launch: occupancy query says %d\n", per_cu);
        (void)hipGetLastError();
        grid = cus;
    }
    if (grid < 0) return;
    (void)hipMemsetAsync((char*)d_ws + WS_CTL, 0, CTL_ZERO_BYTES, stream);
    Args a{};
    for (int i = 0; i < 18; ++i) a.in[i] = (const float*)d_in[i];
    a.out = (float*)d_out; a.ws = (unsigned char*)d_ws;
#if MK_ONE_LAUNCH
    a.ph_lo = 0; a.ph_hi = NPH;
    hipLaunchKernelGGL(fwd, dim3(grid), dim3(NTHREADS), LDS_BYTES, stream, a);
#else
    for (int p = 0; p < NPH; ++p) { a.ph_lo = p; a.ph_hi = p + 1; hipLaunchKernelGGL(fwd, dim3(grid), dim3(NTHREADS), LDS_BYTES, stream, a); }
#endif
}
```

```cpp
#include <hip/hip_runtime.h>
#include <cstdio>
#include <cstdint>

#ifndef PROBE_REP
#define PROBE_REP 0
#endif
#ifndef NAIVE_MLSTM
#define NAIVE_MLSTM 0
#endif
#ifndef NAIVE_ATTN
#define NAIVE_ATTN 0
#endif
#ifndef MK_ONE_LAUNCH
#define MK_ONE_LAUNCH 1
#endif

constexpr int D = 1024, BATCH = 16, SEQ = 2048, T = BATCH * SEQ, DEPTH = 2;
constexpr int MH = 4, MDH = 128, MW = 512, CONVW = 5, NMG = 16;
constexpr int AH = 4, ADH = 64, ADV = 128;
constexpr int IN_COLS = 5648, OFF_MG = 2048, OFF_DQ = 2064;
constexpr int NE = 16, CAP = 256, DFF = 2048;
constexpr int NIN = 5632;
constexpr float EPS = 1e-6f;
constexpr float LOG2E = 1.4426950408889634f;
constexpr int NWAVES = 8, NTHREADS = 512;

#define GAS __attribute__((address_space(1)))
#define LAS __attribute__((address_space(3)))
typedef unsigned short bf16;
typedef unsigned v4u __attribute__((ext_vector_type(4)));
typedef unsigned v2u __attribute__((ext_vector_type(2)));
typedef float f32x4 __attribute__((ext_vector_type(4)));
typedef float f32x2 __attribute__((ext_vector_type(2)));
typedef short bf16x8 __attribute__((ext_vector_type(8)));

__device__ __forceinline__ float bf2f(unsigned short b) { return __uint_as_float(((unsigned)b) << 16); }
__device__ __forceinline__ float bflo(unsigned w) { return __uint_as_float(w << 16); }
__device__ __forceinline__ float bfhi(unsigned w) { return __uint_as_float(w & 0xffff0000u); }
__device__ __forceinline__ unsigned f2bf(float f) { unsigned u = __float_as_uint(f); return (u + 0x7fffu + ((u >> 16) & 1u)) >> 16; }
typedef __bf16 bf16x2_n_ __attribute__((ext_vector_type(2)));
__device__ __forceinline__ unsigned pk2(float lo, float hi) { const f32x2 x = (f32x2){lo, hi}; const bf16x2_n_ v = __builtin_convertvector(x, bf16x2_n_); return __builtin_bit_cast(unsigned, v); }
__device__ __forceinline__ float wave_sum(float v) {
#pragma unroll
    for (int o = 1; o < 64; o <<= 1) v += __shfl_xor(v, o);
    return v;
}
__device__ __forceinline__ float sigmoidf_(float x) { return __builtin_amdgcn_rcpf(1.0f + __builtin_amdgcn_exp2f(-x * LOG2E)); }

__device__ __forceinline__ float ub0(unsigned w) { return (float)(w & 0xffu); }
__device__ __forceinline__ float ub1(unsigned w) { return (float)((w >> 8) & 0xffu); }
__device__ __forceinline__ float ub2(unsigned w) { return (float)((w >> 16) & 0xffu); }
__device__ __forceinline__ float ub3(unsigned w) { return (float)(w >> 24); }
__device__ __forceinline__ unsigned pk4_u8gate(float a, float b, float c, float d) {
    unsigned p = __builtin_amdgcn_cvt_pk_u8_f32(fmaxf(a * 255.0f, 1.0f), 0, 0u); p = __builtin_amdgcn_cvt_pk_u8_f32(fmaxf(b * 255.0f, 1.0f), 1, p);
    p = __builtin_amdgcn_cvt_pk_u8_f32(fmaxf(c * 255.0f, 1.0f), 2, p); return __builtin_amdgcn_cvt_pk_u8_f32(fmaxf(d * 255.0f, 1.0f), 3, p); }

namespace pg8 {
#define PG8_LAS __attribute__((address_space(3)))
typedef unsigned short bf16_t;
typedef unsigned u32x4 __attribute__((ext_vector_type(4)));
typedef int v4i __attribute__((ext_vector_type(4)));
typedef unsigned v2u_ __attribute__((ext_vector_type(2)));
constexpr int BM = 256, BK = 64, HALF = 128, HTB = HALF * BK * 2, STAGE_BYTES = 8 * HTB, NXCD = 8, WGM = 8;

__host__ __device__ __forceinline__ int lds_byte(int r, int c) { const int st = (r >> 4) * 2 + (c >> 5), rr = r & 15, cc = c & 31, ob = rr * 64 + cc * 2; return st * 1024 + (ob ^ (((ob >> 9) & 1) << 5)); }
__host__ __device__ __forceinline__ void stage_rc(int b, int& R, int& C) { const int st = b / 1024, sb = b % 1024, swz = sb ^ (((sb >> 9) & 1) << 5); R = (st >> 1) * 16 + swz / 64; C = (st & 1) * 32 + (swz % 64) / 2; }
__host__ __device__ __forceinline__ int perm32(int rho) { const int n = rho >> 4, i = rho & 15; return 8 * (i >> 2) + 4 * n + (i & 3); }

struct Unit { int pm, pn, bt, kofs; };

struct StdOrder {
    int nM, nN, nwg, G, c;
    __device__ void init(int M, int N, int G_, int c_) { nM = M / BM; nN = N / BM; nwg = nM * nN; G = G_; c = c_; }
    __device__ bool next(int i, Unit& u) const {
        const long L = (long)i * G + c; if (L >= nwg) return false;
        int wgid = (int)L; { const int q = nwg / NXCD, r = nwg % NXCD, xcd = wgid % NXCD, off = wgid / NXCD; wgid = (xcd < r ? xcd * (q + 1) : r * (q + 1) + (xcd - r) * q) + off; }
        const int nig = WGM * nN, gid = wgid / nig, fm = gid * WGM, gsz = (nM - fm) < WGM ? (nM - fm) : WGM;
        u.pm = fm + ((wgid % nig) % gsz); u.pn = (wgid % nig) / gsz; u.bt = u.pn; u.kofs = 0; return true;
    }
    static constexpr bool GATHER = false;
};
struct StdOrderG : StdOrder {
    static constexpr bool GATHER = true;
    __device__ __forceinline__ int a_row(const Unit& u, int r) const { return u.pm * 256 + r; }
};
struct G1Order {
    const int* idx; int G, c;
    __device__ bool next(int i, Unit& u) const {
        if (G != 256) { const int L = i * G + c; if (L >= 4096) return false; u.pm = L >> 4; u.pn = L & 15; u.bt = (u.pm & 15) * 16 + u.pn; u.kofs = 0; return true; }
        if (i >= 16) return false;
        const int xcd = c & 7, loc = c >> 3, e = 2 * xcd + (i >> 3), r = i & 7, b = (r & 3) * 4 + (loc & 3), j = (r >> 2) * 8 + (loc >> 2);
        u.pm = b * 16 + e; u.pn = j; u.bt = e * 16 + j; u.kofs = 0; return true;
    }
    static constexpr bool GATHER = true;
    __device__ __forceinline__ int a_row(const Unit& u, int r) const { return idx[u.pm * 256 + r]; }
};
struct G2Order {
    int G, c;
    __device__ bool next(int i, Unit& u) const {
        if (G != 256) { const int L = i * G + c; if (L >= 1024) return false; u.pm = L >> 2; u.pn = L & 3; u.bt = (u.pm & 15) * 4 + u.pn; u.kofs = 0; return true; }
        if (i >= 4) return false;
        const int xcd = c & 7, loc = c >> 3, e = 2 * xcd + (i >> 1), b = (i & 1) * 8 + (loc & 7), pn = loc >> 3;
        u.pm = b * 16 + e; u.pn = pn; u.bt = e * 4 + pn; u.kofs = 0; return true;
    }
    static constexpr bool GATHER = true;
    __device__ __forceinline__ int a_row(const Unit& u, int r) const { return u.pm * 256 + r; }
};

typedef float f32x2_t_ __attribute__((ext_vector_type(2))); typedef __bf16 bf16x2_t_ __attribute__((ext_vector_type(2)));
__device__ __forceinline__ unsigned cvt_pk_bf16(float lo, float hi) { const f32x2_t_ x = (f32x2_t_){lo, hi}; const bf16x2_t_ b = __builtin_convertvector(x, bf16x2_t_); return __builtin_bit_cast(unsigned, b); }

typedef f32x4 Acc[2][2][4][2];

struct EpiInproj {
    static constexpr bool PERM = true, MIDWAY = false, F8 = false;
    bf16_t *zqk, *zmv, *zmo, *zdq, *zdk, *zdv, *zg; const float* rs;
    __device__ __forceinline__ void operator()(const Acc& acc, const Unit& u, int wr, int wc, int fr, int fq) const {
        const int pn = u.pn; bf16_t* base; int ldc, colt, act = 0;
        if (pn < 4) { base = zqk; ldc = 1024; colt = pn * 256; }
        else if (pn < 6) { base = zmv; ldc = 512; colt = (pn - 4) * 256; }
        else if (pn < 8) { base = zdq; ldc = 512; colt = (pn - 6) * 256; act = 2; }
        else if (pn < 10) { base = zdk; ldc = 512; colt = (pn - 8) * 256; }
        else { base = zdv; ldc = 512; colt = (pn - 10) * 256; }
        const int row0 = u.pm * BM + wr * 64 + fr, col0 = colt + wc * 32 + 8 * fq;
        float rsv[2][4];
#pragma unroll
        for (int ai = 0; ai < 2; ++ai)
#pragma unroll
            for (int m = 0; m < 4; ++m) rsv[ai][m] = rs[row0 + ai * HALF + m * 16];
#pragma unroll
        for (int ai = 0; ai < 2; ++ai)
#pragma unroll
            for (int m = 0; m < 4; ++m) { const int row = row0 + ai * HALF + m * 16; bf16_t* rowp = base + (size_t)row * ldc + col0; const float rsc = rsv[ai][m] * ((act == 2) ? 0.125f * LOG2E : 1.0f);
#pragma unroll
                for (int bj = 0; bj < 2; ++bj) { f32x4 v0 = acc[ai][bj][m][0] * rsc, v1 = acc[ai][bj][m][1] * rsc;
                    if (act == 1) {
#pragma unroll
                        for (int j = 0; j < 4; ++j) { v0[j] = sigmoidf_(v0[j]); v1[j] = sigmoidf_(v1[j]); } }
                    u32x4 w; w.x = cvt_pk_bf16(v0[0], v0[1]); w.y = cvt_pk_bf16(v0[2], v0[3]); w.z = cvt_pk_bf16(v1[0], v1[1]); w.w = cvt_pk_bf16(v1[2], v1[3]);
                    *(u32x4*)(rowp + bj * HALF) = w; } }
    }
};
#define RCPG(x) __builtin_amdgcn_rcpf(fmaxf((x), 1e-30f))
struct UpOrder : StdOrder {
    __device__ bool next(int i, Unit& u) const { if (!StdOrder::next(i >> 1, u)) return false; u.kofs = (i & 1) * 1024; return true; }
};
struct EpiUp {
    static constexpr bool PERM = true, MIDWAY = true, F8 = false;
    bf16_t* mix; const unsigned char* zg;
    __device__ __forceinline__ bool midway(Acc& acc, const Unit& u, int wr, int wc, int fr, int fq) const {
        if (u.kofs != 0) return false;
        const int row0 = u.pm * BM + wr * 64 + fr, col0 = u.pn * BM + wc * 32 + 8 * fq;
#pragma unroll
        for (int ai = 0; ai < 2; ++ai) {
            v2u_ gaq[4][2], gbq[4][2];
#pragma unroll
            for (int m = 0; m < 4; ++m)
#pragma unroll
                for (int bj = 0; bj < 2; ++bj) { const unsigned char* gp = zg + (size_t)(row0 + ai * HALF + m * 16) * 2048 + col0 + bj * HALF; gaq[m][bj] = *(const v2u_*)gp; gbq[m][bj] = *(const v2u_*)(gp + 1024); }
#pragma unroll
            for (int m = 0; m < 4; ++m) {
#pragma unroll
                for (int bj = 0; bj < 2; ++bj) {
                    const v2u_ ga = gaq[m][bj], gb = gbq[m][bj];
                    f32x4& v0 = acc[ai][bj][m][0]; f32x4& v1 = acc[ai][bj][m][1];
                    v0[0] *= ub0(ga.x) * __builtin_amdgcn_rcpf(ub0(gb.x)); v0[1] *= ub1(ga.x) * __builtin_amdgcn_rcpf(ub1(gb.x)); v0[2] *= ub2(ga.x) * __builtin_amdgcn_rcpf(ub2(gb.x)); v0[3] *= ub3(ga.x) * __builtin_amdgcn_rcpf(ub3(gb.x));
                    v1[0] *= ub0(ga.y) * __builtin_amdgcn_rcpf(ub0(gb.y)); v1[1] *= ub1(ga.y) * __builtin_amdgcn_rcpf(ub1(gb.y)); v1[2] *= ub2(ga.y) * __builtin_amdgcn_rcpf(ub2(gb.y)); v1[3] *= ub3(ga.y) * __builtin_amdgcn_rcpf(ub3(gb.y)); } } }
        return true;
    }
    __device__ __forceinline__ void operator()(const Acc& acc, const Unit& u, int wr, int wc, int fr, int fq) const {
        const int row0 = u.pm * BM + wr * 64 + fr, col0 = u.pn * BM + wc * 32 + 8 * fq;
        constexpr float Q = 1.0f / 255.0f;
        v2u_ gq[2][4][2];
#pragma unroll
        for (int ai = 0; ai < 2; ++ai)
#pragma unroll
            for (int m = 0; m < 4; ++m)
#pragma unroll
                for (int bj = 0; bj < 2; ++bj) gq[ai][m][bj] = *(const v2u_*)(zg + (size_t)(row0 + ai * HALF + m * 16) * 2048 + 1024 + col0 + bj * HALF);
#pragma unroll
        for (int ai = 0; ai < 2; ++ai)
#pragma unroll
            for (int m = 0; m < 4; ++m) { const size_t row = (size_t)(row0 + ai * HALF + m * 16);
#pragma unroll
                for (int bj = 0; bj < 2; ++bj) { const int col = col0 + bj * HALF;
                    const v2u_ g = gq[ai][m][bj];
                    f32x4 v0 = acc[ai][bj][m][0], v1 = acc[ai][bj][m][1];
                    v0[0] *= ub0(g.x) * Q; v0[1] *= ub1(g.x) * Q; v0[2] *= ub2(g.x) * Q; v0[3] *= ub3(g.x) * Q;
                    v1[0] *= ub0(g.y) * Q; v1[1] *= ub1(g.y) * Q; v1[2] *= ub2(g.y) * Q; v1[3] *= ub3(g.y) * Q;
                    u32x4 w; w.x = cvt_pk_bf16(v0[0], v0[1]); w.y = cvt_pk_bf16(v0[2], v0[3]); w.z = cvt_pk_bf16(v1[0], v1[1]); w.w = cvt_pk_bf16(v1[2], v1[3]);
                    *(u32x4*)(mix + row * 1024 + col) = w; } }
    }
};
struct EpiResid {
    static constexpr bool PERM = true, MIDWAY = false, F8 = false;
    bf16_t* x;
    __device__ __forceinline__ void operator()(const Acc& acc, const Unit& u, int wr, int wc, int fr, int fq) const {
        const int row0 = u.pm * BM + wr * 64 + fr, col0 = u.pn * BM + wc * 32 + 8 * fq;
        u32x4 ov[2][4][2];
#pragma unroll
        for (int ai = 0; ai < 2; ++ai)
#pragma unroll
            for (int m = 0; m < 4; ++m)
#pragma unroll
                for (int bj = 0; bj < 2; ++bj) ov[ai][m][bj] = *(const u32x4*)(x + (size_t)(row0 + ai * HALF + m * 16) * 1024 + col0 + bj * HALF);
#pragma unroll
        for (int ai = 0; ai < 2; ++ai) {
#pragma unroll
            for (int m = 0; m < 4; ++m) { bf16_t* rowp = x + (size_t)(row0 + ai * HALF + m * 16) * 1024 + col0;
#pragma unroll
                for (int bj = 0; bj < 2; ++bj) { const u32x4 o = ov[ai][m][bj]; const f32x4 a0 = acc[ai][bj][m][0], a1 = acc[ai][bj][m][1];
                    u32x4 w; w.x = cvt_pk_bf16(a0[0] + bflo(o.x), a0[1] + bfhi(o.x)); w.y = cvt_pk_bf16(a0[2] + bflo(o.y), a0[3] + bfhi(o.y));
                    w.z = cvt_pk_bf16(a1[0] + bflo(o.z), a1[1] + bfhi(o.z)); w.w = cvt_pk_bf16(a1[2] + bflo(o.w), a1[3] + bfhi(o.w));
                    *(u32x4*)(rowp + bj * HALF) = w; } } }
    }
};
constexpr int W8_LOG2 = 5, H8_LOG2 = 2;
constexpr float W8_SCALE = 32.0f, H8_SCALE = 4.0f, Y8_SCALE = 64.0f;
__device__ __forceinline__ float clamp_f8(float x) { float r; asm("v_max_f32 %0, 0xc3e00000, %1\n\tv_min_f32 %0, 0x43e00000, %0" : "=v"(r) : "v"(x)); return r; }
__device__ __forceinline__ unsigned pk4_fp8(float a, float b, float c, float d) {
    int p = __builtin_amdgcn_cvt_pk_fp8_f32(clamp_f8(a), clamp_f8(b), 0, false); p = __builtin_amdgcn_cvt_pk_fp8_f32(clamp_f8(c), clamp_f8(d), p, true); return (unsigned)p; }
struct EpiG1 {
    static constexpr bool PERM = true, MIDWAY = false, F8 = true;
    unsigned char* hid;
    __device__ __forceinline__ void operator()(const Acc& acc, const Unit& u, int wr, int wc, int fr, int fq) const {
        const int row0 = u.pm * BM + wr * 64 + fr, col0 = u.pn * 128 + wc * 32 + 8 * fq;
        constexpr float SG = 1.0f / W8_SCALE;
#pragma unroll
        for (int ai = 0; ai < 2; ++ai)
#pragma unroll
            for (int m = 0; m < 4; ++m) { unsigned char* rowp = hid + (size_t)(row0 + ai * HALF + m * 16) * DFF + col0;
                f32x4 v0, v1;
#pragma unroll
                for (int j = 0; j < 4; ++j) { const float g0 = acc[ai][0][m][0][j], g1 = acc[ai][0][m][1][j];
                    v0[j] = g0 * sigmoidf_(g0 * SG) * __builtin_amdgcn_ldexpf(acc[ai][1][m][0][j], H8_LOG2 - 2 * W8_LOG2); v1[j] = g1 * sigmoidf_(g1 * SG) * __builtin_amdgcn_ldexpf(acc[ai][1][m][1][j], H8_LOG2 - 2 * W8_LOG2); }
                v2u w; w.x = pk4_fp8(v0[0], v0[1], v0[2], v0[3]); w.y = pk4_fp8(v1[0], v1[1], v1[2], v1[3]);
                *(v2u*)rowp = w; }
    }
};
struct EpiGate8 {
    static constexpr bool PERM = true, MIDWAY = false, F8 = true;
    unsigned char *zmo, *zg; const float* rs;
    __device__ __forceinline__ void operator()(const Acc& acc, const Unit& u, int wr, int wc, int fr, int fq) const {
        unsigned char* base; int ldc, colt;
        if (u.pn < 2) { base = zmo; ldc = 512; colt = u.pn * 256; } else { base = zg; ldc = 2048; colt = (u.pn - 2) * 256; }
        const int row0 = u.pm * BM + wr * 64 + fr, col0 = colt + wc * 32 + 8 * fq;
        constexpr float SG = 1.0f / W8_SCALE;
        float rsv[2][4];
#pragma unroll
        for (int ai = 0; ai < 2; ++ai)
#pragma unroll
            for (int m = 0; m < 4; ++m) rsv[ai][m] = rs[row0 + ai * HALF + m * 16];
#pragma unroll
        for (int ai = 0; ai < 2; ++ai)
#pragma unroll
            for (int m = 0; m < 4; ++m) { const int row = row0 + ai * HALF + m * 16; unsigned char* rowp = base + (size_t)row * ldc + col0; const float rsc = rsv[ai][m] * SG;
#pragma unroll
                for (int bj = 0; bj < 2; ++bj) { f32x4 v0 = acc[ai][bj][m][0], v1 = acc[ai][bj][m][1];
#pragma unroll
                    for (int j = 0; j < 4; ++j) { v0[j] = sigmoidf_(v0[j] * rsc); v1[j] = sigmoidf_(v1[j] * rsc); }
                    v2u_ w; w.x = pk4_u8gate(v0[0], v0[1], v0[2], v0[3]); w.y = pk4_u8gate(v1[0], v1[1], v1[2], v1[3]);
                    *(v2u_*)(rowp + bj * HALF) = w; } }
    }
};
struct EpiG2 {
    static constexpr bool PERM = true, MIDWAY = false, F8 = true;
    unsigned char* ye; const float* gatev;
    __device__ __forceinline__ void operator()(const Acc& acc, const Unit& u, int wr, int wc, int fr, int fq) const {
        const int row0 = u.pm * BM + wr * 64 + fr, col0 = u.pn * BM + wc * 32 + 8 * fq;
        float gv[2][4];
#pragma unroll
        for (int ai = 0; ai < 2; ++ai)
#pragma unroll
            for (int m = 0; m < 4; ++m) gv[ai][m] = gatev[row0 + ai * HALF + m * 16];
#pragma unroll
        for (int ai = 0; ai < 2; ++ai)
#pragma unroll
            for (int m = 0; m < 4; ++m) { const int row = row0 + ai * HALF + m * 16; const float g = gv[ai][m] * (Y8_SCALE / (W8_SCALE * H8_SCALE)); unsigned char* rowp = ye + (size_t)row * 1024 + col0;
#pragma unroll
                for (int bj = 0; bj < 2; ++bj) { const f32x4 v0 = acc[ai][bj][m][0] * g, v1 = acc[ai][bj][m][1] * g;
                    v2u w; w.x = pk4_fp8(v0[0], v0[1], v0[2], v0[3]); w.y = pk4_fp8(v1[0], v1[1], v1[2], v1[3]);
                    *(v2u*)(rowp + bj * HALF) = w; } }
    }
};

template <class Epi, class Sched>
__device__ __forceinline__ void gemm_phase(PG8_LAS unsigned char* lds, const bf16_t* Aptr, const bf16_t* Btptr, const int K, const Sched& S, const Epi& E, const int wv, const int LD = 0) {
    const int ld = LD ? LD : K;
    constexpr bool GATHER = Sched::GATHER;
    int tid_; asm volatile("v_mbcnt_lo_u32_b32 %0, -1, 0\n\tv_mbcnt_hi_u32_b32 %0, -1, %0" : "=v"(tid_)); tid_ += wv * 64;
    const int tid = tid_, wid = __builtin_amdgcn_readfirstlane(tid >> 6), lane = tid & 63, wr = wid >> 2, wc = wid & 3, fr = lane & 15, fq = lane >> 4;
    const int nt = K / BK;
    unsigned voffA[2], voffB[2];
#pragma unroll
    for (int i = 0; i < 2; ++i) { int R, C; stage_rc(tid * 16 + i * 8192, R, C); const int Rb = Epi::PERM ? ((R & ~31) + perm32(R & 31)) : R;
        voffA[i] = (unsigned)(R * ld + C) * 2u; voffB[i] = (unsigned)(Rb * ld + C) * 2u; }
    const size_t kstep = (size_t)(BK * 2);
    const size_t hstep = (size_t)HALF * ld * 2;
    const size_t tstep = 2 * hstep;
    const unsigned ldsw = (unsigned)wid * 1024u;
    const int aoff = lds_byte(wr * 64 + fr, fq * 8), boff = lds_byte(wc * 32 + fr, fq * 8);
#define PG8_SA(b, h) (((b) * 2 + (h)) * HTB)
#define PG8_SB(b, h) ((4 + (b) * 2 + (h)) * HTB)
#define PG8_STAGE(bufoff, gbase, voff) do { _Pragma("unroll") for (int _i = 0; _i < 2; ++_i) \
        __builtin_amdgcn_global_load_lds((const unsigned*)((const char*)(gbase) + (voff)[_i]), (PG8_LAS unsigned*)(lds + (bufoff) + ldsw + _i * 8192), 16, 0, 0); } while (0)
#define PG8_STAGE_A(bufoff, gbase, h) do { if constexpr (GATHER) { PG8_STAGE(bufoff, gbase, vg[h]); } else { PG8_STAGE(bufoff, (gbase) + (h) * hstep, voffA); } } while (0)
#define PG8_LDA(dst, b, h) do { _Pragma("unroll") for (int m = 0; m < 4; ++m) _Pragma("unroll") for (int k = 0; k < 2; ++k) dst[m][k] = *(const PG8_LAS bf16x8*)(lds + PG8_SA(b, h) + aoff + m * 2048 + k * 1024); } while (0)
#define PG8_LDB(dst, b, h) do { _Pragma("unroll") for (int n = 0; n < 2; ++n) _Pragma("unroll") for (int k = 0; k < 2; ++k) dst[n][k] = *(const PG8_LAS bf16x8*)(lds + PG8_SB(b, h) + boff + n * 2048 + k * 1024); } while (0)
#define PG8_CAT(x, y) __builtin_shufflevector((v4i)(x), (v4i)(y), 0, 1, 2, 3, 4, 5, 6, 7)
#define PG8_MMA(ai, bj, At, Bt) do { __builtin_amdgcn_s_setprio(1); if constexpr (Epi::F8) { _Pragma("unroll") for (int m = 0; m < 4; ++m) _Pragma("unroll") for (int n = 0; n < 2; ++n) \
        acc[ai][bj][m][n] = __builtin_amdgcn_mfma_scale_f32_16x16x128_f8f6f4(PG8_CAT(Bt[n][0], Bt[n][1]), PG8_CAT(At[m][0], At[m][1]), acc[ai][bj][m][n], 0, 0, 0, sc1, 0, sc1); } \
    else { _Pragma("unroll") for (int m = 0; m < 4; ++m) _Pragma("unroll") for (int n = 0; n < 2; ++n) _Pragma("unroll") for (int k = 0; k < 2; ++k) \
        acc[ai][bj][m][n] = __builtin_amdgcn_mfma_f32_16x16x32_bf16(Bt[n][k], At[m][k], acc[ai][bj][m][n], 0, 0, 0); } __builtin_amdgcn_s_setprio(0); } while (0)
#define PG8_WAIT_V(n) asm volatile("s_waitcnt vmcnt(" #n ")" ::: "memory")
#define PG8_WAIT_L(n) asm volatile("s_waitcnt lgkmcnt(" #n ")" ::: "memory")
#define PG8_BAR __builtin_amdgcn_s_barrier()
#define PG8_SCHED __builtin_amdgcn_sched_barrier(0)
#define PG8_GROWS_TO(dst, u) do { _Pragma("unroll") for (int _h = 0; _h < 2; ++_h) _Pragma("unroll") for (int _i = 0; _i < 2; ++_i) { \
        int _R, _C; stage_rc(tid * 16 + _i * 8192, _R, _C); dst[_h][_i] = (unsigned)S.a_row(u, _h * HALF + _R); } } while (0)
#define PG8_GOFFS_FROM(src) do { _Pragma("unroll") for (int _h = 0; _h < 2; ++_h) _Pragma("unroll") for (int _i = 0; _i < 2; ++_i) { \
        int _R, _C; stage_rc(tid * 16 + _i * 8192, _R, _C); vg[_h][_i] = (src[_h][_i] * (unsigned)ld + (unsigned)_C) * 2u; } } while (0)
#define PG8_GOFFS(u) do { PG8_GROWS_TO(vgn, u); PG8_GOFFS_FROM(vgn); } while (0)
    Unit cur, nxt; int ui = 0;
    if (!S.next(0, cur)) return;
    int sc1 = 0x7f7f7f7f; asm volatile("" : "+v"(sc1));
    float zf = 0.f; asm volatile("" : "+v"(zf));
    f32x4 acc[2][2][4][2];
#pragma unroll
    for (int a = 0; a < 2; ++a)
#pragma unroll
        for (int b = 0; b < 2; ++b)
#pragma unroll
            for (int m = 0; m < 4; ++m)
#pragma unroll
                for (int n = 0; n < 2; ++n) acc[a][b][m][n] = (f32x4){zf, zf, zf, zf};
    bf16x8 At[4][2], B0[2][2], B1[2][2];
    unsigned vg[2][2] = {{0u, 0u}, {0u, 0u}}, vgn[2][2] = {{0u, 0u}, {0u, 0u}};
    const char* cA = (const char*)Aptr + cur.kofs; const char* cB = (const char*)Btptr + (size_t)cur.bt * tstep + cur.kofs;
    if constexpr (GATHER) { PG8_GOFFS(cur); } else { cA += (size_t)cur.pm * tstep; }
    PG8_STAGE(PG8_SB(0, 0), cB, voffB); PG8_STAGE(PG8_SB(0, 1), cB + hstep, voffB); PG8_STAGE_A(PG8_SA(0, 0), cA, 0); PG8_STAGE_A(PG8_SA(0, 1), cA, 1);
    if (wr == 1) PG8_BAR;
    PG8_WAIT_V(2); PG8_BAR;
    PG8_STAGE(PG8_SB(1, 0), cB + kstep, voffB); PG8_STAGE_A(PG8_SA(1, 0), cA + kstep, 0); PG8_STAGE(PG8_SB(1, 1), cB + hstep + kstep, voffB);
    PG8_WAIT_V(6); PG8_BAR;
    for (;;) {
        const bool has_next = S.next(ui + 1, nxt);
        const char* nA = cA; if constexpr (!GATHER) { if (has_next) nA = (const char*)Aptr + (size_t)nxt.pm * tstep + nxt.kofs; }
        const char* nB = has_next ? (const char*)Btptr + (size_t)nxt.bt * tstep + nxt.kofs : cB;
        if constexpr (GATHER) { if (has_next) { PG8_GROWS_TO(vgn, nxt); } }
        for (int t = 0; t < nt; t += 2) {
            const bool last = (t == nt - 2);
            const char* a1 = cA + (size_t)(t + 1) * kstep;
            const char* a2 = last ? nA : cA + (size_t)(t + 2) * kstep; const char* b2 = last ? nB : cB + (size_t)(t + 2) * kstep;
            const char* a3 = a2 + kstep; const char* b3 = b2 + kstep;
            PG8_LDB(B0, 0, 0); PG8_LDB(B1, 0, 1); PG8_SCHED; PG8_LDA(At, 0, 0); PG8_STAGE_A(PG8_SA(1, 1), a1, 1);
            if constexpr (GATHER) {
                if (last && has_next) { asm volatile("" : "+v"(vgn[0][0]), "+v"(vgn[0][1]), "+v"(vgn[1][0]), "+v"(vgn[1][1])); PG8_GOFFS_FROM(vgn); } }
            PG8_WAIT_V(8); PG8_WAIT_L(0); PG8_BAR; PG8_MMA(0, 0, At, B0); PG8_MMA(0, 1, At, B1); PG8_BAR; PG8_SCHED;
            PG8_LDA(At, 0, 1); PG8_STAGE(PG8_SB(0, 0), b2, voffB); PG8_STAGE(PG8_SB(0, 1), b2 + hstep, voffB); PG8_STAGE_A(PG8_SA(0, 0), a2, 0);
            PG8_WAIT_V(8); PG8_WAIT_L(0); PG8_BAR; PG8_MMA(1, 0, At, B0); PG8_MMA(1, 1, At, B1); PG8_BAR; PG8_SCHED;
            PG8_LDB(B0, 1, 0); PG8_LDB(B1, 1, 1); PG8_SCHED; PG8_LDA(At, 1, 0); PG8_STAGE_A(PG8_SA(0, 1), a2, 1);
            PG8_WAIT_V(8); PG8_WAIT_L(0); PG8_BAR; PG8_MMA(0, 0, At, B0); PG8_MMA(0, 1, At, B1); PG8_BAR; PG8_SCHED;
            PG8_LDA(At, 1, 1); PG8_STAGE(PG8_SB(1, 0), b3, voffB); PG8_STAGE(PG8_SB(1, 1), b3 + hstep, voffB); PG8_STAGE_A(PG8_SA(1, 0), a3, 0);
            PG8_WAIT_V(8); PG8_WAIT_L(0); PG8_BAR; PG8_MMA(1, 0, At, B0); PG8_MMA(1, 1, At, B1); PG8_BAR; PG8_SCHED;
        }
        if (wr == 0) PG8_BAR;
        bool keep = false;
        if constexpr (Epi::MIDWAY) keep = E.midway(acc, cur, wr, wc, fr, fq);
        if (!keep) E(acc, cur, wr, wc, fr, fq);
        if (!has_next) break;
        if (!keep) {
#pragma unroll
        for (int a = 0; a < 2; ++a)
#pragma unroll
            for (int b = 0; b < 2; ++b)
#pragma unroll
                for (int m = 0; m < 4; ++m)
#pragma unroll
                    for (int n = 0; n < 2; ++n) acc[a][b][m][n] = (f32x4){zf, zf, zf, zf};
        }
        cur = nxt; cA = nA; cB = nB; ++ui;
        if (wr == 1) PG8_BAR;
    }
    PG8_WAIT_V(0);
    PG8_BAR;
#undef PG8_SA
#undef PG8_SB
#undef PG8_STAGE
#undef PG8_STAGE_A
#undef PG8_LDA
#undef PG8_LDB
#undef PG8_MMA
#undef PG8_CAT
#undef PG8_WAIT_V
#undef PG8_WAIT_L
#undef PG8_BAR
#undef PG8_SCHED
#undef PG8_GOFFS
#undef PG8_GROWS_TO
#undef PG8_GOFFS_FROM
}
}

constexpr size_t MiB = 1u << 20;
constexpr size_t WS_CTL = 0, CTL_ZERO_BYTES = 1 * MiB;
constexpr size_t WS_MG = 1 * MiB, WS_AFF = 3 * MiB, WS_INV = 5 * MiB, WS_IDX = 7 * MiB, WS_GATEV = 7 * MiB + 256 * 1024, WS_RSTD1 = 7 * MiB + 512 * 1024;
constexpr size_t WS_WIN = 8 * MiB, WS_WA = 19 * MiB, WS_WB = 20 * MiB, WS_WO = 21 * MiB, WS_WGU = 24 * MiB, WS_WD = 152 * MiB;
constexpr size_t WS_WGU_L1 = 88 * MiB, WS_WD_L1 = 184 * MiB, WS_WA_L1 = 888 * MiB, WS_WO_L1 = 890 * MiB;
constexpr size_t WS_XB = 216 * MiB;
constexpr size_t WS_WIN8 = WS_WIN + (size_t)3584 * 2048;
constexpr size_t WS_ZQK = 280 * MiB, WS_ZMV = 344 * MiB, WS_ZMO = 376 * MiB, WS_ZDQ = 408 * MiB, WS_ZDK = 440 * MiB, WS_ZDV = 472 * MiB, WS_ZG = 504 * MiB;
constexpr size_t WS_HM = 632 * MiB, WS_HD = 664 * MiB, WS_MIX = 696 * MiB, WS_HF = 760 * MiB, WS_HB = 824 * MiB, WS_END = 888 * MiB;
constexpr size_t WS_XR = 892 * MiB, WS_END2 = 956 * MiB;
constexpr size_t WS_HID = 280 * MiB, WS_YE = 536 * MiB;
constexpr int CW_BAR = 4096;

constexpr int RING_BYTES = 131072;
constexpr int LDSCTL_OFF = RING_BYTES, MISC_OFF = LDSCTL_OFF + 320;
constexpr int LDS_BYTES = 147456;

#define XB_TMO      128
#define XB_XCNT(j)  (256  + 64 * (j))
#define XB_XSUB(j)  (1280 + 64 * (j))
#define XB_XGEN(j)  (2304 + 64 * (j))
#define XB_TOP      3328
#define XB_TOPGEN   3392
#define XCD_BAR_WORDS 3456
#define XB_SPIN_CAP (1u << 22)
__device__ __forceinline__ unsigned xb_ld(unsigned* p)              { return __hip_atomic_load(p, __ATOMIC_RELAXED, __HIP_MEMORY_SCOPE_AGENT); }
__device__ __forceinline__ unsigned xb_add(unsigned* p, unsigned v) { return __hip_atomic_fetch_add(p, v, __ATOMIC_RELAXED, __HIP_MEMORY_SCOPE_AGENT); }
__device__ __forceinline__ unsigned xb_xcc_id() { return (unsigned)__builtin_amdgcn_s_getreg((3 << 11) | 20) & 0xFu; }
#define XB_SPIN(cond, bar) do { unsigned _sp = 0; while (cond) { __builtin_amdgcn_s_sleep(1); \
    if ((++_sp & 255u) == 0u) { if (xb_ld(&(bar)[XB_TMO])) break; if (_sp > XB_SPIN_CAP) { atomicAdd(&(bar)[XB_TMO], 1u); break; } } } } while (0)
struct XcdBarrier { unsigned* bar; unsigned x; volatile LAS unsigned* st; };
__device__ __forceinline__ XcdBarrier xcd_barrier_post(unsigned* bar, volatile LAS unsigned* st) {
    XcdBarrier b; b.bar = bar; b.x = xb_xcc_id(); b.st = st;
    if (threadIdx.x == 0) (void)xb_add(&bar[XB_XCNT(b.x)], 1u);
    return b;
}
__device__ __forceinline__ void xcd_barrier_complete(unsigned* bar, unsigned x, unsigned& nloc, unsigned& nx) {
    const unsigned G = gridDim.x * gridDim.y * gridDim.z;
    unsigned sum, cnt, mine, sp = 0u;
    for (;;) {
        sum = 0u; cnt = 0u; mine = 0u;
        unsigned cj[16];
#pragma unroll
        for (unsigned j = 0; j < 16; ++j) cj[j] = *(volatile unsigned*)&bar[XB_XCNT(j)];
#pragma unroll
        for (unsigned j = 0; j < 16; ++j) { const unsigned c = cj[j]; sum += c; cnt += (c > 0u) ? 1u : 0u; mine = (j == x) ? c : mine; }
        if (sum == G) break;
        __builtin_amdgcn_s_sleep(1);
        if ((++sp & 255u) == 0u) { if (xb_ld(&bar[XB_TMO])) break; if (sp > XB_SPIN_CAP) { atomicAdd(&bar[XB_TMO], 1u); break; } }
    }
    nloc = mine > 0u ? mine : 1u; nx = cnt > 0u ? cnt : 1u;
}
__device__ __forceinline__ void xcd_barrier(const XcdBarrier& b) {
    asm volatile("s_waitcnt vmcnt(0)" ::: "memory");
    __syncthreads();
    if (threadIdx.x == 0) {
        unsigned* bar = b.bar;
        __builtin_amdgcn_s_waitcnt(0);
        unsigned nloc = b.st[0], nx = b.st[1];
        if (nloc == 0u) { xcd_barrier_complete(bar, b.x, nloc, nx); b.st[0] = nloc; b.st[1] = nx; }
        const unsigned old = xb_add(&bar[XB_XSUB(b.x)], 1u);
        const unsigned gen = old / nloc;
        if (old + 1u == (gen + 1u) * nloc) {
            __builtin_amdgcn_fence(__ATOMIC_RELEASE, "agent");
            asm volatile("s_waitcnt vmcnt(0)" ::: "memory");
            const unsigned og = xb_add(&bar[XB_TOP], 1u);
            const unsigned tg = og / nx;
            if (og + 1u == (tg + 1u) * nx) xb_add(&bar[XB_TOPGEN], 1u);
            else XB_SPIN(xb_ld(&bar[XB_TOPGEN]) == tg, bar);
            __builtin_amdgcn_fence(__ATOMIC_ACQUIRE, "agent");
            asm volatile("s_waitcnt vmcnt(0)" ::: "memory");
        } else {
            XB_SPIN(xb_ld(&bar[XB_TOPGEN]) == gen, bar);
            __builtin_amdgcn_fence(__ATOMIC_ACQUIRE, "agent");
            asm volatile("s_waitcnt vmcnt(0)" ::: "memory");
        }
    }
    __syncthreads();
}

struct Args { const float* in[18]; float* out; unsigned char* ws; int ph_lo, ph_hi; };
enum { I_X = 0, I_NMG, I_WIN, I_BMG, I_CW, I_CB, I_MNG, I_LAM, I_DNG, I_WUA, I_WUB, I_WOUT, I_NFG, I_WR, I_WGE, I_WUE, I_WDE, I_NF };

struct Frame {
    LAS unsigned char* lds;
    int G, bx, wv;
    const float* in[18];
    float* X;
    unsigned char* ws;
};
#define WSP(type, off) ((type*)(F.ws + (off)))
__device__ __forceinline__ int lane_id_volatile() { int l; asm volatile("v_mbcnt_lo_u32_b32 %0, -1, 0\n\tv_mbcnt_hi_u32_b32 %0, -1, %0" : "=v"(l)); return l; }
#define PH_IDS int tid = F.wv * 64 + lane_id_volatile(); const int lane = tid & 63; const int wave = __builtin_amdgcn_readfirstlane(tid >> 6); (void)lane; (void)wave

struct CvItem { const float* W; bf16* WT; int pitch, Kdst, k0, f8; const float* gk; };
__device__ __forceinline__ void cv_load(const CvItem& c, int lane, f32x4 (&v)[16]) {
    const int rsh = c.f8 ? 3 : 4, lr = lane >> rsh, lc = (lane & ((1 << rsh) - 1)) * 4, rpi = 64 >> rsh;
    const float* src = c.W + (size_t)(c.k0 + lr) * c.pitch + lc; const size_t step = (size_t)rpi * c.pitch;
#pragma unroll
    for (int i = 0; i < 16; ++i) v[i] = __builtin_nontemporal_load((const f32x4*)(src + i * step));
}
__device__ __forceinline__ void cv_store(const CvItem& c, int lane, const f32x4 (&v)[16], LAS float* scr) {
    if (c.f8) {
#pragma unroll
        for (int i = 0; i < 16; ++i) { const int k = 8 * i + (lane >> 3), n = (lane & 7) * 4; *(LAS f32x4*)(scr + k * 32 + (n ^ (((k >> 4) & 7) << 2))) = v[i]; }
        asm volatile("s_waitcnt lgkmcnt(0)" ::: "memory");
        float gs[16];
        if (c.gk) {
#pragma unroll
            for (int j4 = 0; j4 < 4; ++j4) { const f32x4 g4 = *(const f32x4*)(c.gk + c.k0 + 16 * (lane & 7) + 4 * j4); gs[4 * j4] = g4.x; gs[4 * j4 + 1] = g4.y; gs[4 * j4 + 2] = g4.z; gs[4 * j4 + 3] = g4.w; } }
        else {
#pragma unroll
            for (int j = 0; j < 16; ++j) gs[j] = 1.0f; }
#pragma unroll
        for (int it = 0; it < 4; ++it) { const int n = it * 8 + (lane >> 3), kc = lane & 7; const LAS float* sp = scr + (16 * kc) * 32 + (n ^ (kc << 2));
            float f[16];
#pragma unroll
            for (int j = 0; j < 16; ++j) f[j] = __builtin_amdgcn_ldexpf(sp[j * 32] * gs[j], pg8::W8_LOG2);
            v4u o; o.x = pg8::pk4_fp8(f[0], f[1], f[2], f[3]); o.y = pg8::pk4_fp8(f[4], f[5], f[6], f[7]); o.z = pg8::pk4_fp8(f[8], f[9], f[10], f[11]); o.w = pg8::pk4_fp8(f[12], f[13], f[14], f[15]);
            *(v4u*)((unsigned char*)c.WT + (size_t)n * c.Kdst + c.k0 + 16 * kc) = o; }
        asm volatile("s_waitcnt lgkmcnt(0)" ::: "memory");
        return;
    }
#pragma unroll
    for (int i = 0; i < 16; ++i) { const int k = 4 * i + (lane >> 4), n = (lane & 15) * 4; *(LAS f32x4*)(scr + k * 64 + (n ^ (((k >> 3) & 7) << 2))) = v[i]; }
    asm volatile("s_waitcnt lgkmcnt(0)" ::: "memory");
    float gb[8];
    if (c.gk) { const f32x4 g0 = *(const f32x4*)(c.gk + c.k0 + 8 * (lane & 7)), g1 = *(const f32x4*)(c.gk + c.k0 + 8 * (lane & 7) + 4); gb[0] = g0.x; gb[1] = g0.y; gb[2] = g0.z; gb[3] = g0.w; gb[4] = g1.x; gb[5] = g1.y; gb[6] = g1.z; gb[7] = g1.w; }
    else {
#pragma unroll
        for (int j = 0; j < 8; ++j) gb[j] = 1.0f; }
#pragma unroll
    for (int it = 0; it < 8; ++it) { const int n = it * 8 + (lane >> 3), kc = lane & 7; const LAS float* sp = scr + (8 * kc) * 64 + (n ^ (kc << 2));
        v4u o; o.x = pk2(sp[0 * 64] * gb[0], sp[1 * 64] * gb[1]); o.y = pk2(sp[2 * 64] * gb[2], sp[3 * 64] * gb[3]); o.z = pk2(sp[4 * 64] * gb[4], sp[5 * 64] * gb[5]); o.w = pk2(sp[6 * 64] * gb[6], sp[7 * 64] * gb[7]);
        *(v4u*)(c.WT + (size_t)n * c.Kdst + c.k0 + 8 * kc) = o; }
    asm volatile("s_waitcnt lgkmcnt(0)" ::: "memory");
}
__device__ __forceinline__ CvItem cv_decode(Frame& F, int l, int it) {
    constexpr int J0 = 16 * 32, J1 = 16 * 56, J2 = 8 * 16, J3 = 8 * 16, J4 = 16 * 16, J5 = 16 * 16 * 32, J6 = J5;
    const float* w_in = F.in[I_WIN] + (size_t)l * D * IN_COLS;
    int r = it; CvItem c; c.f8 = 0; c.gk = nullptr;
    if (r < J0 + J1) c.gk = F.in[I_NMG] + (size_t)l * D;
    if (r < J0) { if (r < 16 * 24) { const int kb = r / 24, nb = r % 24; c.W = w_in + nb * 64; c.pitch = IN_COLS; c.WT = WSP(bf16, WS_WIN) + (size_t)(nb * 64) * D; c.Kdst = D; c.k0 = kb * 64; return c; }
        r -= 16 * 24; const int kb = r / 16, nb = r % 16;
        c.W = w_in + 1536 + nb * 32; c.pitch = IN_COLS; c.f8 = 1; c.WT = (bf16*)(F.ws + WS_WIN8 + (size_t)(nb * 32) * D); c.Kdst = D; c.k0 = kb * 128; return c; } r -= J0;
    if (r < J1) { if (r < 16 * 24) { const int kb = r / 24, nb = r % 24; c.W = w_in + OFF_DQ + nb * 64; c.pitch = IN_COLS; c.WT = WSP(bf16, WS_WIN) + (size_t)(1536 + nb * 64) * D; c.Kdst = D; c.k0 = kb * 64; return c; }
        r -= 16 * 24; const int kb = r / 64, nb = r % 64;
        c.W = w_in + OFF_DQ + 1536 + nb * 32; c.pitch = IN_COLS; c.f8 = 1; c.WT = (bf16*)(F.ws + WS_WIN8 + (size_t)(512 + nb * 32) * D); c.Kdst = D; c.k0 = kb * 128; return c; } r -= J1;
    if (r < J2) { const int kb = r / 16, nb = r % 16; c.W = F.in[I_WUA] + (size_t)l * MW * D + nb * 64; c.pitch = D; c.WT = WSP(bf16, l == 0 ? WS_WA : WS_WA_L1) + (size_t)(nb * 64) * 1024; c.Kdst = 1024; c.k0 = kb * 64; return c; } r -= J2;
    if (r < J3) { const int kb = r / 16, nb = r % 16; c.W = F.in[I_WUB] + (size_t)l * MW * D + nb * 64; c.pitch = D; c.WT = WSP(bf16, l == 0 ? WS_WA : WS_WA_L1) + (size_t)(nb * 64) * 1024 + 512; c.Kdst = 1024; c.k0 = kb * 64; return c; } r -= J3;
    if (r < J4) { const int kb = r / 16, nb = r % 16; c.W = F.in[I_WOUT] + (size_t)l * D * D + nb * 64; c.pitch = D; c.WT = WSP(bf16, l == 0 ? WS_WO : WS_WO_L1) + (size_t)(nb * 64) * D; c.Kdst = D; c.k0 = kb * 64; return c; } r -= J4;
    if (r < J5 + J6) { const int up = r >= J5; if (up) r -= J5; const int e = r / 512, q = r % 512, kb = q / 64, nb = q % 64, col = nb * 32;
        c.W = (up ? F.in[I_WUE] : F.in[I_WGE]) + ((size_t)l * NE + e) * D * DFF + col; c.pitch = DFF; c.f8 = 1;
        c.WT = (bf16*)(F.ws + (l == 0 ? WS_WGU : WS_WGU_L1) + (size_t)((e * 16 + (col >> 7)) * 256 + up * 128 + (col & 127)) * D); c.Kdst = D; c.k0 = kb * 128; return c; } r -= J5 + J6;
    { const int e = r / 512, q = r % 512, kb = q / 32, nb = q % 32;
      c.W = F.in[I_WDE] + ((size_t)l * NE + e) * DFF * D + nb * 32; c.pitch = D; c.f8 = 1; c.WT = (bf16*)(F.ws + (l == 0 ? WS_WD : WS_WD_L1) + (size_t)(e * 1024 + nb * 32) * DFF); c.Kdst = DFF; c.k0 = kb * 128; return c; }
}
constexpr int CV_GU0 = 16 * 32 + 16 * 56 + 8 * 16 + 8 * 16 + 16 * 16, CV_GU1 = CV_GU0 + 2 * 16 * 16 * 32, CV_NITEMS = CV_GU1 + 16 * 32 * 16;
__device__ __forceinline__ void cv_run(Frame& F, int l, int lane, LAS float* scr, int first, int count, int wi, int nw) {
    f32x4 va[16], vb[16];
    int it = wi;
    if (it >= count) return;
    CvItem ca = cv_decode(F, l, first + it), cbn = ca;
    cv_load(ca, lane, va);
#pragma unroll 1
    for (;;) {
        const bool hb = (it + nw < count);
        if (hb) { cbn = cv_decode(F, l, first + it + nw); cv_load(cbn, lane, vb); }
        cv_store(ca, lane, va, scr);
        if (!hb) break;
        it += nw;
        const bool ha = (it + nw < count);
        if (ha) { ca = cv_decode(F, l, first + it + nw); cv_load(ca, lane, va); }
        cv_store(cbn, lane, vb, scr);
        if (!ha) break;
        it += nw;
    }
}
constexpr int CV_WIN = 16 * 32 + 16 * 56;
__device__ __forceinline__ void ph_convert(Frame& F, int l) {
    PH_IDS;
    LAS float* scr = (LAS float*)(F.lds + wave * 16384);
    const int gw = F.bx * NWAVES + wave, NGW = F.G * NWAVES;
    cv_run(F, l, lane, scr, 0, CV_WIN, gw, NGW);
}

__device__ __forceinline__ void stage_w16(int tid, LAS float* w16, const float* src, int pitch) {
    __syncthreads();
    f32x4 w[8];
#pragma unroll
    for (int n = 0; n < 8; ++n) { const int i = tid + NTHREADS * n, k = i >> 2, q = i & 3; w[n] = *(const f32x4*)(src + (size_t)k * pitch + q * 4); }
#pragma unroll
    for (int n = 0; n < 8; ++n) { const int i = tid + NTHREADS * n, k = i >> 2, q = i & 3; *(LAS f32x4*)(w16 + ((((k >> 8) * 4 + (k & 3)) * 4 + q) * 64 + ((k & 255) >> 2)) * 4) = w[n]; }
    __syncthreads();
}
template <int N> __device__ __forceinline__ float row_ror_add(float x) { return x + __int_as_float(__builtin_amdgcn_update_dpp(0, __float_as_int(x), 0x120 + N, 0xf, 0xf, false)); }
template <int N> __device__ __forceinline__ float row_ror_max(float x) { return fmaxf(x, __int_as_float(__builtin_amdgcn_update_dpp(0, __float_as_int(x), 0x120 + N, 0xf, 0xf, false))); }
__device__ __forceinline__ float xrow_sum(float v) {
    auto a = __builtin_amdgcn_permlane16_swap(__float_as_uint(v), __float_as_uint(v), false, false); v = __uint_as_float(a[0]) + __uint_as_float(a[1]);
    auto b = __builtin_amdgcn_permlane32_swap(__float_as_uint(v), __float_as_uint(v), false, false); return __uint_as_float(b[0]) + __uint_as_float(b[1]); }
__device__ __forceinline__ float xrow_max(float v) {
    auto a = __builtin_amdgcn_permlane16_swap(__float_as_uint(v), __float_as_uint(v), false, false); v = fmaxf(__uint_as_float(a[0]), __uint_as_float(a[1]));
    auto b = __builtin_amdgcn_permlane32_swap(__float_as_uint(v), __float_as_uint(v), false, false); return fmaxf(__uint_as_float(b[0]), __uint_as_float(b[1])); }
__device__ __forceinline__ float wave_sum_fast(float v) { v = row_ror_add<8>(v); v = row_ror_add<4>(v); v = row_ror_add<2>(v); v = row_ror_add<1>(v); return xrow_sum(v); }
template <int R> __device__ __forceinline__ void proj16(const f32x4 (&h)[R][4], const LAS float* w16, int lane, float (&t)[R][4]) {
    float p[R][16];
#pragma unroll
    for (int r = 0; r < R; ++r)
#pragma unroll
        for (int j = 0; j < 16; ++j) p[r][j] = 0.f;
    int lane4 = 4 * lane; asm volatile("" : "+v"(lane4) : "v"(h[0][0][0]), "v"(h[R - 1][0][0]));
#pragma unroll
    for (int jj = 0; jj < 4; ++jj)
#pragma unroll
        for (int c = 0; c < 4; ++c) {
#pragma unroll
            for (int q = 0; q < 4; ++q) { const f32x4 w = *(const LAS f32x4*)(w16 + ((jj * 4 + c) * 4 + q) * 256 + lane4);
#pragma unroll
                for (int r = 0; r < R; ++r) { const float hv = h[r][jj][c]; p[r][4 * q + 0] += hv * w.x; p[r][4 * q + 1] += hv * w.y; p[r][4 * q + 2] += hv * w.z; p[r][4 * q + 3] += hv * w.w; } }
            if (c & 1) {
#pragma unroll
                for (int r = 0; r < R; ++r) asm volatile("" : "+v"(p[r][0]), "+v"(p[r][1]), "+v"(p[r][2]), "+v"(p[r][3]), "+v"(p[r][4]), "+v"(p[r][5]), "+v"(p[r][6]), "+v"(p[r][7]), "+v"(p[r][8]), "+v"(p[r][9]), "+v"(p[r][10]), "+v"(p[r][11]), "+v"(p[r][12]), "+v"(p[r][13]), "+v"(p[r][14]), "+v"(p[r][15]) :: "memory"); } }
#pragma unroll
    for (int r = 0; r < R; ++r) {
        float q8[8];
#pragma unroll
        for (int j = 0; j < 8; ++j) { auto rr = __builtin_amdgcn_permlane32_swap(__float_as_uint(p[r][j]), __float_as_uint(p[r][j + 8]), false, false); q8[j] = __uint_as_float(rr[0]) + __uint_as_float(rr[1]); }
#pragma unroll
        for (int m = 0; m < 4; ++m) { auto rr = __builtin_amdgcn_permlane16_swap(__float_as_uint(q8[m]), __float_as_uint(q8[m + 4]), false, false); float v = __uint_as_float(rr[0]) + __uint_as_float(rr[1]);
            v = row_ror_add<8>(v); v = row_ror_add<4>(v); v = row_ror_add<2>(v); v = row_ror_add<1>(v); t[r][m] = v; } }
}
__device__ __forceinline__ f32x4 ldx4(const bf16* p) { const v2u w = *(const v2u*)p; return (f32x4){bflo(w.x), bfhi(w.x), bflo(w.y), bfhi(w.y)}; }
__device__ __forceinline__ void store_bf16_row(bf16* dst, const f32x4 (&h)[4], int lane) {
#pragma unroll
    for (int j = 0; j < 4; ++j) { v2u o; o.x = pk2(h[j].x, h[j].y); o.y = pk2(h[j].z, h[j].w); *(v2u*)(dst + 256 * j + 4 * lane) = o; }
}
__device__ __forceinline__ void rms_row(const f32x4 (&v)[4], const float* g, int lane, f32x4 (&h)[4]) {
    float s = 0.f;
#pragma unroll
    for (int j = 0; j < 4; ++j) s += (v[j].x * v[j].x + v[j].y * v[j].y) + (v[j].z * v[j].z + v[j].w * v[j].w);
    const float rstd = 1.0f / sqrtf(wave_sum_fast(s) * (1.0f / D) + EPS);
#pragma unroll
    for (int j = 0; j < 4; ++j) { const f32x4 gg = *(const f32x4*)(g + 256 * j + 4 * lane); h[j] = v[j] * rstd * gg; }
}
template <int R> __device__ __forceinline__ void prep1_rows(Frame& F, int lane, int l, int row0, int rstep, const f32x4 (&v)[R][4]) {
    (void)l;
#pragma unroll
    for (int r = 0; r < R; ++r) {
        float ss = 0.f;
#pragma unroll
        for (int j = 0; j < 4; ++j) ss += (v[r][j].x * v[r][j].x + v[r][j].y * v[r][j].y) + (v[r][j].z * v[r][j].z + v[r][j].w * v[r][j].w);
        const float rstd = 1.0f / sqrtf(wave_sum_fast(ss) * (1.0f / D) + EPS);
        if (lane == 0) WSP(float, WS_RSTD1)[row0 + r * rstep] = rstd;
#pragma unroll
        for (int j = 0; j < 4; ++j) *(unsigned*)(F.ws + WS_MIX + (size_t)(row0 + r * rstep) * D + 256 * j + 4 * lane) = pg8::pk4_fp8(v[r][j].x, v[r][j].y, v[r][j].z, v[r][j].w); }
}
__device__ __forceinline__ void ph_prep_first(Frame& F) {
    PH_IDS;
    const int gw = F.bx * NWAVES + wave, NGW = F.G * NWAVES;
    f32x4 v[2][4];
#pragma unroll
    for (int r = 0; r < 2; ++r)
#pragma unroll
        for (int j = 0; j < 4; ++j) v[r][j] = *(const f32x4*)(F.in[I_X] + (size_t)(gw + r * NGW) * D + 256 * j + 4 * lane);
#pragma unroll 1
    for (int row = gw; row < T; row += 2 * NGW) {
        f32x4 vn[2][4];
        const int nrow = (row + 2 * NGW < T) ? row + 2 * NGW : row;
#pragma unroll
        for (int r = 0; r < 2; ++r)
#pragma unroll
            for (int j = 0; j < 4; ++j) { vn[r][j] = *(const f32x4*)(F.in[I_X] + (size_t)(nrow + r * NGW) * D + 256 * j + 4 * lane); { v2u o; o.x = pk2(v[r][j].x, v[r][j].y); o.y = pk2(v[r][j].z, v[r][j].w); *(v2u*)(WSP(bf16, WS_XR) + (size_t)(row + r * NGW) * D + 256 * j + 4 * lane) = o; } }
        prep1_rows<2>(F, lane, 0, row, NGW, v);
#pragma unroll
        for (int r = 0; r < 2; ++r)
#pragma unroll
            for (int j = 0; j < 4; ++j) v[r][j] = vn[r][j];
    }
    __syncthreads();
}
__device__ __forceinline__ void stage_wmf(int tid, LAS unsigned char* img, const float* src, int pitch, const float* g) {
    __syncthreads();
    static_assert(32 * 64 == 4 * NTHREADS, "four image pieces per thread");
#pragma unroll
    for (int it = 0; it < 4; ++it) { const int idx = tid + it * NTHREADS; const int s = idx >> 6, ln = idx & 63, j = ln & 15, q = ln >> 4;
        unsigned hi[4], lo[4];
#pragma unroll
        for (int t2 = 0; t2 < 4; ++t2) { const int k = 32 * s + 8 * q + 2 * t2;
            const float w0 = src[(size_t)k * pitch + j] * g[k], w1 = src[(size_t)(k + 1) * pitch + j] * g[k + 1];
            const unsigned h0 = f2bf(w0), h1 = f2bf(w1); hi[t2] = h0 | (h1 << 16);
            lo[t2] = f2bf(w0 - bf2f((unsigned short)h0)) | (f2bf(w1 - bf2f((unsigned short)h1)) << 16); }
        *(LAS v4u*)(img + ((s * 2 + 0) * 64 + ln) * 16) = (v4u){hi[0], hi[1], hi[2], hi[3]};
        *(LAS v4u*)(img + ((s * 2 + 1) * 64 + ln) * 16) = (v4u){lo[0], lo[1], lo[2], lo[3]}; }
    __syncthreads();
}
__device__ __forceinline__ void ph_prep2(Frame& F, int l) {
    PH_IDS;
    LAS unsigned char* img = (LAS unsigned char*)(F.lds + 0);
    stage_wmf(tid, img, F.in[I_WR] + (size_t)l * D * NE, NE, F.in[I_NFG] + (size_t)l * D);
    LAS float* gl = (LAS float*)(F.lds + 65536);
    for (int k = tid; k < D; k += NTHREADS) gl[k] = F.in[I_NFG][(size_t)l * D + k];
    __syncthreads();
    const int gw = F.bx * NWAVES + wave, NGW = F.G * NWAVES;
#pragma unroll 1
    for (int grp = gw; grp < T / 16; grp += NGW) {
        const int i = lane & 15, q = lane >> 4;
        const bf16* xp = WSP(bf16, WS_XR) + (size_t)(grp * 16 + i) * D + 8 * q;
        float zf = 0.f; asm volatile("" : "+v"(zf));
        f32x4 acc = (f32x4){zf, zf, zf, zf}; float ssq = 0.f;
        v4u a[32];
#pragma unroll
        for (int u = 0; u < 32; ++u) a[u] = *(const v4u*)(xp + 32 * u);
#pragma unroll
        for (int u = 0; u < 32; ++u) { const bf16x8 bh = *(const LAS bf16x8*)(img + ((u * 2 + 0) * 64 + lane) * 16), bl = *(const LAS bf16x8*)(img + ((u * 2 + 1) * 64 + lane) * 16);
            const bf16x8 av = __builtin_bit_cast(bf16x8, a[u]);
            acc = __builtin_amdgcn_mfma_f32_16x16x32_bf16(av, bh, acc, 0, 0, 0); acc = __builtin_amdgcn_mfma_f32_16x16x32_bf16(av, bl, acc, 0, 0, 0);
            const float x0 = bflo(a[u].x), x1 = bfhi(a[u].x), x2 = bflo(a[u].y), x3 = bfhi(a[u].y), x4 = bflo(a[u].z), x5 = bfhi(a[u].z), x6 = bflo(a[u].w), x7 = bfhi(a[u].w);
            ssq += (x0 * x0 + x1 * x1) + (x2 * x2 + x3 * x3) + ((x4 * x4 + x5 * x5) + (x6 * x6 + x7 * x7)); }
        ssq += __shfl_xor(ssq, 16); ssq += __shfl_xor(ssq, 32);
        const float rstd = 1.0f / sqrtf(ssq * (1.0f / D) + EPS);
#pragma unroll
        for (int r = 0; r < 4; ++r) { float t = acc[r] * __shfl(rstd, 4 * q + r);
            float mx = row_ror_max<8>(t); mx = row_ror_max<4>(mx); mx = row_ror_max<2>(mx); mx = row_ror_max<1>(mx);
            const float e = __expf(t - mx);
            float se = row_ror_add<8>(e); se = row_ror_add<4>(se); se = row_ror_add<2>(se); se = row_ror_add<1>(se);
            WSP(float, WS_AFF)[(size_t)(grp * 16 + 4 * q + r) * 16 + i] = e / se; }
        { unsigned m1 = 0xffffffffu; asm volatile("" : "+v"(m1)); *(v4u*)(WSP(int, WS_INV) + (size_t)(grp * 16) * 16 + 4 * lane) = (v4u){m1, m1, m1, m1}; }
        unsigned char* op = F.ws + WS_XB + (size_t)(grp * 16 + i) * D + 8 * q;
#pragma unroll
        for (int u = 0; u < 32; ++u) asm volatile("" : "+v"(a[u]));
#pragma unroll
        for (int u = 0; u < 32; ++u) { const f32x4 g0 = *(const LAS f32x4*)(gl + 32 * u + 8 * q), g1 = *(const LAS f32x4*)(gl + 32 * u + 8 * q + 4);
            v2u o; o.x = pg8::pk4_fp8(bflo(a[u].x) * rstd * g0.x, bfhi(a[u].x) * rstd * g0.y, bflo(a[u].y) * rstd * g0.z, bfhi(a[u].y) * rstd * g0.w);
            o.y = pg8::pk4_fp8(bflo(a[u].z) * rstd * g1.x, bfhi(a[u].z) * rstd * g1.y, bflo(a[u].w) * rstd * g1.z, bfhi(a[u].w) * rstd * g1.w);
            *(v2u*)(op + 32 * u) = o; }
    }
    __syncthreads();
}
__device__ __forceinline__ void ph_mgate(Frame& F, int l) {
    PH_IDS;
    LAS unsigned char* img = (LAS unsigned char*)(F.lds + 0);
    stage_wmf(tid, img, F.in[I_WIN] + (size_t)l * D * IN_COLS + OFF_MG, IN_COLS, F.in[I_NMG] + (size_t)l * D);
    const int gw = F.bx * NWAVES + wave, NGW = F.G * NWAVES;
#pragma unroll 1
    for (int grp = gw; grp < T / 16; grp += NGW) {
        const int i = lane & 15, q = lane >> 4;
        const bf16* xp = WSP(bf16, WS_XR) + (size_t)(grp * 16 + i) * D + 8 * q;
        float zf = 0.f; asm volatile("" : "+v"(zf));
        f32x4 acc = (f32x4){zf, zf, zf, zf}; float ssq = 0.f;
        {
            v4u a[32];
#pragma unroll
            for (int u = 0; u < 32; ++u) a[u] = *(const v4u*)(xp + 32 * u);
#pragma unroll
            for (int u = 0; u < 32; ++u) { const bf16x8 bh = *(const LAS bf16x8*)(img + ((u * 2 + 0) * 64 + lane) * 16), bl = *(const LAS bf16x8*)(img + ((u * 2 + 1) * 64 + lane) * 16);
                const bf16x8 av = __builtin_bit_cast(bf16x8, a[u]);
                acc = __builtin_amdgcn_mfma_f32_16x16x32_bf16(av, bh, acc, 0, 0, 0); acc = __builtin_amdgcn_mfma_f32_16x16x32_bf16(av, bl, acc, 0, 0, 0);
                const float x0 = bflo(a[u].x), x1 = bfhi(a[u].x), x2 = bflo(a[u].y), x3 = bfhi(a[u].y), x4 = bflo(a[u].z), x5 = bfhi(a[u].z), x6 = bflo(a[u].w), x7 = bfhi(a[u].w);
                ssq += (x0 * x0 + x1 * x1) + (x2 * x2 + x3 * x3) + ((x4 * x4 + x5 * x5) + (x6 * x6 + x7 * x7)); }
        }
        ssq += __shfl_xor(ssq, 16); ssq += __shfl_xor(ssq, 32);
        const float rstd = 1.0f / sqrtf(ssq * (1.0f / D) + EPS);
        const float bm = F.in[I_BMG][l * 16 + i];
#pragma unroll
        for (int r = 0; r < 4; ++r) WSP(float, WS_MG)[(size_t)(grp * 16 + 4 * q + r) * 16 + i] = acc[r] * __shfl(rstd, 4 * q + r) + bm;
    }
    __syncthreads();
}
__device__ __forceinline__ void ph_topk(Frame& F) {
    PH_IDS;
    LAS unsigned long long* keys = (LAS unsigned long long*)(F.lds + 0);
    for (int item = F.bx; item < BATCH * NE; item += F.G) {
        const int b = item >> 4, e = item & 15;
        __syncthreads();
        static_assert(SEQ == 4 * NTHREADS, "four scores per thread");
        float sv[4];
#pragma unroll
        for (int n = 0; n < 4; ++n) sv[n] = WSP(float, WS_AFF)[((size_t)b * SEQ + tid + n * NTHREADS) * 16 + e];
#pragma unroll
        for (int n = 0; n < 4; ++n) { const int s = tid + n * NTHREADS;
            keys[s] = ((unsigned long long)__float_as_uint(sv[n]) << 32) | (unsigned long long)(0xFFFFFFFFu - (unsigned)s); }
        __syncthreads();
        for (int k = 2; k <= SEQ; k <<= 1)
            for (int j = k >> 1; j > 0; j >>= 1) {
#pragma unroll
                for (int pp = 0; pp < 2; ++pp) { const int p = tid + NTHREADS * pp; const int i = ((p & ~(j - 1)) << 1) | (p & (j - 1)), ix = i | j;
                    const unsigned long long x = keys[i], y = keys[ix]; const bool up = ((i & k) == 0);
                    if ((x < y) == up) { keys[i] = y; keys[ix] = x; } }
                __syncthreads();
            }
        if (tid < CAP) { const unsigned long long kk = keys[tid]; const int s = (int)(0xFFFFFFFFu - (unsigned)(kk & 0xFFFFFFFFull));
            WSP(int, WS_IDX)[item * CAP + tid] = b * SEQ + s; WSP(float, WS_GATEV)[item * CAP + tid] = __uint_as_float((unsigned)(kk >> 32));
            WSP(int, WS_INV)[((size_t)b * SEQ + s) * 16 + e] = tid; }
    }
    __syncthreads();
}
__device__ __forceinline__ void ph_combine(Frame& F, int l) {
    PH_IDS;
    const bool lastl = (l + 1 == DEPTH);
    const int gw = F.bx * NWAVES + wave, NGW = F.G * NWAVES;
    f32x4 v[2][4]; int myinv[2], ninv[2];
    const int row1 = (gw + 2 * NGW < T) ? gw + 2 * NGW : gw;
#pragma unroll
    for (int r = 0; r < 2; ++r) { myinv[r] = WSP(int, WS_INV)[(size_t)(gw + r * NGW) * 16 + (lane & 15)]; ninv[r] = WSP(int, WS_INV)[(size_t)(row1 + r * NGW) * 16 + (lane & 15)];
#pragma unroll
        for (int j = 0; j < 4; ++j) v[r][j] = ldx4(WSP(bf16, WS_XR) + (size_t)(gw + r * NGW) * D + 256 * j + 4 * lane); }
#define CB_GATHER(ROW_, INV_, Y_, FL_, REST_) do { _Pragma("unroll") for (int r = 0; r < 2; ++r) { const int b = ((ROW_) + r * NGW) / SEQ; \
            unsigned mask = (unsigned)__builtin_amdgcn_ballot_w64(INV_[r] >= 0) & 0xffffu;        \
            _Pragma("unroll") for (int k = 0; k < 4; ++k) { const bool hit = mask != 0u; const int e = hit ? __builtin_ctz(mask) : 0; const int sl = __builtin_amdgcn_readlane(INV_[r], e); \
                const unsigned char* yr = F.ws + WS_YE + ((size_t)(b * 16 + e) * CAP + (hit ? sl : 0)) * D; FL_[r][k] = hit ? (1.0f / pg8::Y8_SCALE) : 0.0f; mask &= mask - 1u; \
                _Pragma("unroll") for (int j = 0; j < 4; ++j) Y_[r][k][j] = *(const unsigned*)(yr + 256 * j + 4 * lane); } \
            REST_[r] = mask; } } while (0)
    unsigned y[2][4][4]; float fl[2][4]; unsigned rest[2];
    CB_GATHER(gw, myinv, y, fl, rest);
#pragma unroll 1
    for (int row = gw; row < T; row += 2 * NGW) {
        f32x4 vn[2][4]; int n2inv[2];
        const int nrow = (row + 2 * NGW < T) ? row + 2 * NGW : row, n2row = (row + 4 * NGW < T) ? row + 4 * NGW : row;
#pragma unroll
        for (int r = 0; r < 2; ++r) { n2inv[r] = WSP(int, WS_INV)[(size_t)(n2row + r * NGW) * 16 + (lane & 15)];
#pragma unroll
            for (int j = 0; j < 4; ++j) vn[r][j] = ldx4(WSP(bf16, WS_XR) + (size_t)(nrow + r * NGW) * D + 256 * j + 4 * lane); }
        unsigned yn[2][4][4]; float fln[2][4]; unsigned restn[2];
        CB_GATHER(nrow, ninv, yn, fln, restn);
#pragma unroll
        for (int r = 0; r < 2; ++r) {
#pragma unroll
            for (int k = 0; k < 4; ++k)
#pragma unroll
                for (int j = 0; j < 4; ++j) { const unsigned yy = y[r][k][j]; const float f = fl[r][k]; const f32x2 lo = __builtin_amdgcn_cvt_pk_f32_fp8((int)yy, false), hi = __builtin_amdgcn_cvt_pk_f32_fp8((int)yy, true);
                    v[r][j].x += f * lo.x; v[r][j].y += f * lo.y; v[r][j].z += f * hi.x; v[r][j].w += f * hi.y; }
            unsigned mask = rest[r]; const int b = (row + r * NGW) / SEQ;
            while (mask) { const int e = __builtin_ctz(mask); mask &= mask - 1u; const int sl = __builtin_amdgcn_readlane(myinv[r], e);
                const unsigned char* yr = F.ws + WS_YE + ((size_t)(b * 16 + e) * CAP + sl) * D;
#pragma unroll
                for (int j = 0; j < 4; ++j) { const unsigned yy = *(const unsigned*)(yr + 256 * j + 4 * lane); const f32x2 lo = __builtin_amdgcn_cvt_pk_f32_fp8((int)yy, false), hi = __builtin_amdgcn_cvt_pk_f32_fp8((int)yy, true);
                    const float f = 1.0f / pg8::Y8_SCALE; v[r][j].x += f * lo.x; v[r][j].y += f * lo.y; v[r][j].z += f * hi.x; v[r][j].w += f * hi.y; } } }
        if (!lastl) {
#pragma unroll
            for (int r = 0; r < 2; ++r)
#pragma unroll
                for (int j = 0; j < 4; ++j) { v2u o; o.x = pk2(v[r][j].x, v[r][j].y); o.y = pk2(v[r][j].z, v[r][j].w); *(v2u*)(WSP(bf16, WS_XR) + (size_t)(row + r * NGW) * D + 256 * j + 4 * lane) = o; }
            prep1_rows<2>(F, lane, l + 1, row, NGW, v);
        } else {
#pragma unroll
            for (int r = 0; r < 2; ++r) { f32x4 h[4]; rms_row(v[r], F.in[I_NF], lane, h);
#pragma unroll
                for (int j = 0; j < 4; ++j) *(f32x4*)(F.X + (size_t)(row + r * NGW) * D + 256 * j + 4 * lane) = h[j]; } }
#pragma unroll
        for (int r = 0; r < 2; ++r) { myinv[r] = ninv[r]; ninv[r] = n2inv[r]; rest[r] = restn[r];
#pragma unroll
            for (int j = 0; j < 4; ++j) v[r][j] = vn[r][j];
#pragma unroll
            for (int k = 0; k < 4; ++k) { fl[r][k] = fln[r][k];
#pragma unroll
                for (int j = 0; j < 4; ++j) y[r][k][j] = yn[r][k][j]; } }
    }
#undef CB_GATHER
    __syncthreads();
}

__device__ __forceinline__ void ph_mlstm_naive(Frame& F, int l) {
    PH_IDS;
    constexpr int TB = 64;
    LAS float* qs = (LAS float*)(F.lds + 0);
    LAS float* ks = (LAS float*)(F.lds + 32768);
    LAS float* vs = (LAS float*)(F.lds + 65536);
    LAS float* gl = (LAS float*)(F.lds + 98304);
    const float* cw = F.in[I_CW] + (size_t)l * CONVW * 2 * MW; const float* cb = F.in[I_CB] + (size_t)l * 2 * MW;
    const bf16* zqk = WSP(bf16, WS_ZQK); const bf16* zmv = WSP(bf16, WS_ZMV); const float* mg = WSP(float, WS_MG);
    for (int item = F.bx; item < BATCH * MH * 2; item += F.G) {
        const int dir = item & 1, h = (item >> 1) & 3, b = item >> 3;
        float* outp = WSP(float, dir ? WS_HB : WS_HF);
        const int v = tid >> 2, kq = tid & 3;
        float C[32], n[32];
#pragma unroll
        for (int i = 0; i < 32; ++i) { C[i] = 0.f; n[i] = 0.f; }
        float m = 0.f;
        for (int blk = 0; blk < SEQ / TB; ++blk) {
            const int ta = dir ? (SEQ - TB - blk * TB) : blk * TB;
            __syncthreads();
            for (int i = tid; i < TB * 256; i += NTHREADS) { const int tt = i >> 8, c = i & 255; const int col = (c < 128) ? (h * 128 + c) : (512 + h * 128 + (c - 128));
                float a = cb[col];
#pragma unroll
                for (int j = 0; j < CONVW; ++j) { const int ts = ta + tt + j - 2; if (ts >= 0 && ts < SEQ) a += cw[j * 2 * MW + col] * bf2f(zqk[((size_t)b * SEQ + ts) * 1024 + col]); }
                a = a * sigmoidf_(a);
                if (c < 128) qs[tt * 128 + c] = a; else ks[tt * 128 + (c - 128)] = a * 0.08838834764831845f; }
            for (int i = tid; i < TB * 128; i += NTHREADS) { const int tt = i >> 7, c = i & 127; vs[i] = bf2f(zmv[((size_t)b * SEQ + ta + tt) * 512 + h * 128 + c]); }
            if (tid < TB) { const float ip = mg[((size_t)b * SEQ + ta + tid) * 16 + dir * 8 + h], fp = mg[((size_t)b * SEQ + ta + tid) * 16 + dir * 8 + 4 + h];
                gl[tid * 2 + 0] = fminf(fp, 0.f) - log1pf(__expf(-fabsf(fp))); gl[tid * 2 + 1] = ip; }
            __syncthreads();
            for (int u = 0; u < TB; ++u) {
                const int tt = dir ? (TB - 1 - u) : u;
                const float lf = gl[tt * 2], li = gl[tt * 2 + 1];
                const float mn = fmaxf(lf + m, li), fs = __expf(lf + m - mn), is = __expf(li - mn); m = mn;
                const float iv = is * vs[tt * 128 + v];
                float hp = 0.f, dp = 0.f;
#pragma unroll
                for (int q4 = 0; q4 < 8; ++q4) { const f32x4 kx = *(const LAS f32x4*)(ks + tt * 128 + kq * 32 + q4 * 4), qx = *(const LAS f32x4*)(qs + tt * 128 + kq * 32 + q4 * 4);
#pragma unroll
                    for (int c = 0; c < 4; ++c) { const int i = q4 * 4 + c; C[i] = fs * C[i] + iv * kx[c]; n[i] = fs * n[i] + is * kx[c]; hp += C[i] * qx[c]; dp += n[i] * qx[c]; } }
                hp += __shfl_xor(hp, 1); hp += __shfl_xor(hp, 2); dp += __shfl_xor(dp, 1); dp += __shfl_xor(dp, 2);
                if (kq == 0) outp[((size_t)b * SEQ + ta + tt) * 512 + h * 128 + v] = hp / fmaxf(fabsf(dp), __expf(-m));
            }
        }
    }
    __syncthreads();
}
__device__ __forceinline__ void ph_mnorm(Frame& F, int l) {
    PH_IDS;
    const int gw = F.bx * NWAVES + wave, NGW = F.G * NWAVES;
    const float* ng = F.in[I_MNG] + (size_t)l * MW + 8 * lane;
    const f32x4 g0 = *(const f32x4*)ng, g1 = *(const f32x4*)(ng + 4);
#define MN_LOAD(TK0_, AF_, AB_, O8_) do { _Pragma("unroll") for (int t4 = 0; t4 < 4; ++t4) { const int tkl = ((TK0_) + t4 * NGW < T) ? (TK0_) + t4 * NGW : gw; const size_t off = (size_t)tkl * 512 + 8 * lane; \
            AF_[t4] = *(const v4u*)(WSP(bf16, WS_HF) + off); AB_[t4] = *(const v4u*)(WSP(bf16, WS_HB) + off); O8_[t4] = *(const v2u*)(F.ws + WS_ZMO + off); } } while (0)
    v4u af4[4], ab4[4]; v2u o84[4];
    MN_LOAD(gw, af4, ab4, o84);
#pragma unroll 1
    for (int tk0 = gw; tk0 < T; tk0 += 4 * NGW) {
        v4u afn[4], abn[4]; v2u o8n[4];
        MN_LOAD(tk0 + 4 * NGW, afn, abn, o8n);
#pragma unroll
        for (int t4 = 0; t4 < 4; ++t4) {
        const int tk = tk0 + t4 * NGW;
        if (tk >= T) break;
        const v4u af = af4[t4], ab = ab4[t4];
        const f32x4 a0 = (f32x4){bflo(af.x), bfhi(af.x), bflo(af.y), bfhi(af.y)}, a1 = (f32x4){bflo(af.z), bfhi(af.z), bflo(af.w), bfhi(af.w)}, b0 = (f32x4){bflo(ab.x), bfhi(ab.x), bflo(ab.y), bfhi(ab.y)}, b1 = (f32x4){bflo(ab.z), bfhi(ab.z), bflo(ab.w), bfhi(ab.w)};
        const v2u o8 = o84[t4];
        constexpr float Q8 = 1.0f / 255.0f;
        const float og0 = ub0(o8.x) * Q8, og1 = ub1(o8.x) * Q8, og2 = ub2(o8.x) * Q8, og3 = ub3(o8.x) * Q8, og4 = ub0(o8.y) * Q8, og5 = ub1(o8.y) * Q8, og6 = ub2(o8.y) * Q8, og7 = ub3(o8.y) * Q8;
        f32x4 x0 = a0 + b0, x1 = a1 + b1;
        float sm = (x0.x + x0.y) + (x0.z + x0.w) + (x1.x + x1.y) + (x1.z + x1.w);
        sm = row_ror_add<8>(sm); sm = row_ror_add<4>(sm); sm = row_ror_add<2>(sm); sm = row_ror_add<1>(sm);
        const float mu = sm * (1.0f / 128.0f);
        x0 = x0 - mu; x1 = x1 - mu;
        float vs = (x0.x * x0.x + x0.y * x0.y) + (x0.z * x0.z + x0.w * x0.w) + (x1.x * x1.x + x1.y * x1.y) + (x1.z * x1.z + x1.w * x1.w);
        vs = row_ror_add<8>(vs); vs = row_ror_add<4>(vs); vs = row_ror_add<2>(vs); vs = row_ror_add<1>(vs);
        const float rs = 1.0f / sqrtf(vs * (1.0f / 128.0f) + EPS);
        v4u w; w.x = pk2(x0.x * rs * g0.x * og0, x0.y * rs * g0.y * og1); w.y = pk2(x0.z * rs * g0.z * og2, x0.w * rs * g0.w * og3);
        w.z = pk2(x1.x * rs * g1.x * og4, x1.y * rs * g1.y * og5); w.w = pk2(x1.z * rs * g1.z * og6, x1.w * rs * g1.w * og7);
        *(v4u*)(WSP(bf16, WS_HM) + (size_t)tk * 1024 + 8 * lane) = w;
        }
#pragma unroll
        for (int t4 = 0; t4 < 4; ++t4) { af4[t4] = afn[t4]; ab4[t4] = abn[t4]; o84[t4] = o8n[t4]; }
    }
#undef MN_LOAD
}
__device__ __forceinline__ void ph_attn_naive(Frame& F, int l) {
    PH_IDS;
    LAS float* Ks = (LAS float*)(F.lds + 0);
    LAS float* Vs = (LAS float*)(F.lds + 32768);
    LAS float* Os = (LAS float*)(F.lds + 65536);
    const float lam_init = __uint_as_float(__builtin_amdgcn_readfirstlane(__float_as_uint(0.8f - 0.6f * __expf(-0.3f * (float)l))));
    const float* lam = F.in[I_LAM] + (size_t)l * 4 * ADH;
    const float s01 = wave_sum(lam[lane] * lam[64 + lane]), s23 = wave_sum(lam[128 + lane] * lam[192 + lane]);
    const float lam_full = __expf(s01) - __expf(s23) + lam_init;
    const float* ng = F.in[I_DNG] + (size_t)l * ADV;
    const bf16* zdq = WSP(bf16, WS_ZDQ); const bf16* zdk = WSP(bf16, WS_ZDK); const bf16* zdv = WSP(bf16, WS_ZDV);
    const int r = tid & 63, part = tid >> 6, hi = part >> 2, dq = part & 3;
    for (int unit = F.bx; unit < BATCH * AH * (SEQ / 64); unit += F.G) {
        const int qb = unit & 31, h = (unit >> 5) & 3, b = unit >> 7;
        const int tq = qb * 64 + r;
        const float slope2 = __builtin_amdgcn_exp2f(-2.0f * (float)(h + 1)) * LOG2E;
        float q[64];
        { const bf16* qp = zdq + ((size_t)b * SEQ + tq) * 512 + h * 128 + hi * 64;
#pragma unroll
          for (int d8 = 0; d8 < 8; ++d8) { const v4u w = *(const v4u*)(qp + d8 * 8); q[d8 * 8 + 0] = bflo(w.x); q[d8 * 8 + 1] = bfhi(w.x); q[d8 * 8 + 2] = bflo(w.y); q[d8 * 8 + 3] = bfhi(w.y);
              q[d8 * 8 + 4] = bflo(w.z); q[d8 * 8 + 5] = bfhi(w.z); q[d8 * 8 + 6] = bflo(w.w); q[d8 * 8 + 7] = bfhi(w.w); } }
        float o[32];
#pragma unroll
        for (int c = 0; c < 32; ++c) o[c] = 0.f;
        float m = -1e30f, lsum = 0.f;
        for (int kt = 0; kt < SEQ / 64; ++kt) {
            __syncthreads();
            for (int i = tid; i < 64 * 16; i += NTHREADS) { const int kr = i >> 4, c8 = i & 15; const size_t g = ((size_t)b * SEQ + kt * 64 + kr) * 512 + h * 128 + c8 * 8;
                const v4u kw = *(const v4u*)(zdk + g), vw = *(const v4u*)(zdv + g);
                LAS float* kd = Ks + kr * 128 + c8 * 8; LAS float* vd = Vs + kr * 128 + c8 * 8;
                kd[0] = bflo(kw.x); kd[1] = bfhi(kw.x); kd[2] = bflo(kw.y); kd[3] = bfhi(kw.y); kd[4] = bflo(kw.z); kd[5] = bfhi(kw.z); kd[6] = bflo(kw.w); kd[7] = bfhi(kw.w);
                vd[0] = bflo(vw.x); vd[1] = bfhi(vw.x); vd[2] = bflo(vw.y); vd[3] = bfhi(vw.y); vd[4] = bflo(vw.z); vd[5] = bfhi(vw.z); vd[6] = bflo(vw.w); vd[7] = bfhi(vw.w); }
            __syncthreads();
            for (int j = 0; j < 64; ++j) {
                float s = 0.f;
#pragma unroll
                for (int d4 = 0; d4 < 16; ++d4) { const f32x4 kx = *(const LAS f32x4*)(Ks + j * 128 + hi * 64 + d4 * 4); s += q[d4 * 4] * kx.x + q[d4 * 4 + 1] * kx.y + q[d4 * 4 + 2] * kx.z + q[d4 * 4 + 3] * kx.w; }
                s -= slope2 * fabsf((float)(tq - (kt * 64 + j)));
                if (s > m) { const float corr = __builtin_amdgcn_exp2f(m - s); lsum *= corr;
#pragma unroll
                    for (int c = 0; c < 32; ++c) o[c] *= corr;
                    m = s; }
                const float p = __builtin_amdgcn_exp2f(s - m); lsum += p;
#pragma unroll
                for (int c4 = 0; c4 < 8; ++c4) { const f32x4 vx = *(const LAS f32x4*)(Vs + j * 128 + dq * 32 + c4 * 4); o[c4 * 4] += p * vx.x; o[c4 * 4 + 1] += p * vx.y; o[c4 * 4 + 2] += p * vx.z; o[c4 * 4 + 3] += p * vx.w; }
            }
        }
        __syncthreads();
        { const float il = 1.0f / lsum;
#pragma unroll
          for (int c = 0; c < 32; ++c) Os[(r * 2 + hi) * 128 + dq * 32 + c] = o[c] * il; }
        __syncthreads();
        float dv[16]; float ss = 0.f;
#pragma unroll
        for (int c = 0; c < 16; ++c) { dv[c] = Os[(r * 2 + 0) * 128 + part * 16 + c] - lam_full * Os[(r * 2 + 1) * 128 + part * 16 + c]; ss += dv[c] * dv[c]; }
        __syncthreads();
        Ks[r * 8 + part] = ss;
        __syncthreads();
        float tot = 0.f;
#pragma unroll
        for (int p8 = 0; p8 < 8; ++p8) tot += Ks[r * 8 + p8];
        const float rs = 1.0f / sqrtf(tot * (1.0f / 128.0f) + EPS) * (1.0f - lam_init);
        bf16* op = WSP(bf16, WS_HD) + ((size_t)b * SEQ + tq) * 512 + h * 128 + part * 16;
        v4u w0, w1;
        w0.x = pk2(dv[0] * rs * ng[part * 16 + 0], dv[1] * rs * ng[part * 16 + 1]); w0.y = pk2(dv[2] * rs * ng[part * 16 + 2], dv[3] * rs * ng[part * 16 + 3]);
        w0.z = pk2(dv[4] * rs * ng[part * 16 + 4], dv[5] * rs * ng[part * 16 + 5]); w0.w = pk2(dv[6] * rs * ng[part * 16 + 6], dv[7] * rs * ng[part * 16 + 7]);
        w1.x = pk2(dv[8] * rs * ng[part * 16 + 8], dv[9] * rs * ng[part * 16 + 9]); w1.y = pk2(dv[10] * rs * ng[part * 16 + 10], dv[11] * rs * ng[part * 16 + 11]);
        w1.z = pk2(dv[12] * rs * ng[part * 16 + 12], dv[13] * rs * ng[part * 16 + 13]); w1.w = pk2(dv[14] * rs * ng[part * 16 + 14], dv[15] * rs * ng[part * 16 + 15]);
        *(v4u*)op = w0; *(v4u*)(op + 8) = w1;
    }
    __syncthreads();
}

namespace attn {
typedef float f32x16 __attribute__((ext_vector_type(16)));
typedef short s16x4 __attribute__((ext_vector_type(4)));
typedef short v4i16_t __attribute__((ext_vector_type(4)));
constexpr int KVT = 64, NT = SEQ / KVT, SLOT = 32768;
__device__ __forceinline__ int crow(int r, int h) { return (r & 3) + 8 * (r >> 2) + 4 * h; }
__device__ __forceinline__ s16x4 vtr(const LAS unsigned char* p) { return __builtin_bit_cast(s16x4, __builtin_amdgcn_ds_read_tr16_b64_v4i16((LAS v4i16_t*)p)); }
__device__ __forceinline__ float max3f(float a, float b, float c) { return __builtin_fmaxf(__builtin_fmaxf(a, b), c); }
__device__ __forceinline__ float swapmax(float v) { auto rr = __builtin_amdgcn_permlane32_swap(__float_as_uint(v), __float_as_uint(v), false, false); return fmaxf(__uint_as_float(rr[0]), __uint_as_float(rr[1])); }
__device__ __forceinline__ float swapsum(float v) { auto rr = __builtin_amdgcn_permlane32_swap(__float_as_uint(v), __float_as_uint(v), false, false); return __uint_as_float(rr[0]) + __uint_as_float(rr[1]); }
__device__ __forceinline__ unsigned cvtpk(float lo, float hi) { typedef float f2 __attribute__((ext_vector_type(2))); typedef __bf16 b2 __attribute__((ext_vector_type(2))); f2 v = {lo, hi}; b2 b = __builtin_convertvector(v, b2); return __builtin_bit_cast(unsigned, b); }

__device__ __forceinline__ void unit(LAS unsigned char* lds, int tid, int b, int h, int qb, const bf16* zdq, const bf16* zdk, const bf16* zdv, bf16* hd,
                                     const float* ng, float lam_full, unsigned oml) {
    const int lane = tid & 63, wave = __builtin_amdgcn_readfirstlane(tid >> 6), hf = wave >> 2, w4 = wave & 3, r32 = lane & 31, hh = lane >> 5;
    const int tq = qb * 128 + w4 * 32 + r32;
    const float slope2 = __builtin_amdgcn_exp2f(-2.0f * (float)(h + 1)) * LOG2E;
    bf16x8 qf[4];
    { const bf16* qp = zdq + ((size_t)b * SEQ + tq) * 512 + h * 128 + hf * 64 + hh * 8;
#pragma unroll
      for (int ks = 0; ks < 4; ++ks) qf[ks] = *(const bf16x8*)(qp + ks * 16); }
    const char* kg = (const char*)(zdk + (size_t)b * SEQ * 512 + h * 128); const char* vg = (const char*)(zdv + (size_t)b * SEQ * 512 + h * 128);
    unsigned koff[2], voff[2];
#pragma unroll
    for (int e = 0; e < 2; ++e) { const int kv = 8 * wave + 4 * e + (lane >> 4), cc = lane & 15;
        koff[e] = (unsigned)(kv * 1024 + ((cc ^ (kv & 15)) * 16)); voff[e] = (unsigned)(kv * 1024 + ((cc ^ ((kv & 3) << 2)) * 16)); }
    const unsigned ldsa = (unsigned)(uintptr_t)lds;
#define AT_GLDS(gsrc, ldst) do { unsigned _keep; asm volatile("s_mov_b32 %0, m0\n\ts_mov_b32 m0, %2\n\ts_nop 0\n\tglobal_load_lds_dwordx4 %1, off\n\ts_mov_b32 m0, %0" : "=&s"(_keep) : "v"(gsrc), "s"(ldst) : "memory"); } while (0)
#define AT_STAGE_K(t, slot) do { _Pragma("unroll") for (int _e = 0; _e < 2; ++_e) { \
        const unsigned _kd = (unsigned)__builtin_amdgcn_readfirstlane((int)(ldsa + (slot) * SLOT + (2 * wave + _e) * 1024)); \
        AT_GLDS(kg + (size_t)(t) * (KVT * 1024) + koff[_e], _kd); } } while (0)
#define AT_STAGE_V(t, slot) do { _Pragma("unroll") for (int _e = 0; _e < 2; ++_e) { \
        const unsigned _kd = (unsigned)__builtin_amdgcn_readfirstlane((int)(ldsa + (slot) * SLOT + (2 * wave + _e) * 1024)); \
        AT_GLDS(vg + (size_t)(t) * (KVT * 1024) + voff[_e], _kd + 16384u); } } while (0)
#define AT_WAITN(c) do { const int _c = (c); if (_c >= 8) asm volatile("s_waitcnt vmcnt(8)" ::: "memory"); else if (_c >= 6) asm volatile("s_waitcnt vmcnt(6)" ::: "memory"); \
        else if (_c >= 4) asm volatile("s_waitcnt vmcnt(4)" ::: "memory"); else if (_c >= 2) asm volatile("s_waitcnt vmcnt(2)" ::: "memory"); else asm volatile("s_waitcnt vmcnt(0)" ::: "memory"); } while (0)
#define AT_NST(s) (((s) < 0) ? 0 : (((s) + 4 < NT) ? 2 : 0) + (((s) + 3 < NT) ? 2 : 0))
    int kx[4], vb[4];
#pragma unroll
    for (int ks = 0; ks < 4; ++ks) kx[ks] = r32 * 256 + (((hf * 8 + 2 * ks + hh) ^ (r32 & 15)) * 16);
    { const int li = lane & 15, q_ = li >> 2, p_ = li & 3, g1 = (lane >> 4) & 1;
#pragma unroll
      for (int db = 0; db < 4; ++db) vb[db] = 16384 + (4 * hh + q_) * 256 + ((((db ^ q_) << 2) + 2 * g1 + (p_ >> 1)) * 16) + (p_ & 1) * 8; }
    f32x16 cc;
#pragma unroll
    for (int r = 0; r < 16; ++r) cc[r] = slope2 * (float)crow(r, hh);
    f32x16 o[4];
#pragma unroll
    for (int db = 0; db < 4; ++db)
#pragma unroll
        for (int r = 0; r < 16; ++r) o[db][r] = 0.f;
    float m = 0.f, l = 0.f;
    int ktd = (qb * 128 + w4 * 32) >> 6;
    const int t0 = 2 * qb;
#define AT_SEQ(i) (((i) < NT - t0) ? t0 + (i) : NT - 1 - (i))
    AT_STAGE_K(AT_SEQ(0), 0); AT_STAGE_V(AT_SEQ(0), 0); AT_STAGE_K(AT_SEQ(1), 1); AT_STAGE_V(AT_SEQ(1), 1); AT_STAGE_K(AT_SEQ(2), 2); AT_STAGE_V(AT_SEQ(2), 2); AT_STAGE_K(AT_SEQ(3), 3);
    asm volatile("" : "+v"(qf[0]), "+v"(qf[1]), "+v"(qf[2]), "+v"(qf[3]));
    asm volatile("s_waitcnt vmcnt(0)" ::: "memory");
    __builtin_amdgcn_s_barrier();
    asm volatile("" ::: "memory");
    f32x16 s0, s1;
    bf16x8 k0[4], k1[4];
#define AT_KLOAD(slq) do { _Pragma("unroll") for (int ks = 0; ks < 4; ++ks) { k0[ks] = *(const LAS bf16x8*)((slq) + kx[ks]); k1[ks] = *(const LAS bf16x8*)((slq) + kx[ks] + 8192); } } while (0)
#define AT_QKC(ktq) do { asm volatile("" : "+s"(ktd)); const bool dg_ = ((ktq) == ktd), lf_ = ((ktq) < ktd); const float sg_ = lf_ ? slope2 : -slope2; \
        { const float z = dg_ ? 0.f : (lf_ ? 1.f : -1.f), cm0 = (dg_ ? 0.f : sg_ * (float)((ktq) * 64 - tq)) - m, cm1 = cm0 + (dg_ ? 0.f : 32.0f * sg_); \
          _Pragma("unroll") for (int r = 0; r < 16; ++r) { s0[r] = cc[r] * z + cm0; s1[r] = cc[r] * z + cm1; } }        \
        asm volatile("" : "+v"(s0), "+v"(s1)); } while (0)
#define AT_QKM() do { __builtin_amdgcn_sched_barrier(0); \
        _Pragma("unroll") for (int ks = 0; ks < 4; ++ks) { s0 = __builtin_amdgcn_mfma_f32_32x32x16_bf16(k0[ks], qf[ks], s0, 0, 0, 0); s1 = __builtin_amdgcn_mfma_f32_32x32x16_bf16(k1[ks], qf[ks], s1, 0, 0, 0); } } while (0)
    AT_KLOAD(lds);
    AT_QKC(AT_SEQ(0)); AT_QKM();
    if (hf == 1) { asm volatile("s_waitcnt lgkmcnt(0)" ::: "memory"); __builtin_amdgcn_s_barrier(); asm volatile("" ::: "memory"); }
    int slot = 0;
    for (int ti = 0; ti < NT; ++ti) {
        const int kt = AT_SEQ(ti);
        const int s2 = (slot == 0) ? 3 : slot - 1;
        const LAS unsigned char* sl = lds + slot * SLOT;
        if (hf == 1) { if (ti + 4 < NT) { AT_STAGE_K(AT_SEQ(ti + 4), slot); } if (ti + 3 < NT) { AT_STAGE_V(AT_SEQ(ti + 3), s2); } }
        asm volatile("" : "+s"(ktd));
        const bool diag = (kt == ktd), left = (kt < ktd);
        (void)left;
        if (diag) {
            const float dq = (float)(tq - kt * 64 - 4 * hh);
#pragma unroll
            for (int r = 0; r < 16; ++r) { const float kk = (float)((r & 3) + 8 * (r >> 2)); s0[r] -= slope2 * fabsf(dq - kk); s1[r] -= slope2 * fabsf(dq - kk - 32.0f); }
        }
        float mxa = max3f(s0[0], s0[1], s0[2]), mxb = max3f(s1[0], s1[1], s1[2]), mxc = max3f(s0[3], s0[4], s0[5]), mxd = max3f(s1[3], s1[4], s1[5]);
        mxa = max3f(mxa, s0[6], s0[7]); mxb = max3f(mxb, s1[6], s1[7]); mxc = max3f(mxc, s0[8], s0[9]); mxd = max3f(mxd, s1[8], s1[9]);
        mxa = max3f(mxa, s0[10], s0[11]); mxb = max3f(mxb, s1[10], s1[11]); mxc = max3f(mxc, s0[12], s0[13]); mxd = max3f(mxd, s1[12], s1[13]);
        mxa = max3f(mxa, s0[14], s0[15]); mxb = max3f(mxb, s1[14], s1[15]);
        const float mx = swapmax(max3f(max3f(mxa, mxb, mxc), mxd, mxd));
        const bool dead = (ti > 0) && __all(mx < -40.0f);
        bf16x8 pf[4];
        if (!dead) {
        if (ti == 0 || __any(mx > 8.0f)) {
            const float delta = (ti == 0) ? mx : fmaxf(mx, 0.f);
#pragma unroll
            for (int r = 0; r < 16; ++r) { s0[r] -= delta; s1[r] -= delta; }
            if (ti > 0) { const float alpha = __builtin_amdgcn_exp2f(-delta); l *= alpha;
#pragma unroll
                for (int db = 0; db < 4; ++db)
#pragma unroll
                    for (int r = 0; r < 16; ++r) o[db][r] *= alpha; }
            m += delta;
        }
        float lsa = 0.f, lsb = 0.f, lsc = 0.f, lsd = 0.f;
#pragma unroll
        for (int r = 0; r < 16; r += 2) { s0[r] = __builtin_amdgcn_exp2f(s0[r]); s1[r] = __builtin_amdgcn_exp2f(s1[r]); s0[r + 1] = __builtin_amdgcn_exp2f(s0[r + 1]); s1[r + 1] = __builtin_amdgcn_exp2f(s1[r + 1]);
            lsa += s0[r]; lsb += s1[r]; lsc += s0[r + 1]; lsd += s1[r + 1]; }
        l += (lsa + lsb) + (lsc + lsd);
        {
            v4u w;
            w.x = cvtpk(s0[0], s0[1]); w.y = cvtpk(s0[2], s0[3]); w.z = cvtpk(s0[4], s0[5]); w.w = cvtpk(s0[6], s0[7]); pf[0] = __builtin_bit_cast(bf16x8, w);
            w.x = cvtpk(s0[8], s0[9]); w.y = cvtpk(s0[10], s0[11]); w.z = cvtpk(s0[12], s0[13]); w.w = cvtpk(s0[14], s0[15]); pf[1] = __builtin_bit_cast(bf16x8, w);
            w.x = cvtpk(s1[0], s1[1]); w.y = cvtpk(s1[2], s1[3]); w.z = cvtpk(s1[4], s1[5]); w.w = cvtpk(s1[6], s1[7]); pf[2] = __builtin_bit_cast(bf16x8, w);
            w.x = cvtpk(s1[8], s1[9]); w.y = cvtpk(s1[10], s1[11]); w.z = cvtpk(s1[12], s1[13]); w.w = cvtpk(s1[14], s1[15]); pf[3] = __builtin_bit_cast(bf16x8, w);
        }
        } else {
#pragma unroll
            for (int f = 0; f < 4; ++f) pf[f] = (bf16x8){0, 0, 0, 0, 0, 0, 0, 0};
        }
        if (ti + 1 < NT) { const int ktn = AT_SEQ(ti + 1); AT_QKC(ktn); }
        if (hf == 0) { AT_WAITN(AT_NST(ti - 2) + AT_NST(ti - 1)); }
        asm volatile("s_waitcnt lgkmcnt(0)" ::: "memory");
        __builtin_amdgcn_s_barrier();
        if (PROBE_REP & 16384) __builtin_amdgcn_s_barrier();
        asm volatile("" ::: "memory");
        if (hf == 0) { if (ti + 4 < NT) { AT_STAGE_K(AT_SEQ(ti + 4), slot); } if (ti + 3 < NT) { AT_STAGE_V(AT_SEQ(ti + 3), s2); } }
        if (ti + 1 < NT) { AT_KLOAD(lds + ((slot == 3) ? 0 : slot + 1) * SLOT); }
        __builtin_amdgcn_sched_barrier(0);
#define AT_VLOAD(dst, db) do { _Pragma("unroll") for (int _f = 0; _f < 4; ++_f) { dst##lo[_f] = vtr(sl + vb[db] + _f * 4096); dst##hi[_f] = vtr(sl + vb[db] + _f * 4096 + 2048); } } while (0)
#define AT_VMMA(src, db) do { _Pragma("unroll") for (int _f = 0; _f < 4; ++_f) { const bf16x8 vf = (bf16x8){src##lo[_f][0], src##lo[_f][1], src##lo[_f][2], src##lo[_f][3], src##hi[_f][0], src##hi[_f][1], src##hi[_f][2], src##hi[_f][3]}; \
            o[db] = __builtin_amdgcn_mfma_f32_32x32x16_bf16(vf, pf[_f], o[db], 0, 0, 0); if (PROBE_REP & 32768) { bf16x8 pz = (bf16x8){0,0,0,0,0,0,0,0}; asm volatile("" : "+v"(pz)); o[db] = __builtin_amdgcn_mfma_f32_32x32x16_bf16(vf, pz, o[db], 0, 0, 0); } } } while (0)
        if (!dead) {
            s16x4 valo[4], vahi[4], vb_lo[4], vb_hi[4];
            AT_VLOAD(va, 0); __builtin_amdgcn_sched_barrier(0);
            AT_VLOAD(vb_, 1); __builtin_amdgcn_sched_barrier(0);
            AT_VMMA(va, 0); __builtin_amdgcn_sched_barrier(0);
            AT_VLOAD(va, 2); __builtin_amdgcn_sched_barrier(0);
            AT_VMMA(vb_, 1); __builtin_amdgcn_sched_barrier(0);
            AT_VLOAD(vb_, 3); __builtin_amdgcn_sched_barrier(0);
            AT_VMMA(va, 2); __builtin_amdgcn_sched_barrier(0);
            AT_VMMA(vb_, 3); __builtin_amdgcn_sched_barrier(0);
        }
#undef AT_VLOAD
#undef AT_VMMA
        __builtin_amdgcn_sched_barrier(0);
        if (ti + 1 < NT) { AT_QKM(); }
        if (hf == 1) { AT_WAITN(AT_NST(ti - 1) + AT_NST(ti)); }
        asm volatile("s_waitcnt lgkmcnt(0)" ::: "memory");
        __builtin_amdgcn_s_barrier();
        if (PROBE_REP & 16384) __builtin_amdgcn_s_barrier();
        asm volatile("" ::: "memory");
        slot = (slot == 3) ? 0 : slot + 1;
    }
    if (hf == 0) __builtin_amdgcn_s_barrier();
    asm volatile("" ::: "memory");
#undef AT_QKC
#undef AT_QKM
#undef AT_KLOAD
#undef AT_STAGE_K
#undef AT_STAGE_V
#undef AT_WAITN
#undef AT_NST
#undef AT_GLDS
#undef AT_SEQ
    l = swapsum(l);
    const float il = 1.0f / l;
    __builtin_amdgcn_s_barrier();
    LAS float* xch = (LAS float*)lds + w4 * (64 * 64);
    if (hf == 1) {
#pragma unroll
        for (int db = 0; db < 4; ++db)
#pragma unroll
            for (int r = 0; r < 16; ++r) xch[(db * 16 + r) * 64 + lane] = o[db][r] * il;
    }
    asm volatile("s_waitcnt lgkmcnt(0)" ::: "memory");
    __builtin_amdgcn_s_barrier();
    asm volatile("" ::: "memory");
    if (hf == 0) {
        float ss = 0.f; float lfv, omv; asm volatile("v_mov_b32 %0, %2\n\tv_mov_b32 %1, %3" : "=&v"(lfv), "=&v"(omv) : "s"(lam_full), "s"(oml));
#pragma unroll
        for (int db = 0; db < 4; ++db)
#pragma unroll
            for (int r = 0; r < 16; ++r) { const float v = o[db][r] * il - lfv * xch[(db * 16 + r) * 64 + lane]; o[db][r] = v; ss += v * v; }
        ss = swapsum(ss);
        const float rs = omv / sqrtf(ss * (1.0f / 128.0f) + EPS);
        const int le = lane_id_volatile(), tqe = qb * 128 + w4 * 32 + (le & 31), hhe = le >> 5;
        bf16* op = hd + ((size_t)b * SEQ + tqe) * 1024 + 512 + h * 128 + 4 * hhe;
        f32x4 gq[4][4];
#pragma unroll
        for (int db = 0; db < 4; ++db)
#pragma unroll
            for (int r4 = 0; r4 < 4; ++r4) gq[db][r4] = *(const f32x4*)(ng + db * 32 + 8 * r4 + 4 * hhe);
#pragma unroll
        for (int db = 0; db < 4; ++db)
#pragma unroll
            for (int r4 = 0; r4 < 4; ++r4) { const int d = db * 32 + 8 * r4; const f32x4 g = gq[db][r4];
                v2u w; w.x = pk2(o[db][4 * r4] * rs * g.x, o[db][4 * r4 + 1] * rs * g.y); w.y = pk2(o[db][4 * r4 + 2] * rs * g.z, o[db][4 * r4 + 3] * rs * g.w);
                *(v2u*)(op + d) = w; }
    }
    asm volatile("s_waitcnt lgkmcnt(0)" ::: "memory");
    __builtin_amdgcn_s_barrier();
}
}
namespace mls {
using attn::f32x16; using attn::s16x4; using attn::vtr; using attn::cvtpk; using attn::swapsum; using attn::crow;
constexpr int QS = 0, KS = 32768, VS = 65536, CB = 98304, AUX = 132096;
constexpr int A_FS = 0, A_ET = 512, A_SIN = 1024, A_EMT = 1536, A_WS = 2048, A_NV = 2560, A_NP = 3072, A_SC = 5120, A_CW = 5632;
__device__ __forceinline__ int swz(int row) { return ((row & 3) << 2) | ((row >> 2) & 3); }
__device__ __forceinline__ int offs(int row, int ch) { return row * 256 + ((ch ^ swz(row)) << 4); }
__device__ __forceinline__ bf16x8 rdrow(const LAS unsigned char* lds, int buf, int RB, int i, int ks) { return *(const LAS bf16x8*)(lds + buf + (RB ^ (ks << 5)) + i * 8192); }
__device__ __forceinline__ bf16x8 trB(const LAS unsigned char* lds, int buf, int TB, int rowc, int c0) {
    const s16x4 lo = vtr(lds + buf + (TB ^ (c0 << 4)) + rowc * 256), hi = vtr(lds + buf + (TB ^ ((c0 | 2) << 4)) + (rowc + 8) * 256);
    return (bf16x8){lo[0], lo[1], lo[2], lo[3], hi[0], hi[1], hi[2], hi[3]};
}
__device__ __forceinline__ bf16x8 trC(const LAS unsigned char* lds, int buf, int TC, int ss, int c0) {
    const s16x4 lo = vtr(lds + buf + (TC ^ (c0 << 4)) + (16 * ss) * 256), hi = vtr(lds + buf + (TC ^ ((c0 | 1) << 4)) + (16 * ss + 4) * 256);
    return (bf16x8){lo[0], lo[1], lo[2], lo[3], hi[0], hi[1], hi[2], hi[3]};
}
__device__ __forceinline__ void mm8(f32x16& acc, const LAS unsigned char* lds, int bufA, int ia, int bufB, int ib, int RB) {
    bf16x8 a[8], b[8];
#pragma unroll
    for (int ks = 0; ks < 4; ++ks) { a[ks] = rdrow(lds, bufA, RB, ia, ks); b[ks] = rdrow(lds, bufB, RB, ib, ks); }
    __builtin_amdgcn_sched_barrier(0);
#pragma unroll
    for (int ks = 4; ks < 8; ++ks) { a[ks] = rdrow(lds, bufA, RB, ia, ks); b[ks] = rdrow(lds, bufB, RB, ib, ks); }
    __builtin_amdgcn_sched_barrier(0);
#pragma unroll
    for (int ks = 0; ks < 8; ++ks) {
        acc = __builtin_amdgcn_mfma_f32_32x32x16_bf16(a[ks], b[ks], acc, 0, 0, 0);
        if (ks == 3) __builtin_amdgcn_sched_barrier(0);
    }
    __builtin_amdgcn_sched_barrier(0);
}
template <int CTRL, int RM> __device__ __forceinline__ float dpp_f(float idv, float v) { return __int_as_float(__builtin_amdgcn_update_dpp(__float_as_int(idv), __float_as_int(v), CTRL, RM, 0xf, false)); }
__device__ __forceinline__ float scan_add(float x, int) {
    x += dpp_f<0x111, 0xf>(0.f, x); x += dpp_f<0x112, 0xf>(0.f, x); x += dpp_f<0x114, 0xf>(0.f, x); x += dpp_f<0x118, 0xf>(0.f, x);
    x += dpp_f<0x142, 0xa>(0.f, x); x += dpp_f<0x143, 0xc>(0.f, x); return x;
}
__device__ __forceinline__ float scan_max(float x, int) {
    const float ni = -3.0e38f;
    x = fmaxf(x, dpp_f<0x111, 0xf>(ni, x)); x = fmaxf(x, dpp_f<0x112, 0xf>(ni, x)); x = fmaxf(x, dpp_f<0x114, 0xf>(ni, x)); x = fmaxf(x, dpp_f<0x118, 0xf>(ni, x));
    x = fmaxf(x, dpp_f<0x142, 0xa>(ni, x)); x = fmaxf(x, dpp_f<0x143, 0xc>(ni, x)); return x;
}
__device__ __forceinline__ void item(LAS unsigned char* lds, int tid, int b, int h, int dir, const bf16* zqk, const bf16* zmv, const float* mg, const float* cw, const float* cb, bf16* outp) {
    const int lane = tid & 63, wave = __builtin_amdgcn_readfirstlane(tid >> 6);
    LAS float* aux = (LAS float*)(lds + AUX);
    { unsigned zz = 0u; asm volatile("" : "+v"(zz)); for (int i = tid; i < 32768 / 16; i += NTHREADS) *(LAS v4u*)(lds + CB + i * 16) = (v4u){zz, zz, zz, zz}; }
    if (tid < 128) aux[A_NV / 4 + tid] = 0.f;
    if (tid < 4 * 128) aux[A_NP / 4 + tid] = 0.f;
    if (tid < 8) aux[A_SC / 4 + tid] = 1.f;
    for (int i = tid; i < 6 * 256; i += NTHREADS) { const int j = i >> 8, c = i & 255; const int col = (c < 128) ? (h * 128 + c) : (512 + h * 128 + (c - 128)); aux[A_CW / 4 + i] = (j < 5) ? cw[j * 1024 + col] : cb[col]; }
    f32x16 X[2];
#pragma unroll
    for (int kb = 0; kb < 2; ++kb)
#pragma unroll
        for (int r = 0; r < 16; ++r) X[kb][r] = 0.f;
    float mstate = 0.f;
    __syncthreads();
#pragma unroll 1
    for (int c = 0; c < SEQ / 128; ++c) {
        const int c0 = dir ? (SEQ - 128 - c * 128) : c * 128;
        int tl = tid; asm volatile("" : "+v"(tl));
        if (tl >= 128 && tl < 256) { const int k = tl - 128; aux[A_NV / 4 + k] = aux[A_SC / 4 + ((c + 1) & 1)] * aux[A_NV / 4 + k] + (aux[A_NP / 4 + k] + aux[A_NP / 4 + 128 + k]) + (aux[A_NP / 4 + 256 + k] + aux[A_NP / 4 + 384 + k]); }
        {
          const int cq = tl & 31, rg = tl >> 5; const int col = (cq < 16) ? (h * 128 + cq * 8) : (512 + h * 128 + (cq - 16) * 8);
          const float ksc = (cq < 16) ? 1.0f : 0.08838834764831845f;
          const int base = dir ? (c0 + 118 - 8 * rg) : (c0 + 8 * rg - 2);
          float ip0 = 0.f, fp0 = 0.f, ip1 = 0.f, fp1 = 0.f; int u0 = 0, u1 = 1;
          if (wave == 0) { int ln_ = lane; asm volatile("" : "+v"(ln_)); u0 = 2 * ln_; u1 = u0 + 1; const int p0 = dir ? (c0 + 127 - u0) : (c0 + u0), p1 = dir ? (c0 + 127 - u1) : (c0 + u1);
              const float* g0 = mg + ((size_t)b * SEQ + p0) * 16 + dir * 8 + h; const float* g1p = mg + ((size_t)b * SEQ + p1) * 16 + dir * 8 + h; ip0 = g0[0]; fp0 = g0[4]; ip1 = g1p[0]; fp1 = g1p[4]; }
          v4u xr[12], vr[4];
#pragma unroll
          for (int i = 0; i < 12; ++i) { const int ts = dir ? base + 11 - i : base + i; xr[i] = (v4u){0u, 0u, 0u, 0u}; if (ts >= 0 && ts < SEQ) xr[i] = *(const v4u*)(zqk + ((size_t)b * SEQ + ts) * 1024 + col); }
#pragma unroll
          for (int n = 0; n < 4; ++n) { const int i = tl + NTHREADS * n, u = i >> 4, ch = i & 15; const int pos = dir ? (c0 + 127 - u) : (c0 + u);
              vr[n] = *(const v4u*)(zmv + ((size_t)b * SEQ + pos) * 512 + h * 128 + ch * 8); }
        if (wave == 0) {
            const float lf0 = fminf(fp0, 0.f) - log1pf(__expf(-fabsf(fp0))), lf1 = fminf(fp1, 0.f) - log1pf(__expf(-fabsf(fp1)));
            const float incl = scan_add(lf0 + lf1, lane);
            const float bc1 = incl, bc0 = incl - lf1;
            const float fs0 = ip0 - bc0, fs1 = ip1 - bc1;
            const float pmx = scan_max(fmaxf(fs0, fs1), lane);
            const float prev = dpp_f<0x138, 0xf>(-3.0e38f, pmx);
            const float dm0 = fmaxf(prev, fs0), dm1 = pmx;
            const float gtot = __uint_as_float(__builtin_amdgcn_readlane(__float_as_uint(bc1), 63)), dlast = __uint_as_float(__builtin_amdgcn_readlane(__float_as_uint(pmx), 63));
            const float M0 = fmaxf(mstate, dm0), M1 = fmaxf(mstate, dm1), Ml = fmaxf(mstate, dlast);
            aux[A_FS / 4 + u0] = fs0; aux[A_FS / 4 + u1] = fs1;
            aux[A_ET / 4 + u0] = -M0; aux[A_ET / 4 + u1] = -M1;
            aux[A_SIN / 4 + u0] = __expf(mstate - M0); aux[A_SIN / 4 + u1] = __expf(mstate - M1);
            aux[A_EMT / 4 + u0] = __expf(-(bc0 + M0)); aux[A_EMT / 4 + u1] = __expf(-(bc1 + M1));
            aux[A_WS / 4 + u0] = __expf(fs0 - Ml); aux[A_WS / 4 + u1] = __expf(fs1 - Ml);
            if (lane == 0) aux[A_SC / 4 + (c & 1)] = __expf(mstate - Ml);
            mstate = gtot + Ml;
        }
          const LAS float* cwl = aux + A_CW / 4 + cq * 8;
          float xu[12][8];
#define ML_UNP(r_) do { xu[r_][0] = bflo(xr[r_].x); xu[r_][1] = bfhi(xr[r_].x); xu[r_][2] = bflo(xr[r_].y); xu[r_][3] = bfhi(xr[r_].y); xu[r_][4] = bflo(xr[r_].z); xu[r_][5] = bfhi(xr[r_].z); xu[r_][6] = bflo(xr[r_].w); xu[r_][7] = bfhi(xr[r_].w); } while (0)
#pragma unroll
          for (int n = 0; n < 8; ++n) {
              if (n == 0) { ML_UNP(0); ML_UNP(1); ML_UNP(2); ML_UNP(3); }
              ML_UNP(n + 4);
              float a[8];
              { const f32x4 b0 = *(const LAS f32x4*)(cwl + 5 * 256), b1 = *(const LAS f32x4*)(cwl + 5 * 256 + 4); a[0] = b0.x; a[1] = b0.y; a[2] = b0.z; a[3] = b0.w; a[4] = b1.x; a[5] = b1.y; a[6] = b1.z; a[7] = b1.w; }
#pragma unroll
              for (int j = 0; j < CONVW; ++j) { const LAS float* wp = cwl + (dir ? (CONVW - 1 - j) : j) * 256; const f32x4 w0 = *(const LAS f32x4*)wp, w1 = *(const LAS f32x4*)(wp + 4);
                  a[0] += w0.x * xu[n + j][0]; a[1] += w0.y * xu[n + j][1]; a[2] += w0.z * xu[n + j][2]; a[3] += w0.w * xu[n + j][3]; a[4] += w1.x * xu[n + j][4]; a[5] += w1.y * xu[n + j][5]; a[6] += w1.z * xu[n + j][6]; a[7] += w1.w * xu[n + j][7]; }
#pragma unroll
              for (int e = 0; e < 8; ++e) a[e] = a[e] * sigmoidf_(a[e]) * ksc;
              v4u o; o.x = pk2(a[0], a[1]); o.y = pk2(a[2], a[3]); o.z = pk2(a[4], a[5]); o.w = pk2(a[6], a[7]);
              *(LAS v4u*)(lds + ((cq < 16) ? QS : KS) + offs(8 * rg + n, cq & 15)) = o;
              __builtin_amdgcn_sched_barrier(0); }
#undef ML_UNP
#pragma unroll
          for (int n = 0; n < 4; ++n) { const int i = tl + NTHREADS * n, u = i >> 4, ch = i & 15; *(LAS v4u*)(lds + VS + offs(u, ch)) = vr[n]; } }
        __syncthreads();
        {
            int lb = lane; asm volatile("" : "+v"(lb));
            const int r32 = lb & 31, hh = lb >> 5;
            int RB, RB2, TB;
            { const int sw = swz(r32), li = lb & 15, q_ = li >> 2, p_ = li & 3, x = 2 * ((lb >> 4) & 1) + (p_ >> 1);
              RB = r32 * 256 + ((hh ^ sw) << 4); RB2 = r32 * 256 + (((8 * hh) ^ sw) << 4);
              TB = (4 * hh + q_) * 256 + (((q_ << 2) | (x ^ hh)) << 4) + 8 * (p_ & 1); }
            const int vh = wave >> 2, j = vh ? 3 - (wave & 3) : (wave & 3), t = 32 * j + r32;
            f32x16 acc[2];
#pragma unroll
            for (int vb2 = 0; vb2 < 2; ++vb2) {
#pragma unroll
                for (int r = 0; r < 16; ++r) acc[vb2][r] = 0.f;
                mm8(acc[vb2], lds, CB, 2 * vh + vb2, QS, j, RB);
                asm volatile("" : "+v"(RB));
            }
            const float sin = aux[A_SIN / 4 + t], et = aux[A_ET / 4 + t];
#pragma unroll
            for (int vb2 = 0; vb2 < 2; ++vb2)
#pragma unroll
                for (int r = 0; r < 16; ++r) acc[vb2][r] *= sin;
            float dn = 0.f;
#pragma unroll
            for (int cq = 0; cq < 8; ++cq) { const int ch = 8 * hh + cq; const v4u qv = *(const LAS v4u*)(lds + QS + (RB2 ^ (cq << 4)) + j * 8192); const f32x4 n0 = *(const LAS f32x4*)(aux + A_NV / 4 + 8 * ch), n1 = *(const LAS f32x4*)(aux + A_NV / 4 + 8 * ch + 4);
                dn += n0.x * bflo(qv.x) + n0.y * bfhi(qv.x) + n0.z * bflo(qv.y) + n0.w * bfhi(qv.y) + n1.x * bflo(qv.z) + n1.y * bfhi(qv.z) + n1.z * bflo(qv.w) + n1.w * bfhi(qv.w);
                if (cq & 1) { asm volatile("" : "+v"(dn)); __builtin_amdgcn_sched_barrier(0); } }
            float dsum = 0.f;
            for (int i = 0; i <= j; ++i) {
                f32x16 sc;
#pragma unroll
                for (int r = 0; r < 16; ++r) sc[r] = 0.f;
                mm8(sc, lds, KS, i, QS, j, RB);
                asm volatile("" : "+v"(RB));
                bf16x8 vfr[4];
#pragma unroll
                for (int vb2 = 0; vb2 < 2; ++vb2) { vfr[2 * vb2] = trB(lds, VS, TB, 32 * i, 4 * (2 * vh + vb2)); vfr[2 * vb2 + 1] = trB(lds, VS, TB, 32 * i + 16, 4 * (2 * vh + vb2)); }
                __builtin_amdgcn_sched_barrier(0);
#pragma unroll
                for (int r4 = 0; r4 < 4; ++r4) { const f32x4 fs = *(const LAS f32x4*)(aux + A_FS / 4 + 32 * i + 8 * r4 + 4 * hh);
#pragma unroll
                    for (int e = 0; e < 4; ++e) { const int r = 4 * r4 + e; const float p = __expf(et + fs[e]); const bool ok = (i < j) || (8 * r4 + 4 * hh + e <= r32);
                        const float w = ok ? sc[r] * p : 0.f; sc[r] = w; dsum += w; } }
                v4u w0, w1;
                w0.x = cvtpk(sc[0], sc[1]); w0.y = cvtpk(sc[2], sc[3]); w0.z = cvtpk(sc[4], sc[5]); w0.w = cvtpk(sc[6], sc[7]);
                w1.x = cvtpk(sc[8], sc[9]); w1.y = cvtpk(sc[10], sc[11]); w1.z = cvtpk(sc[12], sc[13]); w1.w = cvtpk(sc[14], sc[15]);
                const bf16x8 wf0 = __builtin_bit_cast(bf16x8, w0), wf1 = __builtin_bit_cast(bf16x8, w1);
                __builtin_amdgcn_sched_barrier(0);
#pragma unroll
                for (int vb2 = 0; vb2 < 2; ++vb2) {
                    acc[vb2] = __builtin_amdgcn_mfma_f32_32x32x16_bf16(vfr[2 * vb2], wf0, acc[vb2], 0, 0, 0);
                    acc[vb2] = __builtin_amdgcn_mfma_f32_32x32x16_bf16(vfr[2 * vb2 + 1], wf1, acc[vb2], 0, 0, 0);
                    __builtin_amdgcn_sched_barrier(0);
                }
            }
            const float den = swapsum(dn) * sin + swapsum(dsum);
            const float scale = 1.0f / fmaxf(fabsf(den), aux[A_EMT / 4 + t]);
            const int pos = dir ? (c0 + 127 - t) : (c0 + t);
            bf16* op = outp + ((size_t)b * SEQ + pos) * 512 + h * 128 + 4 * hh;
#pragma unroll
            for (int vb2 = 0; vb2 < 2; ++vb2)
#pragma unroll
                for (int r4 = 0; r4 < 4; ++r4) { v2u o4; o4.x = cvtpk(acc[vb2][4 * r4] * scale, acc[vb2][4 * r4 + 1] * scale); o4.y = cvtpk(acc[vb2][4 * r4 + 2] * scale, acc[vb2][4 * r4 + 3] * scale);
                    *(v2u*)(op + 32 * (2 * vh + vb2) + 8 * r4) = o4; }
        }
        __syncthreads();
        {
            int lb = lane; asm volatile("" : "+v"(lb));
            const int hh = lb >> 5;
            int TC;
            { const int li = lb & 15, q_ = li >> 2, p_ = li & 3, x = 2 * ((lb >> 4) & 1) + (p_ >> 1);
              TC = (8 * hh + q_) * 256 + (((q_ << 2) | (x ^ (2 * hh))) << 4) + 8 * (p_ & 1); }
            const int vs = wave & 3, kh = wave >> 2;
            const float sp = aux[A_SC / 4 + (c & 1)];
#pragma unroll
            for (int kb = 0; kb < 2; ++kb)
#pragma unroll
                for (int r = 0; r < 16; ++r) X[kb][r] *= sp;
            {
                bf16x8 vr_[2], k0_[2], k1_[2]; f32x4 wa_[2], wb_[2];
                vr_[0] = trC(lds, VS, TC, 0, 4 * vs); k0_[0] = trC(lds, KS, TC, 0, 8 * kh); k1_[0] = trC(lds, KS, TC, 0, 8 * kh + 4);
                wa_[0] = *(const LAS f32x4*)(aux + A_WS / 4 + 8 * hh); wb_[0] = *(const LAS f32x4*)(aux + A_WS / 4 + 8 * hh + 4);
#pragma unroll
                for (int ss = 0; ss < 8; ++ss) { const int cu = ss & 1, nx = cu ^ 1;
                    if (ss + 1 < 8) { vr_[nx] = trC(lds, VS, TC, ss + 1, 4 * vs); k0_[nx] = trC(lds, KS, TC, ss + 1, 8 * kh); k1_[nx] = trC(lds, KS, TC, ss + 1, 8 * kh + 4);
                        wa_[nx] = *(const LAS f32x4*)(aux + A_WS / 4 + 16 * (ss + 1) + 8 * hh); wb_[nx] = *(const LAS f32x4*)(aux + A_WS / 4 + 16 * (ss + 1) + 8 * hh + 4); }
                    const v4u vv = __builtin_bit_cast(v4u, vr_[cu]); const f32x4 wa = wa_[cu], wb = wb_[cu]; v4u vw;
                    vw.x = cvtpk(bflo(vv.x) * wa.x, bfhi(vv.x) * wa.y); vw.y = cvtpk(bflo(vv.y) * wa.z, bfhi(vv.y) * wa.w); vw.z = cvtpk(bflo(vv.z) * wb.x, bfhi(vv.z) * wb.y); vw.w = cvtpk(bflo(vv.w) * wb.z, bfhi(vv.w) * wb.w);
                    const bf16x8 vf = __builtin_bit_cast(bf16x8, vw);
                    X[0] = __builtin_amdgcn_mfma_f32_32x32x16_bf16(k0_[cu], vf, X[0], 0, 0, 0);
                    X[1] = __builtin_amdgcn_mfma_f32_32x32x16_bf16(k1_[cu], vf, X[1], 0, 0, 0);
                    __builtin_amdgcn_sched_barrier(0);
                }
            }
            { int t2 = tid; asm volatile("" : "+v"(t2)); const int k = t2 & 127, sq = t2 >> 7; float a = 0.f;
#pragma unroll 8
              for (int s2 = 0; s2 < 32; ++s2) { const int sI = 32 * sq + s2; a += aux[A_WS / 4 + sI] * bf2f(*(const LAS unsigned short*)(lds + KS + offs(sI, k >> 3) + (k & 7) * 2)); }
              aux[A_NP / 4 + sq * 128 + k] = a; }
        }
        __syncthreads();
        { int lb = lane; asm volatile("" : "+v"(lb)); const int r32 = lb & 31, hh = lb >> 5;
          const int vs = wave & 3, kh = wave >> 2, v = 32 * vs + r32;
#pragma unroll
          for (int kb = 0; kb < 2; ++kb)
#pragma unroll
              for (int r4 = 0; r4 < 4; ++r4) { v2u w; w.x = cvtpk(X[kb][4 * r4], X[kb][4 * r4 + 1]); w.y = cvtpk(X[kb][4 * r4 + 2], X[kb][4 * r4 + 3]);
                  *(LAS v2u*)(lds + CB + offs(v, 8 * kh + 4 * kb + r4) + 8 * hh) = w; } }
    }
    __syncthreads();
}
}
constexpr int CW_QUEUE = 2048;
__device__ __forceinline__ void ph_mixers(Frame& F, int l, int qslot) {
    PH_IDS;
    static_assert(DEPTH == 2, "lam_init literals");
    const float lam_init = (l == 0) ? 0.2f : 0.35550906759096927f;
    const float* lam = F.in[I_LAM] + (size_t)l * 4 * ADH;
    const float s01 = wave_sum_fast(lam[lane] * lam[64 + lane]), s23 = wave_sum_fast(lam[128 + lane] * lam[192 + lane]);
    const float lam_full = __uint_as_float(__builtin_amdgcn_readfirstlane(__float_as_uint(__expf(s01) - __expf(s23) + lam_init)));
    const unsigned oml = (l == 0) ? 0x3f4ccccdu : 0x3f24fd5cu;
    const float* cw = F.in[I_CW] + (size_t)l * CONVW * 2 * MW; const float* cb = F.in[I_CB] + (size_t)l * 2 * MW;
    unsigned* head = (unsigned*)(F.ws + WS_CTL) + CW_QUEUE + 64 * qslot;
    volatile LAS unsigned* qw = (volatile LAS unsigned*)(F.lds + MISC_OFF + 64);
    constexpr int NML = BATCH * MH * 2, NAT = BATCH * AH * (SEQ / 128);
    constexpr int NCV0 = (CV_NITEMS - CV_WIN) / 128, NCV1 = CV_WIN / 128;
    static_assert((CV_NITEMS - CV_WIN) % 128 == 0 && CV_WIN % 128 == 0 && 3 * (NCV0 + NCV1) <= NAT + NCV0 + NCV1, "conversion items are 128 tiles; the (2 attention, 1 conversion) groups fit");
    const int NCV = NCV0 + ((l + 1 < DEPTH) ? NCV1 : 0);
    for (;;) {
        __syncthreads();
        if (tid == 0) qw[0] = __hip_atomic_fetch_add(head, 1u, __ATOMIC_RELAXED, __HIP_MEMORY_SCOPE_AGENT);
        __syncthreads();
        int it = (int)qw[0];
        if (PROBE_REP & 8) { if (it >= NML + 2 * (NAT + NCV)) break; if (it >= NML + NAT + NCV) it -= NAT + NCV; }
        else if (PROBE_REP & 4) { if (it >= 2 * NML + NAT + NCV) break; if (it >= NML + NAT + NCV) it -= NML + NAT + NCV; }
        else if (it >= NML + NAT + NCV) break;
        const int tq_ = F.wv * 64 + lane_id_volatile();
        if (it < NML) { const int dir = it & 1, h = (it >> 1) & 3, b = it >> 3; int t1 = tq_; asm volatile("" : "+v"(t1));
            mls::item(F.lds, t1, b, h, dir, WSP(bf16, WS_ZQK), WSP(bf16, WS_ZMV), WSP(float, WS_MG), cw, cb, WSP(bf16, dir ? WS_HB : WS_HF)); }
        else {
            const int j = it - NML; int u, ci = -1;
            if (j < 3 * NCV) { if (j % 3 == 2) ci = j / 3; u = j - j / 3; } else u = j - NCV;
            if (ci >= 0) {
                int t2 = tq_; asm volatile("" : "+v"(t2));
                const int l2 = (ci >= NCV0) ? l + 1 : l, first = (ci >= NCV0) ? (ci - NCV0) * 128 : CV_WIN + ci * 128;
                cv_run(F, l2, t2 & 63, (LAS float*)(F.lds + (t2 >> 6) * 16384), first, 128, __builtin_amdgcn_readfirstlane(t2 >> 6), NWAVES); }
            else { const int qb = u & 15, b = (u >> 4) & 15, h = 3 - (u >> 8);
            int t3 = tq_; asm volatile("" : "+v"(t3));
            attn::unit(F.lds, t3, b, h, qb, WSP(bf16, WS_ZDQ), WSP(bf16, WS_ZDK), WSP(bf16, WS_ZDV), WSP(bf16, WS_HM), F.in[I_DNG] + (size_t)l * ADV, lam_full, oml); } }
    }
}

constexpr int NPH = 1 + DEPTH * 10;
__global__ void __launch_bounds__(NTHREADS, 2) fwd(Args args) {
    extern __shared__ __attribute__((aligned(16))) unsigned char lds_raw[];
    Frame F;
    F.lds = (LAS unsigned char*)lds_raw;
    F.G = gridDim.x; F.bx = blockIdx.x; F.wv = __builtin_amdgcn_readfirstlane(threadIdx.x >> 6);
#pragma unroll
    for (int i = 0; i < 18; ++i) F.in[i] = args.in[i];
    F.X = args.out; F.ws = args.ws;
    volatile LAS unsigned* MISC = (volatile LAS unsigned*)(F.lds + MISC_OFF);
    for (int u = threadIdx.x; u < (LDS_BYTES - LDSCTL_OFF) / 4; u += NTHREADS) ((LAS unsigned*)(F.lds + LDSCTL_OFF))[u] = 0u;
    __syncthreads();
    const int lo = args.ph_lo, hi = args.ph_hi;
    XcdBarrier bar; bar.bar = (unsigned*)(F.ws + WS_CTL) + CW_BAR; bar.x = 0; bar.st = nullptr;
    if (hi - lo > 1) bar = xcd_barrier_post((unsigned*)(F.ws + WS_CTL) + CW_BAR, MISC + 8);
#define IN(k) (lo <= (k) && (k) < hi)
#define SEAM(k) do { if (IN(k) && IN((k) + 1)) { xcd_barrier(bar); if (PROBE_REP & 4096) xcd_barrier(bar); } } while (0)
    LAS unsigned char* ring = F.lds;

    if (IN(0)) { ph_convert(F, 0); ph_prep_first(F);
        if (PROBE_REP & 1) { __syncthreads(); ph_convert(F, 0); ph_prep_first(F); } }
    SEAM(0);
    for (int l = 0; l < DEPTH; ++l) {
        const int p0 = 1 + l * 10;
        if (IN(p0 + 0)) {
            ph_mgate(F, l);
            pg8::StdOrder S; S.init(T, NIN - 2560, F.G, F.bx);
            pg8::EpiInproj E{WSP(bf16, WS_ZQK), WSP(bf16, WS_ZMV), WSP(bf16, WS_ZMO), WSP(bf16, WS_ZDQ), WSP(bf16, WS_ZDK), WSP(bf16, WS_ZDV), WSP(bf16, WS_ZG), WSP(float, WS_RSTD1)};
            pg8::gemm_phase(ring, WSP(bf16, WS_XR), WSP(bf16, WS_WIN), D, S, E, F.wv);
            pg8::StdOrderG S2; S2.init(T, 2560, F.G, F.bx);
            pg8::EpiGate8 E2{F.ws + WS_ZMO, F.ws + WS_ZG, WSP(float, WS_RSTD1)};
            pg8::gemm_phase(ring, WSP(bf16, WS_MIX), (const pg8::bf16_t*)(F.ws + WS_WIN8), D / 2, S2, E2, F.wv);
        }
        SEAM(p0 + 0);
        if (IN(p0 + 1)) { ph_mixers(F, l, l); }
        SEAM(p0 + 1);
        if (IN(p0 + 2)) { for (int rep = 0; rep < ((PROBE_REP & 16) ? 2 : 1); ++rep) ph_mnorm(F, l); }
        SEAM(p0 + 2);
        if (IN(p0 + 3)) {
            pg8::UpOrder S; S.init(T, D, F.G, F.bx);
            pg8::EpiUp E{WSP(bf16, WS_MIX), F.ws + WS_ZG}; pg8::gemm_phase(ring, WSP(bf16, WS_HM), WSP(bf16, l == 0 ? WS_WA : WS_WA_L1), MW, S, E, F.wv, 1024);
        }
        SEAM(p0 + 3);
        if (IN(p0 + 4)) {
            pg8::StdOrder S; S.init(T, D, F.G, F.bx);
            pg8::EpiResid E{WSP(bf16, WS_XR)}; pg8::gemm_phase(ring, WSP(bf16, WS_MIX), WSP(bf16, l == 0 ? WS_WO : WS_WO_L1), D, S, E, F.wv);
        }
        SEAM(p0 + 4);
        if (IN(p0 + 5)) { for (int rep = 0; rep < ((PROBE_REP & 64) ? 2 : 1); ++rep) ph_prep2(F, l); }
        SEAM(p0 + 5);
        if (IN(p0 + 6)) { for (int rep = 0; rep < ((PROBE_REP & 128) ? 2 : 1); ++rep) ph_topk(F); }
        SEAM(p0 + 6);
        if (IN(p0 + 7)) {
            pg8::G1Order S{WSP(int, WS_IDX), F.G, F.bx};
            pg8::EpiG1 E{F.ws + WS_HID}; for (int rep = 0; rep < ((PROBE_REP & 256) ? 2 : 1); ++rep) pg8::gemm_phase(ring, WSP(bf16, WS_XB), WSP(bf16, l == 0 ? WS_WGU : WS_WGU_L1), D / 2, S, E, F.wv);
        }
        SEAM(p0 + 7);
        if (IN(p0 + 8)) {
            pg8::G2Order S{F.G, F.bx};
            pg8::EpiG2 E{F.ws + WS_YE, WSP(float, WS_GATEV)}; for (int rep = 0; rep < ((PROBE_REP & 512) ? 2 : 1); ++rep) pg8::gemm_phase(ring, WSP(bf16, WS_HID), WSP(bf16, l == 0 ? WS_WD : WS_WD_L1), DFF / 2, S, E, F.wv);
        }
        SEAM(p0 + 8);
        if (IN(p0 + 9)) { ph_combine(F, l); }
        SEAM(p0 + 9);
    }
#undef IN
#undef SEAM
}

extern "C" void kernel_launch(void* const* d_in, const int* in_sizes, int n_in, void* d_out, int out_size, void* d_ws, size_t ws_size, hipStream_t stream) {
    static int grid = 0;
    if (grid == 0) {
        if (n_in != 18 || out_size != T * D || ws_size < WS_END2) { fprintf(stderr, "kernel_launch: unexpected shapes (n_in %d, out %d, ws %zu)\n", n_in, out_size, ws_size); grid = -1; return; }
        int dev = 0, cus = 0, per_cu = 0;
        if (hipGetDevice(&dev) != hipSuccess || hipDeviceGetAttribute(&cus, hipDeviceAttributeMultiprocessorCount, dev) != hipSuccess) { grid = -1; return; }
        if (hipFuncSetAttribute((const void*)fwd, hipFuncAttributeMaxDynamicSharedMemorySize, LDS_BYTES) != hipSuccess) { fprintf(stderr, "kernel_launch: hipFuncSetAttribute failed\n"); grid = -1; return; }
        if (hipOccupancyMaxActiveBlocksPerMultiprocessor(&per_cu, (const void*)fwd, NTHREADS, LDS_BYTES) != hipSuccess || per_cu < 1) fprintf(stderr, "kernel_launch: occupancy query says %d\n", per_cu);
        (void)hipGetLastError();
        grid = cus;
    }
    if (grid < 0) return;
    (void)hipMemsetAsync((char*)d_ws + WS_CTL, 0, CTL_ZERO_BYTES, stream);
    Args a{};
    for (int i = 0; i < 18; ++i) a.in[i] = (const float*)d_in[i];
    a.out = (float*)d_out; a.ws = (unsigned char*)d_ws;
#if MK_ONE_LAUNCH
    a.ph_lo = 0; a.ph_hi = NPH;
    hipLaunchKernelGGL(fwd, dim3(grid), dim3(NTHREADS), LDS_BYTES, stream, a);
#else
    for (int p = 0; p < NPH; ++p) { a.ph_lo = p; a.ph_hi = p + 1; hipLaunchKernelGGL(fwd, dim3(grid), dim3(NTHREADS), LDS_BYTES, stream, a); }
#endif
}
```
